# Optimizing an MI355X kernel written in HIP

```python
import jax, jax.numpy as jnp
from jax import lax
import numpy as np

D_MODEL = 1024
BATCH = 8
SEQ = 4096
DEPTH = 2

N_MEM = 256
DA_HEADS = 4
DA_HEAD_DIM = 64
DA_V_DIM = 2 * DA_HEAD_DIM
DA_WIDTH = DA_HEADS * DA_V_DIM
LRU_WIDTH = 512
LRU_BLOCKS = 8
LRU_BLOCK = LRU_WIDTH // LRU_BLOCKS
LRU_C = 8.0
CONV_WIDTH = 4
CONV_LEFT = 2
CONV_RIGHT = 1
MIX_WIDTH = DA_WIDTH + LRU_WIDTH
IN_WIDTH = 3 * DA_WIDTH + 2 * LRU_WIDTH
ROPE_THETA = 500000.0
ROPE_DIM = DA_HEAD_DIM // 4
X_HEADS = 4
X_HEAD_DIM = D_MODEL // X_HEADS
D_FF = 4 * D_MODEL
Q_BLOCK = 128
EPS = 1e-6

kernel_name = "hybrid_diffattn_rglru_memory_encoder"


def rms_norm(x, g):
    xf = x.astype(jnp.float32)
    y = xf * lax.rsqrt(jnp.mean(xf * xf, axis=-1, keepdims=True) + EPS)
    return (y * g.astype(jnp.float32)).astype(x.dtype)


def rope_tables(positions):
    inv_freq = jnp.power(jnp.float32(ROPE_THETA),
                         -jnp.arange(0, ROPE_DIM, 2, dtype=jnp.float32) / ROPE_DIM)
    ang = positions.astype(jnp.float32)[..., None] * inv_freq
    return jnp.cos(ang)[:, :, None, None, :], jnp.sin(ang)[:, :, None, None, :]


def partial_rope(t, cos, sin):
    half = ROPE_DIM // 2
    c = cos.astype(t.dtype)
    s = sin.astype(t.dtype)
    t1 = t[..., :half]
    t2 = t[..., half:ROPE_DIM]
    return jnp.concatenate([t1 * c - t2 * s, t2 * c + t1 * s, t[..., ROPE_DIM:]], axis=-1)


def diff_attention(q, k, v, lam):
    B, S = q.shape[0], q.shape[1]
    nb = S // Q_BLOCK
    scale = DA_HEAD_DIM ** -0.5
    k1 = k[:, :, :, 0]
    k2 = k[:, :, :, 1]
    qb = q.reshape(B, nb, Q_BLOCK, DA_HEADS, 2, DA_HEAD_DIM).transpose(1, 0, 2, 3, 4, 5)

    def block(qblk):
        s1 = jnp.einsum('bqhd,bkhd->bhqk', qblk[:, :, :, 0], k1,
                        preferred_element_type=jnp.float32) * scale
        s2 = jnp.einsum('bqhd,bkhd->bhqk', qblk[:, :, :, 1], k2,
                        preferred_element_type=jnp.float32) * scale
        p = jax.nn.softmax(s1, axis=-1) - lam * jax.nn.softmax(s2, axis=-1)
        return jnp.einsum('bhqk,bkhe->bqhe', p.astype(v.dtype), v)

    o = lax.map(block, qb)
    return o.transpose(1, 0, 2, 3, 4).reshape(B, S, DA_HEADS, DA_V_DIM)


def centred_dwconv(x, w, b):
    S = x.shape[1]
    xp = jnp.pad(x, ((0, 0), (CONV_LEFT, CONV_RIGHT), (0, 0)))
    y = b
    for j in range(CONV_WIDTH):
        y = y + xp[:, j:j + S] * w[j]
    return y


def block_diag(x, w, b):
    B, S = x.shape[0], x.shape[1]
    xb = x.reshape(B, S, LRU_BLOCKS, LRU_BLOCK)
    return (jnp.einsum('bsni,nij->bsnj', xb, w) + b).reshape(B, S, LRU_WIDTH)


def _linrec(e1, e2):
    a1, b1 = e1
    a2, b2 = e2
    return a1 * a2, a2 * b1 + b2


def rg_lru(x, w_r, b_r, w_i, b_i, a_param, reverse):
    r = jax.nn.sigmoid(block_diag(x, w_r, b_r).astype(jnp.float32))
    i = jax.nn.sigmoid(block_diag(x, w_i, b_i).astype(jnp.float32))
    log_a = -LRU_C * r * jax.nn.softplus(-a_param.astype(jnp.float32))
    a = jnp.exp(log_a)
    u = x.astype(jnp.float32) * i * jnp.sqrt(-jnp.expm1(2.0 * log_a))
    _, h = lax.associative_scan(_linrec, (a, u), axis=1, reverse=reverse)
    return h.astype(x.dtype)


def setup_inputs(seed: int = 0) -> dict:
    key = jax.random.key(seed)
    ks = iter(jax.random.split(key, 64))
    f32 = jnp.float32

    def nrm(shape, scale):
        return jax.random.normal(next(ks), shape, f32) * scale

    def gain(shape):
        return 1.0 + 0.02 * jax.random.normal(next(ks), shape, f32)

    u = jax.random.uniform(next(ks), (DEPTH, 2, LRU_WIDTH), f32, 0.9, 0.999)
    a0 = u ** (1.0 / LRU_C)
    lru_a_param = jnp.log(a0) - jnp.log1p(-a0)

    offs = jax.random.randint(next(ks), (BATCH, 1), 0, 1024, dtype=jnp.int32)
    positions = jnp.arange(SEQ, dtype=jnp.int32)[None, :] + offs

    return {
        "x": nrm((BATCH, SEQ, D_MODEL), 1.0),
        "mem": nrm((BATCH, N_MEM, D_MODEL), 1.0),
        "positions": positions,
        "g_mix": gain((DEPTH, D_MODEL)),
        "w_in": nrm((DEPTH, D_MODEL, IN_WIDTH), D_MODEL ** -0.5),
        "da_lq1": nrm((DEPTH, DA_HEAD_DIM), 0.1),
        "da_lk1": nrm((DEPTH, DA_HEAD_DIM), 0.1),
        "da_lq2": nrm((DEPTH, DA_HEAD_DIM), 0.1),
        "da_lk2": nrm((DEPTH, DA_HEAD_DIM), 0.1),
        "da_subln_g": gain((DEPTH, DA_V_DIM)),
        "lru_conv_w": nrm((DEPTH, CONV_WIDTH, LRU_WIDTH), CONV_WIDTH ** -0.5),
        "lru_conv_b": nrm((DEPTH, LRU_WIDTH), 0.01),
        "lru_w_r": nrm((DEPTH, 2, LRU_BLOCKS, LRU_BLOCK, LRU_BLOCK), LRU_BLOCK ** -0.5),
        "lru_b_r": nrm((DEPTH, 2, LRU_BLOCKS, LRU_BLOCK), 0.01),
        "lru_w_i": nrm((DEPTH, 2, LRU_BLOCKS, LRU_BLOCK, LRU_BLOCK), LRU_BLOCK ** -0.5),
        "lru_b_i": nrm((DEPTH, 2, LRU_BLOCKS, LRU_BLOCK), 0.01),
        "lru_a_param": lru_a_param,
        "lru_norm_g": gain((DEPTH, LRU_WIDTH)),
        "w_out": nrm((DEPTH, MIX_WIDTH, D_MODEL), MIX_WIDTH ** -0.5),
        "g_xq": gain((DEPTH, D_MODEL)),
        "g_mem": gain((DEPTH, D_MODEL)),
        "xa_wq": nrm((DEPTH, D_MODEL, D_MODEL), D_MODEL ** -0.5),
        "xa_wk": nrm((DEPTH, D_MODEL, D_MODEL), D_MODEL ** -0.5),
        "xa_wv": nrm((DEPTH, D_MODEL, D_MODEL), D_MODEL ** -0.5),
        "xa_wo": nrm((DEPTH, D_MODEL, D_MODEL), D_MODEL ** -0.5),
        "g_mlp": gain((DEPTH, D_MODEL)),
        "mlp_w1": nrm((DEPTH, D_MODEL, D_FF), D_MODEL ** -0.5),
        "mlp_w2": nrm((DEPTH, D_FF, D_MODEL), D_FF ** -0.5),
        "g_final": gain((D_MODEL,)),
    }


def reference(x, mem, positions, g_mix, w_in, da_lq1, da_lk1, da_lq2, da_lk2, da_subln_g,
              lru_conv_w, lru_conv_b, lru_w_r, lru_b_r, lru_w_i, lru_b_i, lru_a_param,
              lru_norm_g, w_out, g_xq, g_mem, xa_wq, xa_wk, xa_wv, xa_wo,
              g_mlp, mlp_w1, mlp_w2, g_final):
    B, S = x.shape[0], x.shape[1]
    M = mem.shape[1]
    cos, sin = rope_tables(positions)

    for l in range(DEPTH):
        h = rms_norm(x, g_mix[l])
        z = h @ w_in[l]
        q = z[..., :DA_WIDTH].reshape(B, S, DA_HEADS, 2, DA_HEAD_DIM)
        k = z[..., DA_WIDTH:2 * DA_WIDTH].reshape(B, S, DA_HEADS, 2, DA_HEAD_DIM)
        v = z[..., 2 * DA_WIDTH:3 * DA_WIDTH].reshape(B, S, DA_HEADS, DA_V_DIM)
        xb = z[..., 3 * DA_WIDTH:3 * DA_WIDTH + LRU_WIDTH]
        gb = z[..., 3 * DA_WIDTH + LRU_WIDTH:]

        q = partial_rope(q, cos, sin)
        k = partial_rope(k, cos, sin)
        lam_init = 0.8 - 0.6 * float(np.exp(-0.3 * l))
        lam = (jnp.exp(jnp.sum(da_lq1[l].astype(jnp.float32) * da_lk1[l].astype(jnp.float32)))
               - jnp.exp(jnp.sum(da_lq2[l].astype(jnp.float32) * da_lk2[l].astype(jnp.float32)))
               + lam_init)
        o = diff_attention(q, k, v, lam)
        o = (rms_norm(o, da_subln_g[l]) * (1.0 - lam_init)).reshape(B, S, DA_WIDTH)

        c = centred_dwconv(xb, lru_conv_w[l], lru_conv_b[l])
        h_f = rg_lru(c, lru_w_r[l, 0], lru_b_r[l, 0], lru_w_i[l, 0], lru_b_i[l, 0],
                     lru_a_param[l, 0], False)
        h_b = rg_lru(c, lru_w_r[l, 1], lru_b_r[l, 1], lru_w_i[l, 1], lru_b_i[l, 1],
                     lru_a_param[l, 1], True)
        r = rms_norm((h_f + h_b) * jax.nn.gelu(gb), lru_norm_g[l])

        x = x + jnp.concatenate([o, r], axis=-1) @ w_out[l]

        hq = rms_norm(x, g_xq[l])
        m = rms_norm(mem, g_mem[l])
        qx = (hq @ xa_wq[l]).reshape(B, S, X_HEADS, X_HEAD_DIM)
        kx = (m @ xa_wk[l]).reshape(B, M, X_HEADS, X_HEAD_DIM)
        vx = (m @ xa_wv[l]).reshape(B, M, X_HEADS, X_HEAD_DIM)
        s = jnp.einsum('bshd,bmhd->bhsm', qx, kx,
                       preferred_element_type=jnp.float32) * (X_HEAD_DIM ** -0.5)
        p = jax.nn.softmax(s, axis=-1).astype(vx.dtype)
        ox = jnp.einsum('bhsm,bmhd->bshd', p, vx).reshape(B, S, D_MODEL)
        x = x + ox @ xa_wo[l]

        hm = rms_norm(x, g_mlp[l])
        x = x + jnp.square(jax.nn.relu(hm @ mlp_w1[l])) @ mlp_w2[l]

    return rms_norm(x, g_final)
```

```cpp
#include <hip/hip_runtime.h>
#include <hip/hip_cooperative_groups.h>
#include <cstdio>
#include <cstdint>
namespace cg = cooperative_groups;
#ifndef REP_FA
#define REP_FA 1
#endif
#ifndef REP_LRUA
#define REP_LRUA 1
#endif
#ifndef REP_LRUC
#define REP_LRUC 1
#endif
#ifndef REP_PRO
#define REP_PRO 1
#endif
#ifndef REP_Q
#define REP_Q 1
#endif
#ifndef REP_SYNC
#define REP_SYNC 0
#endif
#ifndef REP_XA
#define REP_XA 1
#endif
#ifndef REP_UP
#define REP_UP 1
#endif
#ifndef REP_IN
#define REP_IN 1
#endif
__device__ __forceinline__ int opaque_tid() { int t = threadIdx.x; asm volatile("" : "+v"(t)); return t; }
namespace pg8 {
#define PG8_LAS __attribute__((address_space(3)))
typedef unsigned short bf16_t;
typedef short bf16x8 __attribute__((ext_vector_type(8)));
typedef float f32x4 __attribute__((ext_vector_type(4)));
typedef unsigned u32x4 __attribute__((ext_vector_type(4)));
constexpr int BM = 256, BK = 64, HALF = 128, HTB = HALF * BK * 2  , STAGE_BYTES = 8 * HTB, NXCD = 8, WGM = 8;

__host__ __device__ __forceinline__ int lds_byte(int r, int c) { const int st = (r >> 4) * 2 + (c >> 5), rr = r & 15, cc = c & 31, ob = rr * 64 + cc * 2; return st * 1024 + (ob ^ (((ob >> 9) & 1) << 5)); }
__host__ __device__ __forceinline__ void stage_rc(int b, int& R, int& C) { const int st = b / 1024, sb = b % 1024, swz = sb ^ (((sb >> 9) & 1) << 5); R = (st >> 1) * 16 + swz / 64; C = (st & 1) * 32 + (swz % 64) / 2; }
__host__ __device__ __forceinline__ int perm32(int rho) { const int n = rho >> 4, i = rho & 15; return 8 * (i >> 2) + 4 * n + (i & 3); }

struct Unit { int pm, pn; };
struct Gemm { const bf16_t* A; const bf16_t* Bt; int M, N, K; };

struct StaticOrder {
    int nM, nN, nwg, G, c;
    __host__ __device__ void init(int M, int N, int G_, int c_) { nM = M / BM; nN = N / BM; nwg = nM * nN; G = G_; c = c_; }
    __host__ __device__ bool next(int i, Unit& u) const {
        const long L = (long)i * G + c; if (L >= nwg) return false;
        int wgid = (int)L; { const int q = nwg / NXCD, r = nwg % NXCD, xcd = wgid % NXCD, off = wgid / NXCD; wgid = (xcd < r ? xcd * (q + 1) : r * (q + 1) + (xcd - r) * q) + off; }
        const int nig = WGM * nN, gid = wgid / nig, fm = gid * WGM, gsz = (nM - fm) < WGM ? (nM - fm) : WGM;
        u.pm = fm + ((wgid % nig) % gsz); u.pn = (wgid % nig) / gsz; return true;
    }
    __device__ __forceinline__ void a_ready(const Unit&) const {}
    __device__ __forceinline__ void done(const Unit&) const {}
};

__device__ __forceinline__ unsigned cvt_pk_bf16(float lo, float hi) { unsigned r; asm volatile("v_cvt_pk_bf16_f32 %0, %1, %2" : "=v"(r) : "v"(lo), "v"(hi)); return r; }
template <class Epi, class Sched, bool ALIGN_EPI = false, bool SP2 = false>
__device__ __forceinline__ void gemm_phase(PG8_LAS unsigned char* lds, const Gemm g, const Sched& S, const Epi& E) {
    const int tid = opaque_tid(), wid = __builtin_amdgcn_readfirstlane(tid >> 6), lane = tid & 63, wr = wid >> 2, wc = wid & 3, fr = lane & 15, fq = lane >> 4;
    const int K = g.K, nt = K / BK;
    unsigned voffA[2], voffB[2];
#pragma unroll
    for (int i = 0; i < 2; ++i) { int R, C; stage_rc(tid * 16 + i * 8192, R, C); const int Rb = Epi::PERM ? ((R & ~31) + perm32(R & 31)) : R;
        voffA[i] = (unsigned)(R * K + C) * 2u; voffB[i] = (unsigned)(Rb * K + C) * 2u; }
    const size_t kstep = (size_t)(BK * 2);
    const size_t hstep = (size_t)HALF * K * 2;
    const size_t tstep = 2 * hstep;
    const unsigned ldsw = (unsigned)wid * 1024u;
    const int aoff = lds_byte(wr * 64 + fr, fq * 8), boff = lds_byte(wc * 32 + fr, fq * 8);
#define PG8_SA(b, h) (((b) * 2 + (h)) * HTB)
#define PG8_SB(b, h) ((4 + (b) * 2 + (h)) * HTB)
#define PG8_STAGE(bufoff, gbase, voff) do { _Pragma("unroll") for (int _i = 0; _i < 2; ++_i) \
        __builtin_amdgcn_global_load_lds((const unsigned*)((const char*)(gbase) + (voff)[_i]), (PG8_LAS unsigned*)(lds + (bufoff) + ldsw + _i * 8192), 16, 0, 0); } while (0)
#define PG8_LDA(dst, b, h) do { _Pragma("unroll") for (int m = 0; m < 4; ++m) _Pragma("unroll") for (int k = 0; k < 2; ++k) dst[m][k] = *(const PG8_LAS bf16x8*)(lds + PG8_SA(b, h) + aoff + m * 2048 + k * 1024); } while (0)
#define PG8_LDB(dst, b, h) do { _Pragma("unroll") for (int n = 0; n < 2; ++n) _Pragma("unroll") for (int k = 0; k < 2; ++k) dst[n][k] = *(const PG8_LAS bf16x8*)(lds + PG8_SB(b, h) + boff + n * 2048 + k * 1024); } while (0)
#define PG8_MMA(ai, bj, At, Bt) do { __builtin_amdgcn_s_setprio(1); _Pragma("unroll") for (int m = 0; m < 4; ++m) _Pragma("unroll") for (int n = 0; n < 2; ++n) _Pragma("unroll") for (int k = 0; k < 2; ++k) \
        acc[ai][bj][m][n] = __builtin_amdgcn_mfma_f32_16x16x32_bf16(Bt[n][k], At[m][k], acc[ai][bj][m][n], 0, 0, 0); __builtin_amdgcn_s_setprio(0); } while (0)
#define PG8_WAIT_V(n) asm volatile("s_waitcnt vmcnt(" #n ")" ::: "memory")
#define PG8_WAIT_L(n) asm volatile("s_waitcnt lgkmcnt(" #n ")" ::: "memory")
#define PG8_BAR __builtin_amdgcn_s_barrier()
#define PG8_SCHED __builtin_amdgcn_sched_barrier(0)
    Unit cur, nxt; int ui = 0;
    if (!S.next(0, cur)) return;
    f32x4 acc[2][2][4][2];
#pragma unroll
    for (int a = 0; a < 2; ++a)
#pragma unroll
        for (int b = 0; b < 2; ++b)
#pragma unroll
            for (int m = 0; m < 4; ++m)
#pragma unroll
                for (int n = 0; n < 2; ++n) acc[a][b][m][n] = (f32x4){0.f, 0.f, 0.f, 0.f};
    bf16x8 At[4][2], B0[2][2], B1[2][2];
    const char* cA = (const char*)g.A + (size_t)cur.pm * tstep; const char* cB = (const char*)g.Bt + (size_t)cur.pn * tstep;
    S.a_ready(cur);
    if constexpr (SP2) {
        PG8_STAGE(PG8_SB(0, 0), cB, voffB); PG8_STAGE(PG8_SB(0, 1), cB + hstep, voffB); PG8_STAGE(PG8_SA(0, 0), cA, voffA); PG8_STAGE(PG8_SA(0, 1), cA + hstep, voffA);
        if (wr == 1) PG8_BAR;
        PG8_WAIT_V(2); PG8_BAR;
        PG8_STAGE(PG8_SB(1, 0), cB + kstep, voffB); PG8_STAGE(PG8_SA(1, 0), cA + kstep, voffA); PG8_STAGE(PG8_SB(1, 1), cB + hstep + kstep, voffB);
        PG8_WAIT_V(6); PG8_BAR;
    } else {
        PG8_STAGE(PG8_SB(0, 0), cB, voffB); PG8_STAGE(PG8_SA(0, 0), cA, voffA); PG8_STAGE(PG8_SB(0, 1), cB + hstep, voffB); PG8_STAGE(PG8_SA(0, 1), cA + hstep, voffA);
        if (wr == 1) PG8_BAR;
        PG8_WAIT_V(4); PG8_BAR;
        PG8_STAGE(PG8_SB(1, 0), cB + kstep, voffB); PG8_STAGE(PG8_SA(1, 0), cA + kstep, voffA); PG8_STAGE(PG8_SB(1, 1), cB + hstep + kstep, voffB);
        PG8_WAIT_V(6); PG8_BAR;
    }
    for (;;) {
        const bool has_next = S.next(ui + 1, nxt);
        const char* nA = has_next ? (const char*)g.A + (size_t)nxt.pm * tstep : cA; const char* nB = has_next ? (const char*)g.Bt + (size_t)nxt.pn * tstep : cB;
        for (int t = 0; t < nt; t += 2) {
            const bool last = (t == nt - 2);
            const char* a1 = cA + (size_t)(t + 1) * kstep;
            const char* a2 = last ? nA : cA + (size_t)(t + 2) * kstep; const char* b2 = last ? nB : cB + (size_t)(t + 2) * kstep;
            const char* a3 = a2 + kstep; const char* b3 = b2 + kstep;
            if (last && has_next) S.a_ready(nxt);
            if constexpr (SP2) {
            PG8_LDB(B0, 0, 0); PG8_LDB(B1, 0, 1); PG8_SCHED; PG8_LDA(At, 0, 0); PG8_STAGE(PG8_SA(1, 1), a1 + hstep, voffA);
            PG8_WAIT_V(8); PG8_WAIT_L(0); PG8_BAR; PG8_MMA(0, 0, At, B0); PG8_MMA(0, 1, At, B1); PG8_BAR; PG8_SCHED;
            PG8_LDA(At, 0, 1); PG8_STAGE(PG8_SB(0, 0), b2, voffB); PG8_STAGE(PG8_SB(0, 1), b2 + hstep, voffB); PG8_STAGE(PG8_SA(0, 0), a2, voffA);
            PG8_WAIT_V(8); PG8_WAIT_L(0); PG8_BAR; PG8_MMA(1, 0, At, B0); PG8_MMA(1, 1, At, B1); PG8_BAR; PG8_SCHED;
            PG8_LDB(B0, 1, 0); PG8_LDB(B1, 1, 1); PG8_SCHED; PG8_LDA(At, 1, 0); PG8_STAGE(PG8_SA(0, 1), a2 + hstep, voffA);
            PG8_WAIT_V(8); PG8_WAIT_L(0); PG8_BAR; PG8_MMA(0, 0, At, B0); PG8_MMA(0, 1, At, B1); PG8_BAR; PG8_SCHED;
            PG8_LDA(At, 1, 1); PG8_STAGE(PG8_SB(1, 0), b3, voffB); PG8_STAGE(PG8_SB(1, 1), b3 + hstep, voffB); PG8_STAGE(PG8_SA(1, 0), a3, voffA);
            PG8_WAIT_V(8); PG8_WAIT_L(0); PG8_BAR; PG8_MMA(1, 0, At, B0); PG8_MMA(1, 1, At, B1); PG8_BAR; PG8_SCHED;
            } else {
            PG8_LDB(B0, 0, 0); PG8_SCHED; PG8_LDA(At, 0, 0); PG8_STAGE(PG8_SA(1, 1), a1 + hstep, voffA);
            PG8_WAIT_L(8); PG8_BAR; PG8_WAIT_L(0); PG8_MMA(0, 0, At, B0); PG8_BAR; PG8_SCHED;
            PG8_LDB(B1, 0, 1); PG8_STAGE(PG8_SB(0, 0), b2, voffB);
            PG8_BAR; PG8_WAIT_L(0); PG8_MMA(0, 1, At, B1); PG8_BAR;
            PG8_LDA(At, 0, 1); PG8_STAGE(PG8_SA(0, 0), a2, voffA);
            PG8_BAR; PG8_WAIT_L(0); PG8_MMA(1, 0, At, B0); PG8_BAR; PG8_SCHED;
            PG8_STAGE(PG8_SB(0, 1), b2 + hstep, voffB);
            PG8_WAIT_V(6); PG8_BAR; PG8_MMA(1, 1, At, B1); PG8_BAR;
            PG8_LDB(B0, 1, 0); PG8_SCHED; PG8_LDA(At, 1, 0); PG8_STAGE(PG8_SA(0, 1), a2 + hstep, voffA);
            PG8_WAIT_L(8); PG8_BAR; PG8_WAIT_L(0); PG8_MMA(0, 0, At, B0); PG8_BAR; PG8_SCHED;
            PG8_LDB(B1, 1, 1); PG8_STAGE(PG8_SB(1, 0), b3, voffB);
            PG8_BAR; PG8_WAIT_L(0); PG8_MMA(0, 1, At, B1); PG8_BAR;
            PG8_LDA(At, 1, 1); PG8_STAGE(PG8_SA(1, 0), a3, voffA);
            PG8_BAR; PG8_WAIT_L(0); PG8_MMA(1, 0, At, B0); PG8_BAR; PG8_SCHED;
            PG8_STAGE(PG8_SB(1, 1), b3 + hstep, voffB);
            PG8_WAIT_V(6); PG8_BAR; PG8_MMA(1, 1, At, B1); PG8_BAR;
            }
        }
        if constexpr (ALIGN_EPI) { if (wr == 0) PG8_BAR; }
        if constexpr (!Epi::AFTER_DRAIN) { E(acc, cur, wr, wc, fr, fq); S.done(cur); }
        if (!has_next) break;
#pragma unroll
        for (int a = 0; a < 2; ++a)
#pragma unroll
            for (int b = 0; b < 2; ++b)
#pragma unroll
                for (int m = 0; m < 4; ++m)
#pragma unroll
                    for (int n = 0; n < 2; ++n) acc[a][b][m][n] = (f32x4){0.f, 0.f, 0.f, 0.f};
        cur = nxt; cA = nA; cB = nB; ++ui;
        if constexpr (ALIGN_EPI) { if (wr == 1) PG8_BAR; }
    }
    PG8_WAIT_V(0);
    if constexpr (!ALIGN_EPI) { if (wr == 0) PG8_BAR; }
    PG8_BAR;
    if constexpr (Epi::AFTER_DRAIN) { E.fused(acc, cur, wr, wc, fr, fq, lds, wid, lane); S.done(cur); }
#undef PG8_SA
#undef PG8_SB
#undef PG8_STAGE
#undef PG8_LDA
#undef PG8_LDB
#undef PG8_MMA
#undef PG8_WAIT_V
#undef PG8_WAIT_L
#undef PG8_BAR
#undef PG8_SCHED
}
}
namespace pg8 {
typedef unsigned u32x4e __attribute__((ext_vector_type(4)));
template <int MODE> struct EpiScale {
    static constexpr bool PERM = true, AFTER_DRAIN = false;
    bf16_t* O; int ldc; const float* rss; float cs; const float* rope;
    __device__ __forceinline__ void operator()(const f32x4 (&acc)[2][2][4][2], const Unit& u, int wr, int wc, int fr, int fq) const {
        const int row0 = u.pm * BM + wr * 64 + fr, col0 = u.pn * BM + wc * 32 + 8 * fq;
        const bool ropew = (MODE == 1) && (u.pn < 4) && ((wc & 1) == 0);
#pragma unroll
        for (int ai = 0; ai < 2; ++ai)
#pragma unroll
            for (int m = 0; m < 4; ++m) {
                const int row = row0 + ai * HALF + m * 16;
                float rs = 1.f;
                if (MODE != 0) { const f32x4 q0 = *((const f32x4*)(rss + (size_t)row * 16) + fq);
                    float sq = (q0[0] + q0[1]) + (q0[2] + q0[3]); sq += __shfl_xor(sq, 16); sq += __shfl_xor(sq, 32);
                    rs = rsqrtf(sq * (1.f / 1024.f) + 1e-6f); }
                if (MODE == 2) rs *= cs;
                f32x4 cv0 = {1.f, 1.f, 1.f, 1.f}, cv1 = cv0, sv0 = {0.f, 0.f, 0.f, 0.f}, sv1 = sv0;
                if (ropew) { const float* rp = rope + (size_t)row * 16; cv0 = *(const f32x4*)rp; cv1 = *(const f32x4*)(rp + 4); sv0 = *(const f32x4*)(rp + 8); sv1 = *(const f32x4*)(rp + 12); }
#pragma unroll
                for (int bj = 0; bj < 2; ++bj) {
                    f32x4 v0 = acc[ai][bj][m][0] * rs, v1 = acc[ai][bj][m][1] * rs;
                    if (MODE == 1) {
                        if (ropew) {
                            f32x4 o0, o1;
#pragma unroll
                            for (int j = 0; j < 4; ++j) { o0[j] = __shfl_xor(v0[j], 16); o1[j] = __shfl_xor(v1[j], 16); }
                            if (fq == 0) { v0 = v0 * cv0 - o0 * sv0; v1 = v1 * cv1 - o1 * sv1; }
                            else if (fq == 1) { v0 = v0 * cv0 + o0 * sv0; v1 = v1 * cv1 + o1 * sv1; }
                        }
                        if (u.pn < 2) { v0 = v0 * cs; v1 = v1 * cs; }
                    }
                    if (MODE == 3) {
#pragma unroll
                        for (int j = 0; j < 4; ++j) { const float a = fmaxf(v0[j], 0.f), b = fmaxf(v1[j], 0.f); v0[j] = a * a; v1[j] = b * b; }
                    }
                    u32x4e w; w.x = cvt_pk_bf16(v0[0], v0[1]); w.y = cvt_pk_bf16(v0[2], v0[3]); w.z = cvt_pk_bf16(v1[0], v1[1]); w.w = cvt_pk_bf16(v1[2], v1[3]);
                    *(u32x4e*)(O + (size_t)row * ldc + col0 + bj * HALF) = w;
                }
            }
    }
};
template <bool F32BASE> struct EpiRes {
    static constexpr bool PERM = true, AFTER_DRAIN = false;
    const float* basef; bf16_t* xb; float* rss;
    __device__ __forceinline__ void operator()(const f32x4 (&acc)[2][2][4][2], const Unit& u, int wr, int wc, int fr, int fq) const {
        const int row0 = u.pm * BM + wr * 64 + fr, col0 = u.pn * BM + wc * 32 + 8 * fq;
#pragma unroll
        for (int ai = 0; ai < 2; ++ai)
#pragma unroll
            for (int m = 0; m < 4; ++m) {
                const int row = row0 + ai * HALF + m * 16; float ss = 0.f;
#pragma unroll
                for (int bj = 0; bj < 2; ++bj) {
                    const size_t off = (size_t)row * 1024 + col0 + bj * HALF;
                    f32x4 b0, b1;
                    if (F32BASE) { b0 = *(const f32x4*)(basef + off); b1 = *(const f32x4*)(basef + off + 4); }
                    else { const u32x4e q = *(const u32x4e*)(xb + off);
                        b0 = (f32x4){__uint_as_float(q.x << 16), __uint_as_float(q.x & 0xffff0000u), __uint_as_float(q.y << 16), __uint_as_float(q.y & 0xffff0000u)};
                        b1 = (f32x4){__uint_as_float(q.z << 16), __uint_as_float(q.z & 0xffff0000u), __uint_as_float(q.w << 16), __uint_as_float(q.w & 0xffff0000u)}; }
                    const f32x4 v0 = acc[ai][bj][m][0] + b0, v1 = acc[ai][bj][m][1] + b1;
                    u32x4e w; w.x = cvt_pk_bf16(v0[0], v0[1]); w.y = cvt_pk_bf16(v0[2], v0[3]); w.z = cvt_pk_bf16(v1[0], v1[1]); w.w = cvt_pk_bf16(v1[2], v1[3]);
                    *(u32x4e*)(xb + off) = w;
                    ss += (v0[0] * v0[0] + v0[1] * v0[1]) + (v0[2] * v0[2] + v0[3] * v0[3]) + (v1[0] * v1[0] + v1[1] * v1[1]) + (v1[2] * v1[2] + v1[3] * v1[3]);
                }
                ss += __shfl_xor(ss, 16); ss += __shfl_xor(ss, 32);
                if (fq == 0) rss[(size_t)row * 16 + u.pn * 4 + wc] = ss;
            }
    }
};
}
namespace fa {
typedef unsigned short bf16_t;
using bf16x8 = __attribute__((ext_vector_type(8))) short;
using s16x4  = __attribute__((ext_vector_type(4))) short;
using f32x16 = __attribute__((ext_vector_type(16))) float;
using u32x4  = __attribute__((ext_vector_type(4))) unsigned;
#define FA_SBAR() __builtin_amdgcn_sched_barrier(0)
__device__ __forceinline__ int crow(int r, int hi) { return (r & 3) + 8 * (r >> 2) + 4 * hi; }
__device__ __forceinline__ unsigned cvtpk(float lo, float hi) { unsigned r; asm volatile("v_cvt_pk_bf16_f32 %0, %1, %2" : "=v"(r) : "v"(lo), "v"(hi)); return r; }
__device__ __forceinline__ int v_st(int k, int c) { const int kk = (k & ~0xC) | ((k & 4) << 1) | ((k & 8) >> 1); return ((kk >> 3) * 4 + (c >> 5)) * 512 + ((kk & 7) * 32 + (c & 31)) * 2; }
__device__ __forceinline__ int v_rd_base(int lane) { return ((lane & 3) << 3) | (((lane >> 2) & 3) << 6) | (((lane >> 4) & 1) << 5) | (((lane >> 5) & 1) << 8); }
constexpr int v_rd_off(int d0, int ks, int half) { return d0 * 512 + ks * 4096 + half * 2048; }
template <int OFF> __device__ __forceinline__ s16x4 tr_read(int vb) { s16x4 r; asm volatile("ds_read_b64_tr_b16 %0, %1 offset:%2" : "=&v"(r) : "v"(vb), "i"(OFF) : "memory"); return r; }
template <int D0> __device__ __forceinline__ void pv_one(f32x16& od, int vb, bf16x8 pa0, bf16x8 pa1, bf16x8 pa2, bf16x8 pa3) {
  const s16x4 l0 = tr_read<v_rd_off(D0, 0, 0)>(vb), h0 = tr_read<v_rd_off(D0, 0, 1)>(vb), l1 = tr_read<v_rd_off(D0, 1, 0)>(vb), h1 = tr_read<v_rd_off(D0, 1, 1)>(vb);
  const s16x4 l2 = tr_read<v_rd_off(D0, 2, 0)>(vb), h2 = tr_read<v_rd_off(D0, 2, 1)>(vb), l3 = tr_read<v_rd_off(D0, 3, 0)>(vb), h3 = tr_read<v_rd_off(D0, 3, 1)>(vb);
  asm volatile("s_waitcnt lgkmcnt(0)" ::: "memory"); FA_SBAR();
#define FA_PK(L, H) (bf16x8){L[0], L[1], L[2], L[3], H[0], H[1], H[2], H[3]}
  od = __builtin_amdgcn_mfma_f32_32x32x16_bf16(pa0, FA_PK(l0, h0), od, 0, 0, 0);
  od = __builtin_amdgcn_mfma_f32_32x32x16_bf16(pa1, FA_PK(l1, h1), od, 0, 0, 0);
  od = __builtin_amdgcn_mfma_f32_32x32x16_bf16(pa2, FA_PK(l2, h2), od, 0, 0, 0);
  od = __builtin_amdgcn_mfma_f32_32x32x16_bf16(pa3, FA_PK(l3, h3), od, 0, 0, 0);
#undef FA_PK
}
__device__ __forceinline__ void pv_d0(f32x16* o, int vb, bf16x8 pa0, bf16x8 pa1, bf16x8 pa2, bf16x8 pa3) {
  pv_one<0>(o[0], vb, pa0, pa1, pa2, pa3); pv_one<1>(o[1], vb, pa0, pa1, pa2, pa3); pv_one<2>(o[2], vb, pa0, pa1, pa2, pa3); pv_one<3>(o[3], vb, pa0, pa1, pa2, pa3);
}
template <int DQK, bool QREG> __device__ __forceinline__ void qkt(f32x16& p0, f32x16& p1, const char* Ks, const bf16x8* qr, const bf16_t* qsrc, int r32, int hi) {
  constexpr int KROWB = DQK * 2;
  p0 = f32x16{}; p1 = f32x16{};
  if constexpr (QREG) {
#pragma unroll
    for (int d0 = 0; d0 < DQK / 16; ++d0) { const int cb = (d0 * 16 + hi * 8) * 2;
      const int sw = (DQK == 64) ? (((r32 >> 1) & 7) << 4) : ((r32 & 7) << 4);
      const bf16x8 b0 = *reinterpret_cast<const bf16x8*>(Ks + r32 * KROWB + (cb ^ sw));
      const bf16x8 b1 = *reinterpret_cast<const bf16x8*>(Ks + (32 + r32) * KROWB + (cb ^ sw));
      p0 = __builtin_amdgcn_mfma_f32_32x32x16_bf16(b0, qr[d0], p0, 0, 0, 0);
      p1 = __builtin_amdgcn_mfma_f32_32x32x16_bf16(b1, qr[d0], p1, 0, 0, 0); }
  } else {
    typedef __attribute__((address_space(1))) const bf16x8 gq_t;
#pragma unroll
    for (int g = 0; g < DQK / 128; ++g) { bf16x8 qv[8];
#pragma unroll
      for (int i = 0; i < 8; ++i) qv[i] = *(gq_t*)(qsrc + (g * 8 + i) * 16);
#pragma unroll
      for (int i = 0; i < 8; ++i) { const int d0 = g * 8 + i, cb = (d0 * 16 + hi * 8) * 2;
        const bf16x8 b0 = *reinterpret_cast<const bf16x8*>(Ks + r32 * KROWB + (cb ^ ((r32 & 7) << 4)));
        const bf16x8 b1 = *reinterpret_cast<const bf16x8*>(Ks + (32 + r32) * KROWB + (cb ^ ((r32 & 7) << 4)));
        p0 = __builtin_amdgcn_mfma_f32_32x32x16_bf16(b0, qv[i], p0, 0, 0, 0);
        p1 = __builtin_amdgcn_mfma_f32_32x32x16_bf16(b1, qv[i], p1, 0, 0, 0); } }
  }
}
__device__ __forceinline__ void softmax_tile(f32x16& p0, f32x16& p1, float& m_reg, float& l_reg, float& alpha, bf16x8& pa0, bf16x8& pa1, bf16x8& pa2, bf16x8& pa3) {
  float pmax = p0[0];
#pragma unroll
  for (int r = 1; r < 16; ++r) pmax = fmaxf(pmax, p0[r]);
#pragma unroll
  for (int r = 0; r < 16; ++r) pmax = fmaxf(pmax, p1[r]);
  { auto rr = __builtin_amdgcn_permlane32_swap(__float_as_uint(pmax), __float_as_uint(pmax), false, false); pmax = fmaxf(__uint_as_float(rr[0]), __uint_as_float(rr[1])); }
  if (__builtin_expect(__all(pmax - m_reg <= 8.f), 1)) { alpha = 1.f; }
  else { const float mn = fmaxf(m_reg, pmax); alpha = __builtin_amdgcn_exp2f(m_reg - mn); m_reg = mn; }
  const float mneg = -m_reg;
#pragma unroll
  for (int r = 0; r < 16; ++r) { p0[r] = __builtin_amdgcn_exp2f(p0[r] + mneg); p1[r] = __builtin_amdgcn_exp2f(p1[r] + mneg); }
  float ps = 0.f;
#pragma unroll
  for (int r = 0; r < 16; ++r) ps += p0[r];
#pragma unroll
  for (int r = 0; r < 16; ++r) ps += p1[r];
  { auto rr = __builtin_amdgcn_permlane32_swap(__float_as_uint(ps), __float_as_uint(ps), false, false); ps = __uint_as_float(rr[0]) + __uint_as_float(rr[1]); }
  l_reg = l_reg * alpha + ps;
#define FA_PK4(P, BASE, OUT) do { unsigned a0 = cvtpk(P[BASE + 0], P[BASE + 1]), a1 = cvtpk(P[BASE + 2], P[BASE + 3]);   \
    unsigned b0 = cvtpk(P[BASE + 4], P[BASE + 5]), b1 = cvtpk(P[BASE + 6], P[BASE + 7]);                              \
    auto r0 = __builtin_amdgcn_permlane32_swap(a0, b0, false, false); auto r1 = __builtin_amdgcn_permlane32_swap(a1, b1, false, false); \
    u32x4 w = {r0[0], r1[0], r0[1], r1[1]}; OUT = *reinterpret_cast<bf16x8*>(&w); } while (0)
  FA_PK4(p0, 0, pa0); FA_PK4(p0, 8, pa1); FA_PK4(p1, 0, pa2); FA_PK4(p1, 8, pa3);
#undef FA_PK4
}
template <int DQK>
__device__ __forceinline__ void flash_unit(const bf16_t* __restrict__ Qb, int ldq, const bf16_t* __restrict__ Kh, int ldk,
                                           const bf16_t* __restrict__ Vh, int ldv, bf16_t* __restrict__ Ob, int ldo, int nkeys, char* lds) {
  constexpr int KROWB = DQK * 2, SHM_K = 64 * KROWB, SHM_V = 16384, ND = DQK / 16, NKL = DQK / 64, CPR = DQK / 8;
  const int tid = opaque_tid(), wid = tid >> 6, lane = tid & 63, r32 = lane & 31, hi = lane >> 5;
  char* V_lds = lds; char* K_lds = lds + 2 * SHM_V;
  float* ws = (float*)(lds + 2 * SHM_V + 2 * SHM_K) + wid * 64; float* li_l = ws; float* al_l = ws + 32;
  constexpr bool QREG = (DQK <= 64);
  float m_reg = -1e30f, l_reg = 0.f; f32x16 o[4] = {}; bf16x8 qr[QREG ? ND : 1];
  const bf16_t* Qw = Qb + (long)(wid * 32 + r32) * ldq + hi * 8;
#pragma unroll
  for (int d0 = 0; d0 < (QREG ? ND : 1); ++d0) qr[d0] = *reinterpret_cast<const bf16x8*>(Qw + d0 * 16);
  const int vr = tid >> 4, vc = (tid & 15) * 8, vst0 = v_st(vr, vc), vst1 = v_st(32 + vr, vc);
  const int vb0 = (int)(uintptr_t)V_lds + v_rd_base(lane);
  bf16x8 vs0, vs1, ksg[NKL];
#define FA_SLOAD(k0) do { vs0 = *reinterpret_cast<const bf16x8*>(Vh + (long)((k0) + vr) * ldv + vc); vs1 = *reinterpret_cast<const bf16x8*>(Vh + (long)((k0) + 32 + vr) * ldv + vc); \
    _Pragma("unroll") for (int i_ = 0; i_ < NKL; ++i_) { const int q_ = tid + 512 * i_, row_ = q_ / CPR, ch_ = q_ % CPR; ksg[i_] = *reinterpret_cast<const bf16x8*>(Kh + (long)((k0) + row_) * ldk + ch_ * 8); } } while (0)
#define FA_SWRITE(b) do { *(bf16x8*)(V_lds + (b) * SHM_V + vst0) = vs0; *(bf16x8*)(V_lds + (b) * SHM_V + vst1) = vs1; \
    _Pragma("unroll") for (int i_ = 0; i_ < NKL; ++i_) { const int q_ = tid + 512 * i_, row_ = q_ / CPR, ch_ = q_ % CPR; \
      *(bf16x8*)(K_lds + (b) * SHM_K + row_ * KROWB + ((ch_ * 16) ^ ((DQK == 64 ? ((row_ >> 1) & 7) : (row_ & 7)) << 4))) = ksg[i_]; } } while (0)
#define FA_RESC(a) do { if (__any((a) < 1.f)) { if (hi == 0) al_l[r32] = (a); asm volatile("s_waitcnt lgkmcnt(0)" ::: "memory"); \
    _Pragma("unroll") for (int d_ = 0; d_ < 4; ++d_) _Pragma("unroll") for (int r_ = 0; r_ < 16; ++r_) o[d_][r_] *= al_l[crow(r_, hi)]; } } while (0)
#define FA_TILE(b) do { f32x16 p0, p1; float alpha; bf16x8 pa0, pa1, pa2, pa3; \
    const bf16_t* qs_ = Qw; asm volatile("" : "+v"(qs_)); qkt<DQK, QREG>(p0, p1, K_lds + (b) * SHM_K, qr, qs_, r32, hi); softmax_tile(p0, p1, m_reg, l_reg, alpha, pa0, pa1, pa2, pa3); FA_RESC(alpha); \
    pv_d0(o, vb0 + (b) * SHM_V, pa0, pa1, pa2, pa3); } while (0)
  const int NT = nkeys / 64;
  FA_SLOAD(0); FA_SWRITE(0); __syncthreads();
  for (int j = 0; j < NT; j += 2) {
    FA_SLOAD((j + 1) * 64);
    FA_TILE(0);
    FA_SWRITE(1); __syncthreads();
    if (j + 2 < NT) FA_SLOAD((j + 2) * 64);
    FA_TILE(1);
    if (j + 2 < NT) FA_SWRITE(0);
    __syncthreads();
  }
  if (hi == 0) li_l[r32] = l_reg; asm volatile("s_waitcnt lgkmcnt(0)" ::: "memory");
  float rli[16];
#pragma unroll
  for (int r = 0; r < 16; ++r) rli[r] = __builtin_amdgcn_rcpf(li_l[crow(r, hi)]);
  bf16_t* Ow = Ob + (long)(wid * 32) * ldo;
#pragma unroll
  for (int r = 0; r < 16; ++r) { const int orow = crow(r, hi);
#pragma unroll
    for (int d0 = 0; d0 < 4; ++d0) { const float v = o[d0][r] * rli[r]; Ow[(long)orow * ldo + d0 * 32 + r32] = (bf16_t)(cvtpk(v, v) & 0xffffu); } }
  __syncthreads();
#undef FA_SLOAD
#undef FA_SWRITE
#undef FA_RESC
#undef FA_TILE
}

__device__ __forceinline__ void partialSM(f32x16& p0, f32x16& p1, float& m_reg, float& alpha) {
  float pmax = p0[0];
#pragma unroll
  for (int r = 1; r < 16; ++r) pmax = fmaxf(pmax, p0[r]);
#pragma unroll
  for (int r = 0; r < 16; ++r) pmax = fmaxf(pmax, p1[r]);
  { auto rr = __builtin_amdgcn_permlane32_swap(__float_as_uint(pmax), __float_as_uint(pmax), false, false); pmax = fmaxf(__uint_as_float(rr[0]), __uint_as_float(rr[1])); }
  if (__builtin_expect(__all(pmax - m_reg <= 8.f), 1)) { alpha = 1.f; }
  else { const float mn = fmaxf(m_reg, pmax); alpha = __builtin_amdgcn_exp2f(m_reg - mn); m_reg = mn; }
  const float mneg = -m_reg;
#pragma unroll
  for (int r = 0; r < 16; ++r) { p0[r] += mneg; p1[r] += mneg; }
#pragma unroll
  for (int r = 0; r < 16; ++r) p0[r] = __builtin_amdgcn_exp2f(p0[r]);
}
__device__ __forceinline__ void finishSM(f32x16& p0, f32x16& p1, float alpha, float& l_reg, bf16x8& pa0, bf16x8& pa1, bf16x8& pa2, bf16x8& pa3) {
#pragma unroll
  for (int r = 0; r < 16; ++r) p1[r] = __builtin_amdgcn_exp2f(p1[r]);
  float ps = 0.f;
#pragma unroll
  for (int r = 0; r < 16; ++r) ps += p0[r];
#pragma unroll
  for (int r = 0; r < 16; ++r) ps += p1[r];
  { auto rr = __builtin_amdgcn_permlane32_swap(__float_as_uint(ps), __float_as_uint(ps), false, false); ps = __uint_as_float(rr[0]) + __uint_as_float(rr[1]); }
  l_reg = l_reg * alpha + ps;
#define FA_PK4(P, BASE, OUT) do { unsigned a0 = cvtpk(P[BASE + 0], P[BASE + 1]), a1 = cvtpk(P[BASE + 2], P[BASE + 3]);   \
    unsigned b0 = cvtpk(P[BASE + 4], P[BASE + 5]), b1 = cvtpk(P[BASE + 6], P[BASE + 7]);                              \
    auto r0 = __builtin_amdgcn_permlane32_swap(a0, b0, false, false); auto r1 = __builtin_amdgcn_permlane32_swap(a1, b1, false, false); \
    u32x4 w = {r0[0], r1[0], r0[1], r1[1]}; OUT = *reinterpret_cast<bf16x8*>(&w); } while (0)
  FA_PK4(p0, 0, pa0); FA_PK4(p0, 8, pa1); FA_PK4(p1, 0, pa2); FA_PK4(p1, 8, pa3);
#undef FA_PK4
}
__device__ __forceinline__ void flash_unit64(const bf16_t* __restrict__ Qb, int ldq, const bf16_t* __restrict__ Kh, int ldk,
                                             const bf16_t* __restrict__ Vh, int ldv, bf16_t* __restrict__ Ob, int ldo, int nkeys, char* lds) {
  constexpr int DQK = 64, KROWB = 128, SHM_K = 8192, SHM_V = 16384;
  const int tid = opaque_tid(), wid = tid >> 6, lane = tid & 63, r32 = lane & 31, hi = lane >> 5;
  char* V_lds = lds; char* K_lds = lds + 2 * SHM_V;
  float* ws = (float*)(lds + 2 * SHM_V + 2 * SHM_K) + wid * 64; float* li_l = ws; float* al_l = ws + 32;
  float m_reg = -1e30f, l_reg = 0.f; f32x16 o[4] = {}; bf16x8 qr[4];
  const bf16_t* Qw = Qb + (long)(wid * 32 + r32) * ldq + hi * 8;
#pragma unroll
  for (int d0 = 0; d0 < 4; ++d0) qr[d0] = *reinterpret_cast<const bf16x8*>(Qw + d0 * 16);
  const int vr = tid >> 4, vc = (tid & 15) * 8, vst0 = v_st(vr, vc), vst1 = v_st(32 + vr, vc);
  const int kr = tid >> 3, kc = tid & 7, kst = kr * KROWB + ((kc * 16) ^ (((kr >> 1) & 7) << 4));
  const int vb0 = (int)(uintptr_t)V_lds + v_rd_base(lane);
  bf16x8 vsA0, vsA1, ksA, vsB0, vsB1, ksB;
#define F2_SLOAD(S, k0) do { vs##S##0 = *reinterpret_cast<const bf16x8*>(Vh + (long)((k0) + vr) * ldv + vc); vs##S##1 = *reinterpret_cast<const bf16x8*>(Vh + (long)((k0) + 32 + vr) * ldv + vc); \
    ks##S = *reinterpret_cast<const bf16x8*>(Kh + (long)((k0) + kr) * ldk + kc * 8); } while (0)
#define F2_SWRITE(b, S) do { *(bf16x8*)(V_lds + (b) * SHM_V + vst0) = vs##S##0; *(bf16x8*)(V_lds + (b) * SHM_V + vst1) = vs##S##1; *(bf16x8*)(K_lds + (b) * SHM_K + kst) = ks##S; } while (0)
#define F2_RESC(a) do { if (__any((a) < 1.f)) { if (hi == 0) al_l[r32] = (a); asm volatile("s_waitcnt lgkmcnt(0)" ::: "memory"); \
    _Pragma("unroll") for (int d_ = 0; d_ < 4; ++d_) _Pragma("unroll") for (int r_ = 0; r_ < 16; ++r_) o[d_][r_] *= al_l[crow(r_, hi)]; } } while (0)
  f32x16 pA0, pA1, pB0, pB1; float alA, alB; bf16x8 pa0, pa1, pa2, pa3; const int NT = nkeys / 64;
  F2_SLOAD(A, 0); F2_SWRITE(0, A); __syncthreads();
  qkt<DQK, true>(pA0, pA1, K_lds, qr, nullptr, r32, hi); partialSM(pA0, pA1, m_reg, alA);
  F2_SLOAD(B, 64); if (2 < NT) F2_SLOAD(A, 128);
  F2_SWRITE(1, B); __syncthreads();
  for (int j = 1; j + 1 < NT; j += 2) {
    FA_SBAR(); qkt<DQK, true>(pB0, pB1, K_lds + SHM_K, qr, nullptr, r32, hi);
    finishSM(pA0, pA1, alA, l_reg, pa0, pa1, pa2, pa3); FA_SBAR();
    F2_SLOAD(B, (j + 2) * 64); FA_SBAR();
    pv_d0(o, vb0, pa0, pa1, pa2, pa3); partialSM(pB0, pB1, m_reg, alB);
    __syncthreads(); F2_SWRITE(0, A);
    F2_RESC(alB); __syncthreads();
    FA_SBAR(); qkt<DQK, true>(pA0, pA1, K_lds, qr, nullptr, r32, hi);
    finishSM(pB0, pB1, alB, l_reg, pa0, pa1, pa2, pa3); FA_SBAR();
    if (j + 3 < NT) F2_SLOAD(A, (j + 3) * 64);
    FA_SBAR();
    pv_d0(o, vb0 + SHM_V, pa0, pa1, pa2, pa3); partialSM(pA0, pA1, m_reg, alA);
    __syncthreads(); F2_SWRITE(1, B);
    F2_RESC(alA); __syncthreads();
  }
  FA_SBAR(); qkt<DQK, true>(pB0, pB1, K_lds + SHM_K, qr, nullptr, r32, hi);
  finishSM(pA0, pA1, alA, l_reg, pa0, pa1, pa2, pa3); FA_SBAR();
  pv_d0(o, vb0, pa0, pa1, pa2, pa3); partialSM(pB0, pB1, m_reg, alB);
  __syncthreads(); F2_RESC(alB);
  finishSM(pB0, pB1, alB, l_reg, pa0, pa1, pa2, pa3); FA_SBAR();
  pv_d0(o, vb0 + SHM_V, pa0, pa1, pa2, pa3);
  if (hi == 0) li_l[r32] = l_reg; asm volatile("s_waitcnt lgkmcnt(0)" ::: "memory");
  float rli[16];
#pragma unroll
  for (int r = 0; r < 16; ++r) rli[r] = __builtin_amdgcn_rcpf(li_l[crow(r, hi)]);
  bf16_t* Ow = Ob + (long)(wid * 32) * ldo;
#pragma unroll
  for (int r = 0; r < 16; ++r) { const int orow = crow(r, hi);
#pragma unroll
    for (int d0 = 0; d0 < 4; ++d0) { const float v = o[d0][r] * rli[r]; Ow[(long)orow * ldo + d0 * 32 + r32] = (bf16_t)(cvtpk(v, v) & 0xffffu); } }
  __syncthreads();
#undef F2_SLOAD
#undef F2_SWRITE
#undef F2_RESC
}

__device__ __forceinline__ void xattn_unit(const bf16_t* __restrict__ Qb, const bf16_t* __restrict__ Kh, const bf16_t* __restrict__ Vh, bf16_t* __restrict__ Ob, char* lds) {
  const int tid = opaque_tid(), wid = __builtin_amdgcn_readfirstlane(tid >> 6), lane = tid & 63, r32 = lane & 31, hi = lane >> 5;
  float* li_l = (float*)(lds + 131072 + 256) + wid * 32;
  { bf16x8 st[16];
#pragma unroll
    for (int i = 0; i < 16; ++i) { const int q = tid + 512 * i, row = q >> 5, ch = q & 31; st[i] = *reinterpret_cast<const bf16x8*>(Kh + (long)row * 2048 + ch * 8); }
#pragma unroll
    for (int i = 0; i < 16; ++i) { const int q = tid + 512 * i, row = q >> 5, ch = q & 31; *(bf16x8*)(lds + row * 512 + ((ch * 16) ^ ((row & 15) << 4))) = st[i]; } }
  __syncthreads();
  f32x16 S[8];
#pragma unroll
  for (int kb = 0; kb < 8; ++kb) S[kb] = f32x16{};
  const bf16_t* Qw = Qb + (long)(wid * 32 + r32) * 1024 + hi * 8;
#pragma unroll
  for (int g = 0; g < 2; ++g) { bf16x8 qv[8];
#pragma unroll
    for (int i = 0; i < 8; ++i) qv[i] = *reinterpret_cast<const bf16x8*>(Qw + (g * 8 + i) * 16);
#pragma unroll
    for (int i = 0; i < 8; ++i) { const int cb = ((g * 8 + i) * 16 + hi * 8) * 2;
#pragma unroll
      for (int kb = 0; kb < 8; ++kb) { const bf16x8 kf = *reinterpret_cast<const bf16x8*>(lds + (kb * 32 + r32) * 512 + (cb ^ ((r32 & 15) << 4)));
        S[kb] = __builtin_amdgcn_mfma_f32_32x32x16_bf16(kf, qv[i], S[kb], 0, 0, 0); } } }
  float m = S[0][0];
#pragma unroll
  for (int kb = 0; kb < 8; ++kb)
#pragma unroll
    for (int r = 0; r < 16; ++r) m = fmaxf(m, S[kb][r]);
  { auto rr = __builtin_amdgcn_permlane32_swap(__float_as_uint(m), __float_as_uint(m), false, false); m = fmaxf(__uint_as_float(rr[0]), __uint_as_float(rr[1])); }
  float l = 0.f;
#pragma unroll
  for (int kb = 0; kb < 8; ++kb)
#pragma unroll
    for (int r = 0; r < 16; ++r) { S[kb][r] = __builtin_amdgcn_exp2f(S[kb][r] - m); l += S[kb][r]; }
  { auto rr = __builtin_amdgcn_permlane32_swap(__float_as_uint(l), __float_as_uint(l), false, false); l = __uint_as_float(rr[0]) + __uint_as_float(rr[1]); }
  bf16x8 pa[16];
#define XA_PK4(P, BASE, OUT) do { unsigned a0 = cvtpk(P[BASE + 0], P[BASE + 1]), a1 = cvtpk(P[BASE + 2], P[BASE + 3]);   \
    unsigned b0 = cvtpk(P[BASE + 4], P[BASE + 5]), b1 = cvtpk(P[BASE + 6], P[BASE + 7]);                              \
    auto r0 = __builtin_amdgcn_permlane32_swap(a0, b0, false, false); auto r1 = __builtin_amdgcn_permlane32_swap(a1, b1, false, false); \
    u32x4 w = {r0[0], r1[0], r0[1], r1[1]}; OUT = *reinterpret_cast<bf16x8*>(&w); } while (0)
#pragma unroll
  for (int kt = 0; kt < 4; ++kt) { XA_PK4(S[2 * kt], 0, pa[4 * kt]); XA_PK4(S[2 * kt], 8, pa[4 * kt + 1]); XA_PK4(S[2 * kt + 1], 0, pa[4 * kt + 2]); XA_PK4(S[2 * kt + 1], 8, pa[4 * kt + 3]); }
#undef XA_PK4
  { bf16x8 st[16];
#pragma unroll
    for (int i = 0; i < 16; ++i) { const int q = tid + 512 * i, row = q >> 5, c = (q & 31) * 8; st[i] = *reinterpret_cast<const bf16x8*>(Vh + (long)row * 2048 + c); }
    __syncthreads();
#pragma unroll
    for (int i = 0; i < 16; ++i) { const int q = tid + 512 * i, row = q >> 5, c = (q & 31) * 8; *(bf16x8*)(lds + ((row >> 6) * 2 + (c >> 7)) * 16384 + v_st(row & 63, c & 127)) = st[i]; } }
  if (hi == 0) li_l[r32] = l;
  __syncthreads();
  float rli[16];
#pragma unroll
  for (int r = 0; r < 16; ++r) rli[r] = __builtin_amdgcn_rcpf(li_l[crow(r, hi)]);
  const int vb0 = (int)(uintptr_t)lds + v_rd_base(lane);
  bf16_t* Ow = Ob + (long)(wid * 32) * 1024;
#pragma unroll
  for (int dvh = 0; dvh < 2; ++dvh) { f32x16 o[4] = {};
#pragma unroll
    for (int kt = 0; kt < 4; ++kt) pv_d0(o, vb0 + (kt * 2 + dvh) * 16384, pa[4 * kt], pa[4 * kt + 1], pa[4 * kt + 2], pa[4 * kt + 3]);
#pragma unroll
    for (int r = 0; r < 16; ++r) { const int orow = crow(r, hi);
#pragma unroll
      for (int d0 = 0; d0 < 4; ++d0) { const float v = o[d0][r] * rli[r]; Ow[(long)orow * 1024 + dvh * 128 + d0 * 32 + r32] = (bf16_t)(cvtpk(v, v) & 0xffffu); } } }
  __syncthreads();
}

__device__ __forceinline__ void flash_unit64c(const bf16_t* __restrict__ Qb, int ldq, const bf16_t* __restrict__ Kh, int ldk,
                                              const bf16_t* __restrict__ Vh, int ldv, bf16_t* __restrict__ Ob, int ldo, int nkeys, char* lds) {
  constexpr int KROWB = 128, SHM_K = 8192, SHM_V = 16384;
  const int tid = opaque_tid(), wid = tid >> 6, lane = tid & 63, r32 = lane & 31, hi = lane >> 5;
  char* V_lds = lds; char* K_lds = lds + 2 * SHM_V;
  float* ws = (float*)(lds + 2 * SHM_V + 2 * SHM_K) + wid * 64; float* li_l = ws; float* al_l = ws + 32;
  float m_run = 0.f, l_reg = 0.f; f32x16 o[4] = {}; bf16x8 qr[4]; f32x16 negm = {};
  const bf16_t* Qw = Qb + (long)(wid * 32 + r32) * ldq + hi * 8;
#pragma unroll
  for (int d0 = 0; d0 < 4; ++d0) qr[d0] = *reinterpret_cast<const bf16x8*>(Qw + d0 * 16);
  const int vr = 2 * (tid >> 5) + ((tid >> 2) & 1), vc = (((tid >> 3) & 3) * 4 + (tid & 3)) * 8, vst0 = v_st(vr, vc), vst1 = v_st(32 + vr, vc);
  const int kr = tid >> 3, kc = tid & 7, kst = kr * KROWB + ((kc * 16) ^ (((kr >> 1) & 7) << 4));
  const int vb0 = (int)(uintptr_t)V_lds + v_rd_base(lane);
  const int ksw = ((r32 >> 1) & 7) << 4;
  bf16x8 vs0, vs1, ks;
#define F4_SLOAD(k0) do { vs0 = *reinterpret_cast<const bf16x8*>(Vh + (long)((k0) + vr) * ldv + vc); vs1 = *reinterpret_cast<const bf16x8*>(Vh + (long)((k0) + 32 + vr) * ldv + vc); \
    ks = *reinterpret_cast<const bf16x8*>(Kh + (long)((k0) + kr) * ldk + kc * 8); } while (0)
#define F4_SWRITE(b) do { *(bf16x8*)(V_lds + (b) * SHM_V + vst0) = vs0; *(bf16x8*)(V_lds + (b) * SHM_V + vst1) = vs1; *(bf16x8*)(K_lds + (b) * SHM_K + kst) = ks; } while (0)
#define F4_PK4(P, BASE, OUT) do { unsigned a0 = cvtpk(P[BASE + 0], P[BASE + 1]), a1 = cvtpk(P[BASE + 2], P[BASE + 3]);   \
    unsigned b0 = cvtpk(P[BASE + 4], P[BASE + 5]), b1 = cvtpk(P[BASE + 6], P[BASE + 7]);                              \
    auto r0 = __builtin_amdgcn_permlane32_swap(a0, b0, false, false); auto r1 = __builtin_amdgcn_permlane32_swap(a1, b1, false, false); \
    u32x4 w = {r0[0], r1[0], r0[1], r1[1]}; OUT = *reinterpret_cast<bf16x8*>(&w); } while (0)
#define F4_TILE(b, FIRST) do { f32x16 p0, p1; bf16x8 pa0, pa1, pa2, pa3; const char* Ks_ = K_lds + (b) * SHM_K; \
    _Pragma("unroll") for (int d0 = 0; d0 < 4; ++d0) { const int cb = (d0 * 16 + hi * 8) * 2; \
      const bf16x8 b0 = *reinterpret_cast<const bf16x8*>(Ks_ + r32 * KROWB + (cb ^ ksw)); const bf16x8 b1 = *reinterpret_cast<const bf16x8*>(Ks_ + (32 + r32) * KROWB + (cb ^ ksw)); \
      if (d0 == 0) { p0 = __builtin_amdgcn_mfma_f32_32x32x16_bf16(b0, qr[0], negm, 0, 0, 0); p1 = __builtin_amdgcn_mfma_f32_32x32x16_bf16(b1, qr[0], negm, 0, 0, 0); } \
      else { p0 = __builtin_amdgcn_mfma_f32_32x32x16_bf16(b0, qr[d0], p0, 0, 0, 0); p1 = __builtin_amdgcn_mfma_f32_32x32x16_bf16(b1, qr[d0], p1, 0, 0, 0); } } \
    float pmax = p0[0]; \
    _Pragma("unroll") for (int r = 1; r < 16; ++r) pmax = fmaxf(pmax, p0[r]); \
    _Pragma("unroll") for (int r = 0; r < 16; ++r) pmax = fmaxf(pmax, p1[r]); \
    { auto rr = __builtin_amdgcn_permlane32_swap(__float_as_uint(pmax), __float_as_uint(pmax), false, false); pmax = fmaxf(__uint_as_float(rr[0]), __uint_as_float(rr[1])); } \
    if ((FIRST) || !__builtin_expect(__all(pmax <= 8.f), 1)) { const float dl = (FIRST) ? pmax : fmaxf(pmax, 0.f); const float alpha = __builtin_amdgcn_exp2f(-dl); m_run += dl; l_reg *= alpha; \
      _Pragma("unroll") for (int r = 0; r < 16; ++r) { p0[r] -= dl; p1[r] -= dl; negm[r] = -m_run; } \
      if (!(FIRST)) { if (hi == 0) al_l[r32] = alpha; asm volatile("s_waitcnt lgkmcnt(0)" ::: "memory"); \
        _Pragma("unroll") for (int d_ = 0; d_ < 4; ++d_) _Pragma("unroll") for (int r_ = 0; r_ < 16; ++r_) o[d_][r_] *= al_l[crow(r_, hi)]; } } \
    _Pragma("unroll") for (int r = 0; r < 16; ++r) { p0[r] = __builtin_amdgcn_exp2f(p0[r]); p1[r] = __builtin_amdgcn_exp2f(p1[r]); } \
    float ps = 0.f; \
    _Pragma("unroll") for (int r = 0; r < 16; ++r) ps += p0[r]; \
    _Pragma("unroll") for (int r = 0; r < 16; ++r) ps += p1[r]; \
    { auto rr = __builtin_amdgcn_permlane32_swap(__float_as_uint(ps), __float_as_uint(ps), false, false); ps = __uint_as_float(rr[0]) + __uint_as_float(rr[1]); } \
    l_reg += ps; \
    F4_PK4(p0, 0, pa0); F4_PK4(p0, 8, pa1); F4_PK4(p1, 0, pa2); F4_PK4(p1, 8, pa3); \
    pv_d0(o, vb0 + (b) * SHM_V, pa0, pa1, pa2, pa3); } while (0)
  const int NT = nkeys / 64;
  F4_SLOAD(0); F4_SWRITE(0); F4_SLOAD(64); F4_SWRITE(1); F4_SLOAD(128); __syncthreads();
  F4_TILE(0, true);
  __syncthreads();
  F4_SWRITE(0); F4_SLOAD(192);
  for (int j = 1; j + 1 < NT; j += 2) {
    F4_TILE(1, false);
    __syncthreads();
    if (j + 2 < NT) { F4_SWRITE(1); if (j + 3 < NT) F4_SLOAD((j + 3) * 64); }
    F4_TILE(0, false);
    __syncthreads();
    if (j + 3 < NT) { F4_SWRITE(0); if (j + 4 < NT) F4_SLOAD((j + 4) * 64); }
  }
  F4_TILE(1, false);
  __syncthreads();
  if (hi == 0) li_l[r32] = l_reg; asm volatile("s_waitcnt lgkmcnt(0)" ::: "memory");
  float rli[16];
#pragma unroll
  for (int r = 0; r < 16; ++r) rli[r] = __builtin_amdgcn_rcpf(li_l[crow(r, hi)]);
  bf16_t* Ow = Ob + (long)(wid * 32) * ldo;
  { bf16_t* stg = (bf16_t*)(lds + 65536) + wid * 4096;
#pragma unroll
    for (int r = 0; r < 16; ++r) { const int orow = crow(r, hi);
#pragma unroll
      for (int d0 = 0; d0 < 4; ++d0) { const float v = o[d0][r] * rli[r]; stg[orow * 128 + d0 * 32 + r32] = (bf16_t)(cvtpk(v, v) & 0xffffu); } }
    asm volatile("s_waitcnt lgkmcnt(0)" ::: "memory");
#pragma unroll
    for (int i = 0; i < 8; ++i) { const int row = i * 4 + (lane >> 4), ch = lane & 15; const u32x4 v = *(const u32x4*)(stg + row * 128 + ch * 8); *(u32x4*)(Ow + (long)row * ldo + ch * 8) = v; } }
  __syncthreads();
#undef F4_SLOAD
#undef F4_SWRITE
#undef F4_PK4
#undef F4_TILE
}
}
typedef unsigned short bf16;
typedef float f32x4 __attribute__((ext_vector_type(4)));
typedef unsigned v4u __attribute__((ext_vector_type(4)));
typedef short bf16x8 __attribute__((ext_vector_type(8)));
typedef float f32x16 __attribute__((ext_vector_type(16)));
#define LAS __attribute__((address_space(3)))
constexpr int BATCH = 8, SEQ = 4096, DM = 1024, T = BATCH * SEQ, DEPTH = 2, NMEM = 256, TM = BATCH * NMEM, INW = 2560, DFF = 4096;
constexpr int NWAVES = 8, NTHR = 512;
constexpr size_t MiB = 1u << 20;
constexpr size_t WS_W = 0, W_LAYER = 32 * MiB;
constexpr size_t WO_IN = 0, WO_OUT = 5 * MiB, WO_Q = 7 * MiB, WO_KV = 9 * MiB, WO_O = 13 * MiB, WO_1 = 15 * MiB, WO_2 = 23 * MiB;
constexpr size_t WS_GATE = 64 * MiB;
constexpr size_t WS_ROPE = 65 * MiB;
constexpr size_t WS_RSS = 67 * MiB;
constexpr size_t WS_MEMN = 68 * MiB;
constexpr size_t WS_KVX = 76 * MiB;
constexpr size_t WS_SUM = 92 * MiB;
constexpr size_t WS_XB = 108 * MiB;
constexpr size_t WS_Z = 172 * MiB, WS_OC = 332 * MiB, WS_MIX = 396 * MiB, WS_CIN = 460 * MiB, WS_RSSP = 464 * MiB, WS_END = 480 * MiB;
constexpr size_t WS_BAR = WS_RSS + 964 * 1024;
constexpr size_t WS_CNT = WS_RSS + 960 * 1024;
constexpr size_t WS_H = WS_Z, WS_QX = WS_Z, WS_OX = WS_Z + 64 * MiB;
constexpr int LDS_BYTES = 147456;
constexpr float LOG2E = 1.4426950408889634f;

__device__ __forceinline__ float bf2f(short v) { return __uint_as_float(((unsigned)(unsigned short)v) << 16); }
__device__ __forceinline__ unsigned f2bf(float f) { unsigned u = __builtin_bit_cast(unsigned, f); return (u + 0x7fffu + ((u >> 16) & 1u)) >> 16; }
__device__ __forceinline__ unsigned pk2(float lo, float hi) { return f2bf(lo) | (f2bf(hi) << 16); }
__device__ __forceinline__ float wave_sum(float v) {
#pragma unroll
    for (int o = 1; o < 64; o <<= 1) v += __shfl_xor(v, o);
    return v;
}
__device__ __forceinline__ float sigm(float x) { return __builtin_amdgcn_rcpf(1.f + __expf(-x)); }
__device__ __forceinline__ float gelu_tanh(float x) { const float y = 0.7978845608028654f * (x + 0.044715f * x * x * x); const float e = __expf(2.f * y); const float th = 1.f - 2.f * __builtin_amdgcn_rcpf(e + 1.f); return 0.5f * x * (1.f + th); }

struct LruArgs { const float* spl; float* CIN; unsigned* CNT; const bf16* Z; const float *conv_w, *conv_b, *b_r, *b_i, *a_param, *norm_g; const bf16* WG; float* SUM; bf16* MIX; const bf16* OC; const float* subln_g; float lam, oml; };
constexpr int CSB = 1040, CFS = 516, CF_OFF = 34816;
__device__ __forceinline__ int crow16(int r, int hi) { return (r & 3) + 8 * (r >> 2) + 4 * hi; }

template <bool REV> __device__ __forceinline__ void lru_scan(f32x16& a, f32x16& u, float cin, float& Atot, float& Htot, int hi) {
    float P[16], As[4], Hs[4];
#pragma unroll
    for (int s = 0; s < 4; ++s) { float h = 0.f, p = 1.f;
#pragma unroll
        for (int q = 0; q < 4; ++q) { const int r = REV ? 4 * s + 3 - q : 4 * s + q; h = a[r] * h + u[r]; p *= a[r]; u[r] = h; P[r] = p; }
        As[s] = p; Hs[s] = h; }
    float pA[4], pH[4];
#pragma unroll
    for (int s = 0; s < 4; ++s) { pA[s] = __shfl_xor(As[s], 32); pH[s] = __shfl_xor(Hs[s], 32); }
    float c = cin, at = 1.f, cm[4] = {0.f, 0.f, 0.f, 0.f};
#pragma unroll
    for (int gg = 0; gg < 8; ++gg) { const int g = REV ? 7 - gg : gg; const int s = g >> 1; const bool own = ((g & 1) == hi);
        const float Ag = own ? As[s] : pA[s], Hg = own ? Hs[s] : pH[s];
        cm[s] = own ? c : cm[s];
        c = Ag * c + Hg; at *= Ag; }
    Atot = at; Htot = c;
#pragma unroll
    for (int r = 0; r < 16; ++r) u[r] = u[r] + P[r] * cm[r >> 2];
}
template <bool REV> __device__ __forceinline__ float lru_carry(const float* sb  , int j) {
    const int n = REV ? 127 - j : j; float c = 0.f;
    for (int k0 = 0; k0 < n; k0 += 8) { float Av[8], Hv[8];
#pragma unroll
        for (int q = 0; q < 8; ++q) { const int k = k0 + q; const bool ok = k < n; const int i = ok ? (REV ? 127 - k : k) : (REV ? 127 : 0);
            const float av = sb[(size_t)i * 2048], hv = sb[(size_t)i * 2048 + 512]; Av[q] = ok ? av : 1.f; Hv[q] = ok ? hv : 0.f; }
#pragma unroll
        for (int q = 0; q < 8; ++q) c = Av[q] * c + Hv[q];
    }
    return c;
}
__device__ __forceinline__ void lru_xload(bf16x8 (&xr)[7], const LruArgs& A, int b, int j, int w, int lane) {
    const int t0 = j * 32 + 4 * w; const long rowb = (long)b * SEQ;
#pragma unroll
    for (int rr = 0; rr < 7; ++rr) { const int t = t0 + rr - 2; const int tc = t < 0 ? 0 : (t >= SEQ ? SEQ - 1 : t);
        const bf16x8 raw = *(const bf16x8*)(A.Z + (rowb + tc) * INW + 1536 + 8 * lane); xr[rr] = (t >= 0 && t < SEQ) ? raw : (bf16x8){0, 0, 0, 0, 0, 0, 0, 0}; }
}
template <bool FINAL> __device__ __forceinline__ void lru_chunk(const LruArgs& A, int b, int j, char* lds, bf16x8 (&xr)[7], int nb_, int nj_, bool publish) {
    const int tid = opaque_tid(), w = __builtin_amdgcn_readfirstlane(tid >> 6), lane = tid & 63, n32 = lane & 31, hi = lane >> 5;
    char* Cs = lds; float* Cf = (float*)(lds + CF_OFF);
    const long rowb = (long)b * SEQ;
    {
        const int tl = 4 * w;
        float xv[7][8];
#pragma unroll
        for (int rr = 0; rr < 7; ++rr) {
#pragma unroll
            for (int e = 0; e < 8; ++e) xv[rr][e] = bf2f(xr[rr][e]); }
        float cw[4][8], cb[8];
#pragma unroll
        for (int jj = 0; jj < 4; ++jj) { const f32x4 a0 = *(const f32x4*)(A.conv_w + jj * 512 + 8 * lane), a1 = *(const f32x4*)(A.conv_w + jj * 512 + 8 * lane + 4);
#pragma unroll
            for (int e = 0; e < 4; ++e) { cw[jj][e] = a0[e]; cw[jj][4 + e] = a1[e]; } }
        { const f32x4 a0 = *(const f32x4*)(A.conv_b + 8 * lane), a1 = *(const f32x4*)(A.conv_b + 8 * lane + 4);
#pragma unroll
            for (int e = 0; e < 4; ++e) { cb[e] = a0[e]; cb[4 + e] = a1[e]; } }
#pragma unroll
        for (int tt = 0; tt < 4; ++tt) { float c[8];
#pragma unroll
            for (int e = 0; e < 8; ++e) c[e] = cb[e] + cw[0][e] * xv[tt][e] + cw[1][e] * xv[tt + 1][e] + cw[2][e] * xv[tt + 2][e] + cw[3][e] * xv[tt + 3][e];
            v4u pk; pk.x = pk2(c[0], c[1]); pk.y = pk2(c[2], c[3]); pk.z = pk2(c[4], c[5]); pk.w = pk2(c[6], c[7]);
            *(v4u*)(Cs + (tl + tt) * CSB + lane * 16) = pk;
            *(f32x4*)(Cf + (tl + tt) * CFS + 8 * lane) = (f32x4){c[0], c[1], c[2], c[3]};
            *(f32x4*)(Cf + (tl + tt) * CFS + 8 * lane + 4) = (f32x4){c[4], c[5], c[6], c[7]}; }
    }
    __syncthreads();
    if (nj_ >= 0) lru_xload(xr, A, nb_, nj_, w, lane);
    bf16x8 gpre[4], o1pre[4], o2pre[4];
    if (FINAL) {
#pragma unroll
        for (int tt = 0; tt < 4; ++tt) { const long grow = rowb + j * 32 + 4 * w + tt;
            gpre[tt] = *(const bf16x8*)(A.Z + grow * INW + 2048 + 8 * lane); o1pre[tt] = *(const bf16x8*)(A.OC + grow * 512 + 8 * lane); o2pre[tt] = *(const bf16x8*)(A.OC + (size_t)T * 512 + grow * 512 + 8 * lane); } }
    bf16x8 af[4];
#pragma unroll
    for (int ks = 0; ks < 4; ++ks) af[ks] = *(const bf16x8*)(Cs + n32 * CSB + (64 * w + 16 * ks + 8 * hi) * 2);
#pragma unroll
    for (int nb = 0; nb < 2; ++nb) {
        const int cl = 32 * nb + n32, ch = 64 * w + cl;
        f32x16 hs = {};
#pragma unroll
        for (int dir = 0; dir < 2; ++dir) {
            const bf16* wg_r = A.WG + ((size_t)((dir * 2 + 0) * 8 + w) * 64 + cl) * 64 + 8 * hi;
            const bf16* wg_i = A.WG + ((size_t)((dir * 2 + 1) * 8 + w) * 64 + cl) * 64 + 8 * hi;
            f32x16 dr = {}, di = {};
#pragma unroll
            for (int ks = 0; ks < 4; ++ks) {
                dr = __builtin_amdgcn_mfma_f32_32x32x16_bf16(af[ks], *(const bf16x8*)(wg_r + 16 * ks), dr, 0, 0, 0);
                di = __builtin_amdgcn_mfma_f32_32x32x16_bf16(af[ks], *(const bf16x8*)(wg_i + 16 * ks), di, 0, 0, 0); }
            const float spl = A.spl[dir * 512 + ch], Br = __builtin_amdgcn_exp2f(-LOG2E * A.b_r[dir * 512 + ch]), Bi = __builtin_amdgcn_exp2f(-LOG2E * A.b_i[dir * 512 + ch]);
#pragma unroll
            for (int r = 0; r < 16; ++r) { const int tok = crow16(r, hi);
                const float rg = __builtin_amdgcn_rcpf(fmaf(__builtin_amdgcn_exp2f(dr[r]), Br, 1.f)), ig = __builtin_amdgcn_rcpf(fmaf(__builtin_amdgcn_exp2f(di[r]), Bi, 1.f));
                const float a = __builtin_amdgcn_exp2f(rg * spl), mult = __builtin_amdgcn_sqrtf(fmaf(-a, a, 1.f));
                dr[r] = a; di[r] = Cf[tok * CFS + ch] * ig * mult; }
            float cin = 0.f;
            if (FINAL) cin = A.CIN[((size_t)(b * 128 + j) * 2 + dir) * 512 + ch];
            float At, Ht;
            if (dir) lru_scan<true>(dr, di, cin, At, Ht, hi); else lru_scan<false>(dr, di, cin, At, Ht, hi);
            if (!FINAL) { if (hi == 0) { float* sp_ = A.SUM + ((size_t)(b * 128 + j) * 2 + dir) * 1024 + ch;
                __hip_atomic_store(sp_, At, __ATOMIC_RELAXED, __HIP_MEMORY_SCOPE_AGENT); __hip_atomic_store(sp_ + 512, Ht, __ATOMIC_RELAXED, __HIP_MEMORY_SCOPE_AGENT); } }
            else { hs = dir ? hs + di : di; }
        }
        if (FINAL) {
#pragma unroll
            for (int r = 0; r < 16; ++r) Cf[crow16(r, hi) * CFS + ch] = hs[r];
        }
    }
    if (!FINAL && publish) {
        asm volatile("s_waitcnt vmcnt(0)" ::: "memory");
        __syncthreads();
        LAS unsigned* flag = (LAS unsigned*)(lds + 131072 - 16);
        if (tid == 0) { const unsigned old = __hip_atomic_fetch_add(A.CNT + b, 4u, __ATOMIC_RELAXED, __HIP_MEMORY_SCOPE_AGENT); *flag = (old == 124u) ? 1u : 0u; }
        __syncthreads();
        const bool last = (*flag != 0u);
        if (last) {
            __builtin_amdgcn_fence(__ATOMIC_ACQUIRE, "agent");
            const float* sb = A.SUM + (size_t)b * 128 * 2048 + tid;
            float* cb_ = A.CIN + (size_t)b * 128 * 1024 + tid;
            float cf = 0.f, cr = 0.f;
            for (int k0 = 0; k0 < 128; k0 += 32) { float Af[32], Hf[32], Ar[32], Hr[32];
#pragma unroll
                for (int q = 0; q < 32; ++q) { const int jf = k0 + q, jr = 127 - jf;
                    Af[q] = __hip_atomic_load(sb + (size_t)jf * 2048, __ATOMIC_RELAXED, __HIP_MEMORY_SCOPE_AGENT); Hf[q] = __hip_atomic_load(sb + (size_t)jf * 2048 + 512, __ATOMIC_RELAXED, __HIP_MEMORY_SCOPE_AGENT);
                    Ar[q] = __hip_atomic_load(sb + (size_t)jr * 2048 + 1024, __ATOMIC_RELAXED, __HIP_MEMORY_SCOPE_AGENT); Hr[q] = __hip_atomic_load(sb + (size_t)jr * 2048 + 1536, __ATOMIC_RELAXED, __HIP_MEMORY_SCOPE_AGENT); }
#pragma unroll
                for (int q = 0; q < 32; ++q) { const int jf = k0 + q, jr = 127 - jf;
                    cb_[(size_t)jf * 1024] = cf; cf = Af[q] * cf + Hf[q];
                    cb_[(size_t)jr * 1024 + 512] = cr; cr = Ar[q] * cr + Hr[q]; }
            }
        }
    }
    __syncthreads();
    if (FINAL) {
#pragma unroll
        for (int tt = 0; tt < 4; ++tt) { const int tl = 4 * w + tt; const long grow = rowb + j * 32 + tl;
            const f32x4 y0 = *(const f32x4*)(Cf + tl * CFS + 8 * lane), y1 = *(const f32x4*)(Cf + tl * CFS + 8 * lane + 4);
            const bf16x8 g = gpre[tt];
            float y[8]; float ss = 0.f;
#pragma unroll
            for (int e = 0; e < 8; ++e) { const float yv = e < 4 ? y0[e] : y1[e - 4]; y[e] = yv * gelu_tanh(bf2f(g[e])); ss += y[e] * y[e]; }
            ss = wave_sum(ss); const float rs = rsqrtf(ss * (1.f / 512.f) + 1e-6f);
            const f32x4 g0 = *(const f32x4*)(A.norm_g + 8 * lane), g1 = *(const f32x4*)(A.norm_g + 8 * lane + 4);
            v4u pk; pk.x = pk2(y[0] * rs * g0[0], y[1] * rs * g0[1]); pk.y = pk2(y[2] * rs * g0[2], y[3] * rs * g0[3]); pk.z = pk2(y[4] * rs * g1[0], y[5] * rs * g1[1]); pk.w = pk2(y[6] * rs * g1[2], y[7] * rs * g1[3]);
            *(v4u*)(A.MIX + grow * DM + 512 + 8 * lane) = pk;
            const bf16x8 o1 = o1pre[tt], o2 = o2pre[tt];
            float d[8]; float s2 = 0.f;
#pragma unroll
            for (int e = 0; e < 8; ++e) { d[e] = bf2f(o1[e]) - A.lam * bf2f(o2[e]); s2 += d[e] * d[e]; }
            s2 += __shfl_xor(s2, 1); s2 += __shfl_xor(s2, 2); s2 += __shfl_xor(s2, 4); s2 += __shfl_xor(s2, 8);
            const float r2 = rsqrtf(s2 * (1.f / 128.f) + 1e-6f) * A.oml;
            const int gc = (8 * lane) & 127;
            const f32x4 s0 = *(const f32x4*)(A.subln_g + gc), s1 = *(const f32x4*)(A.subln_g + gc + 4);
            v4u pq; pq.x = pk2(d[0] * r2 * s0[0], d[1] * r2 * s0[1]); pq.y = pk2(d[2] * r2 * s0[2], d[3] * r2 * s0[3]); pq.z = pk2(d[4] * r2 * s1[0], d[5] * r2 * s1[1]); pq.w = pk2(d[6] * r2 * s1[2], d[7] * r2 * s1[3]);
            *(v4u*)(A.MIX + grow * DM + 8 * lane) = pq; }
        __syncthreads();
    }
}
#define XB_TMO      128
#define XB_XCNT(j)  (256  + 64 * (j))
#define XB_XSUB(j)  (1280 + 64 * (j))
#define XB_XGEN(j)  (2304 + 64 * (j))
#define XB_TOP      3328
#define XB_TOPGEN   3392
#define XCD_BAR_WORDS 3456
#define XB_SPIN_CAP (1u << 18)

__device__ __forceinline__ unsigned xb_ld(unsigned* p)              { return __hip_atomic_load(p, __ATOMIC_RELAXED, __HIP_MEMORY_SCOPE_AGENT); }
__device__ __forceinline__ unsigned xb_add(unsigned* p, unsigned v) { return __hip_atomic_fetch_add(p, v, __ATOMIC_RELAXED, __HIP_MEMORY_SCOPE_AGENT); }
__device__ __forceinline__ unsigned xb_xcc_id() { return (unsigned)__builtin_amdgcn_s_getreg((3 << 11) | 20) & 0xFu; }
#define XB_SPIN(cond, bar) do { unsigned _sp = 0; while (cond) { __builtin_amdgcn_s_sleep(1); \
    if ((++_sp & 255u) == 0u) { if (xb_ld(&(bar)[XB_TMO])) break; if (_sp > XB_SPIN_CAP) { atomicAdd(&(bar)[XB_TMO], 1u); break; } } } } while (0)

struct XcdBarrier {
    unsigned* bar; unsigned x;
    volatile LAS unsigned* st;
};

__device__ __forceinline__ XcdBarrier xcd_barrier_post(unsigned* bar, volatile LAS unsigned* st) {
    XcdBarrier b; b.bar = bar; b.x = xb_xcc_id(); b.st = st;
    if (threadIdx.x == 0) (void)xb_add(&bar[XB_XCNT(b.x)], 1u);
    return b;
}
__device__ __forceinline__ void xcd_barrier_complete(unsigned* bar, unsigned x, unsigned& nloc, unsigned& nx) {
    const unsigned G = gridDim.x * gridDim.y * gridDim.z;
    unsigned sum, cnt, mine, sp = 0u;
    for (;;) {
        sum = 0u; cnt = 0u; mine = 0u;
#pragma unroll
        for (unsigned j = 0; j < 16; ++j) { const unsigned c = xb_ld(&bar[XB_XCNT(j)]); sum += c; cnt += (c > 0u) ? 1u : 0u; mine = (j == x) ? c : mine; }
        if (sum == G) break;
        __builtin_amdgcn_s_sleep(1);
        if ((++sp & 255u) == 0u) { if (xb_ld(&bar[XB_TMO])) break; if (sp > XB_SPIN_CAP) { atomicAdd(&bar[XB_TMO], 1u); break; } }
    }
    nloc = mine > 0u ? mine : 1u; nx = cnt > 0u ? cnt : 1u;
}

__device__ __forceinline__ void xcd_barrier(const XcdBarrier& b) {
    asm volatile("s_waitcnt vmcnt(0)" ::: "memory");
    __syncthreads();
    if (threadIdx.x == 0) {
        unsigned* bar = b.bar;
        __builtin_amdgcn_s_waitcnt(0);
        unsigned nloc = b.st[0], nx = b.st[1];
        if (nloc == 0u) { xcd_barrier_complete(bar, b.x, nloc, nx); b.st[0] = nloc; b.st[1] = nx; }
        const unsigned old = xb_add(&bar[XB_XSUB(b.x)], 1u);
        const unsigned gen = old / nloc;
        if (old + 1u == (gen + 1u) * nloc) {
            __builtin_amdgcn_fence(__ATOMIC_RELEASE, "agent");
            asm volatile("s_waitcnt vmcnt(0)" ::: "memory");
            const unsigned og = xb_add(&bar[XB_TOP], 1u);
            const unsigned tg = og / nx;
            if (og + 1u == (tg + 1u) * nx) xb_add(&bar[XB_TOPGEN], 1u);
            else XB_SPIN(xb_ld(&bar[XB_TOPGEN]) == tg, bar);
            __builtin_amdgcn_fence(__ATOMIC_ACQUIRE, "agent");
            xb_add(&bar[XB_XGEN(b.x)], 1u);
            asm volatile("s_waitcnt vmcnt(0)" ::: "memory");
        } else {
            XB_SPIN(xb_ld(&bar[XB_XGEN(b.x)]) == gen, bar);
            __builtin_amdgcn_fence(__ATOMIC_ACQUIRE, "agent");
            asm volatile("s_waitcnt vmcnt(0)" ::: "memory");
        }
    }
    __syncthreads();
}

struct Args { const void* in[29]; float* out; unsigned char* ws; };
__device__ __forceinline__ void transpose_item(const float* W, int K, int N, bf16* WT, int row_off, const float* gain, LAS float* scr, int item, int lane) {
    const int nblk = N / 32, kb = item / nblk, nb = item % nblk, k0 = 64 * kb, n0 = 32 * nb;
    float wv_[32];
#pragma unroll
    for (int i = 0; i < 32; ++i) wv_[i] = W[(size_t)(k0 + 2 * i + (lane >> 5)) * N + n0 + (lane & 31)];
#pragma unroll
    for (int i = 0; i < 32; ++i) { const int kk = 2 * i + (lane >> 5); const float gv = gain ? gain[k0 + kk] : 1.f; scr[kk * 33 + (lane & 31)] = wv_[i] * gv; }
    asm volatile("s_waitcnt lgkmcnt(0)" ::: "memory");
    const int c = lane & 7;
#pragma unroll
    for (int j = 0; j < 4; ++j) { const int n = (lane >> 3) + 8 * j; const LAS float* s = scr + (8 * c) * 33 + n;
        v4u o; o.x = pk2(s[0 * 33], s[1 * 33]); o.y = pk2(s[2 * 33], s[3 * 33]); o.z = pk2(s[4 * 33], s[5 * 33]); o.w = pk2(s[6 * 33], s[7 * 33]);
        *(v4u*)(WT + (size_t)(row_off + n0 + n) * K + k0 + 8 * c) = o; }
    asm volatile("s_waitcnt lgkmcnt(0)" ::: "memory");
}
#define IN_F(i) ((const float*)args.in[i])

__global__ void __launch_bounds__(NTHR, 2) mega_fwd(Args args) {
    extern __shared__ __attribute__((aligned(16))) unsigned char lds[];
    cg::grid_group grid = cg::this_grid();
    const int tid = threadIdx.x, lane = tid & 63, wave = __builtin_amdgcn_readfirstlane(tid >> 6);
    const int G = gridDim.x, bx = blockIdx.x;
    const int vcu = (G % 8 == 0) ? (bx % 8) * (G / 8) + bx / 8 : bx;
    unsigned char* ws = args.ws;
    float* XF = args.out;
    bf16* XB = (bf16*)(ws + WS_XB);
    float* RSS = (float*)(ws + WS_RSSP);
    float* ROPE = (float*)(ws + WS_ROPE);
    bf16* Zb = (bf16*)(ws + WS_Z); bf16* OC = (bf16*)(ws + WS_OC); bf16* MIX = (bf16*)(ws + WS_MIX);
    bf16* Hb = (bf16*)(ws + WS_H); bf16* QX = (bf16*)(ws + WS_QX); bf16* OX = (bf16*)(ws + WS_OX);
    LAS unsigned char* ldsl = (LAS unsigned char*)lds;

    volatile LAS unsigned* bst = (volatile LAS unsigned*)(ldsl + 131072 + 64);
    if (tid < 2) bst[tid] = 0u;
    __syncthreads();
    for (int rep_ = 0; rep_ < REP_PRO; ++rep_) {
        const int gw = vcu * NWAVES + wave, NGW = G * NWAVES;
        LAS float* scr = (LAS float*)(ldsl + wave * 16384);
        constexpr int I_IN = 16 * 80, I_SQ = 16 * 32, I_1 = 16 * 128, I_2 = 64 * 32, IPL = I_IN + 5 * I_SQ + I_1 + I_2;
        for (int it = gw; it < DEPTH * IPL; it += NGW) {
            const int l = it / IPL; int r = it % IPL; unsigned char* wl = ws + WS_W + (size_t)l * W_LAYER;
            if (r < I_IN) { transpose_item(IN_F(4) + (size_t)l * DM * INW, DM, INW, (bf16*)(wl + WO_IN), 0, IN_F(3) + l * DM, scr, r, lane); continue; } r -= I_IN;
            if (r < I_SQ) { transpose_item(IN_F(18) + (size_t)l * DM * DM, DM, DM, (bf16*)(wl + WO_OUT), 0, nullptr, scr, r, lane); continue; } r -= I_SQ;
            if (r < I_SQ) { transpose_item(IN_F(21) + (size_t)l * DM * DM, DM, DM, (bf16*)(wl + WO_Q), 0, IN_F(19) + l * DM, scr, r, lane); continue; } r -= I_SQ;
            if (r < I_SQ) { transpose_item(IN_F(22) + (size_t)l * DM * DM, DM, DM, (bf16*)(wl + WO_KV), 0, nullptr, scr, r, lane); continue; } r -= I_SQ;
            if (r < I_SQ) { transpose_item(IN_F(23) + (size_t)l * DM * DM, DM, DM, (bf16*)(wl + WO_KV), DM, nullptr, scr, r, lane); continue; } r -= I_SQ;
            if (r < I_SQ) { transpose_item(IN_F(24) + (size_t)l * DM * DM, DM, DM, (bf16*)(wl + WO_O), 0, nullptr, scr, r, lane); continue; } r -= I_SQ;
            if (r < I_1) { transpose_item(IN_F(26) + (size_t)l * DM * DFF, DM, DFF, (bf16*)(wl + WO_1), 0, IN_F(25) + l * DM, scr, r, lane); continue; } r -= I_1;
            transpose_item(IN_F(27) + (size_t)l * DFF * DM, DFF, DM, (bf16*)(wl + WO_2), 0, nullptr, scr, r, lane);
        }
        const int gt = vcu * NTHR + tid, NGT = G * NTHR;
        { bf16* WG = (bf16*)(ws + WS_GATE);
          for (int o = gt; o < DEPTH * 2 * 2 * 8 * 64 * 64; o += NGT) { const int i = o & 63, jx = (o >> 6) & 63, n = (o >> 12) & 7, gate = (o >> 15) & 1, dir = (o >> 16) & 1, l = o >> 17;
              const float* src = gate ? IN_F(14) : IN_F(12);
              WG[o] = (bf16)f2bf(-LOG2E * src[((((size_t)l * 2 + dir) * 8 + n) * 64 + i) * 64 + jx]); } }
        { float* SPL = (float*)(ws + WS_GATE + 768 * 1024); for (int o = gt; o < DEPTH * 2 * 512; o += NGT) SPL[o] = -8.f * LOG2E * log1pf(expf(-IN_F(16)[o])); }
        { const int* pos = (const int*)args.in[2];
          for (int o = gt; o < T * 8; o += NGT) { const int row = o >> 3, i = o & 7; const float inv = powf(500000.f, -(float)i * 0.125f); const float ang = (float)pos[row] * inv;
              ROPE[row * 16 + i] = cosf(ang); ROPE[row * 16 + 8 + i] = sinf(ang); } }
        if (gt < DEPTH * BATCH) ((unsigned*)(ws + WS_CNT))[gt] = 0u;
        if (gt < XCD_BAR_WORDS) ((unsigned*)(ws + WS_BAR))[gt] = 0u;
        for (int m0 = gw * 4; m0 < T; m0 += NGW * 4) { f32x4 v[4][4];
#pragma unroll
            for (int q = 0; q < 4; ++q) { const f32x4* xr = (const f32x4*)(IN_F(0) + (size_t)(m0 + q) * DM) + lane;
#pragma unroll
                for (int j = 0; j < 4; ++j) v[q][j] = xr[64 * j]; }
#pragma unroll
            for (int q = 0; q < 4; ++q) { float s = 0.f;
#pragma unroll
                for (int j = 0; j < 4; ++j) s += (v[q][j].x * v[q][j].x + v[q][j].y * v[q][j].y) + (v[q][j].z * v[q][j].z + v[q][j].w * v[q][j].w);
                s = wave_sum(s); if (lane < 16) RSS[(size_t)(m0 + q) * 16 + lane] = (lane == 0) ? s : 0.f;
                unsigned long long* o8 = (unsigned long long*)(XB + (size_t)(m0 + q) * DM) + lane;
#pragma unroll
                for (int j = 0; j < 4; ++j) o8[64 * j] = (unsigned long long)pk2(v[q][j].x, v[q][j].y) | ((unsigned long long)pk2(v[q][j].z, v[q][j].w) << 32); } }
        for (int m = gw; m < DEPTH * TM; m += NGW) { const int l = m / TM, row = m % TM; const f32x4* xr = (const f32x4*)(IN_F(1) + (size_t)row * DM) + lane; const f32x4* gr = (const f32x4*)(IN_F(20) + l * DM) + lane; f32x4 v[4]; float s = 0.f;
#pragma unroll
            for (int j = 0; j < 4; ++j) { v[j] = xr[64 * j]; s += (v[j].x * v[j].x + v[j].y * v[j].y) + (v[j].z * v[j].z + v[j].w * v[j].w); }
            const float rs = rsqrtf(wave_sum(s) * (1.f / DM) + 1e-6f);
            unsigned long long* o8 = (unsigned long long*)((bf16*)(ws + WS_MEMN) + (size_t)m * DM) + lane;
#pragma unroll
            for (int j = 0; j < 4; ++j) { const f32x4 g = gr[64 * j]; o8[64 * j] = (unsigned long long)pk2(v[j].x * rs * g.x, v[j].y * rs * g.y) | ((unsigned long long)pk2(v[j].z * rs * g.z, v[j].w * rs * g.w) << 32); } }
    }
    grid.sync();
    const XcdBarrier xbar = xcd_barrier_post((unsigned*)(ws + WS_BAR), bst);
#define GRID_BAR() xcd_barrier(xbar)

    for (int l = 0; l < DEPTH; ++l) {
        pg8::Gemm g{(const bf16*)(ws + WS_MEMN) + (size_t)l * TM * DM, (const bf16*)(ws + WS_W + (size_t)l * W_LAYER + WO_KV), TM, 2048, DM};
        pg8::StaticOrder S; S.init(TM, 2048, G, bx);
        pg8::EpiScale<0> E{(bf16*)(ws + WS_KVX) + (size_t)l * TM * 2048, 2048, nullptr, 1.f, nullptr};
        pg8::gemm_phase<pg8::EpiScale<0>, pg8::StaticOrder, true, true>(ldsl, g, S, E);
    }

#pragma unroll
    for (int l = 0; l < DEPTH; ++l) {
        unsigned char* wl = ws + WS_W + (size_t)l * W_LAYER;
        for (int rep_ = 0; rep_ < REP_IN; ++rep_) {
            pg8::Gemm g{XB, (const bf16*)(wl + WO_IN), T, INW, DM}; pg8::StaticOrder S; S.init(T, INW, G, bx);
            pg8::EpiScale<1> E{Zb, INW, RSS + (size_t)(3 * l) * T * 16, 0.125f * LOG2E, ROPE};
            pg8::gemm_phase<pg8::EpiScale<1>, pg8::StaticOrder, true, true>(ldsl, g, S, E);
        }
        GRID_BAR();
        const float lam_init = 0.8f - 0.6f * expf(-0.3f * (float)l);
        float lam;
        { const float a = wave_sum(IN_F(5)[l * 64 + lane] * IN_F(6)[l * 64 + lane]), b2 = wave_sum(IN_F(7)[l * 64 + lane] * IN_F(8)[l * 64 + lane]); lam = expf(a) - expf(b2) + lam_init; }
        LruArgs LA{(const float*)(ws + WS_GATE + 768 * 1024) + l * 1024, (float*)(ws + WS_CIN), (unsigned*)(ws + WS_CNT) + l * BATCH, Zb, IN_F(10) + (size_t)l * 4 * 512, IN_F(11) + l * 512, IN_F(13) + l * 1024, IN_F(15) + l * 1024, IN_F(16) + l * 1024, IN_F(17) + l * 512,
                   (const bf16*)(ws + WS_GATE) + (size_t)l * 131072, (float*)(ws + WS_SUM), MIX, OC, IN_F(9) + l * 128, lam, 1.f - lam_init};
#ifndef NO_LRUA
        for (int rep_ = 0; rep_ < REP_LRUA; ++rep_)
        for (int base = vcu * 4; base < BATCH * 128; base += G * 4) { bf16x8 xr[7]; lru_xload(xr, LA, base >> 7, base & 127, wave, lane);
#pragma unroll 1
            for (int i = 0; i < 4; ++i) lru_chunk<false>(LA, base >> 7, (base & 127) + i, (char*)lds, xr, base >> 7, i < 3 ? (base & 127) + i + 1 : -1, i == 3); }
#endif
        for (int rep_ = 0; rep_ < REP_FA; ++rep_)
        for (int i = 0; i * G < 1024; ++i) {
            const int L = i * G + vcu; if (L >= 1024) break;
            const int uid = (G == 256) ? (((vcu >> 5) * 4 + i) * 32 + (vcu & 31)) : L;
            const int bh = uid >> 5, wi = uid & 31, c = wi >> 4, qb = wi & 15, b = bh >> 2, h = bh & 3;
            const bf16* Qp = Zb + ((size_t)b * SEQ + qb * 256) * INW + h * 128 + c * 64;
            const bf16* Kp = Zb + ((size_t)b * SEQ) * INW + 512 + h * 128 + c * 64;
            const bf16* Vp = Zb + ((size_t)b * SEQ) * INW + 1024 + h * 128;
            bf16* Op = OC + (size_t)c * T * 512 + ((size_t)b * SEQ + qb * 256) * 512 + h * 128;
#ifndef NO_FA64
            fa::flash_unit64c(Qp, INW, Kp, INW, Vp, INW, Op, 512, SEQ, (char*)lds);
#endif
        }
        GRID_BAR();
#ifndef NO_LRUC
        for (int rep_ = 0; rep_ < REP_LRUC; ++rep_)
        for (int base = vcu * 4; base < BATCH * 128; base += G * 4) { bf16x8 xr[7]; lru_xload(xr, LA, base >> 7, base & 127, wave, lane);
#pragma unroll 1
            for (int i = 0; i < 4; ++i) lru_chunk<true>(LA, base >> 7, (base & 127) + i, (char*)lds, xr, base >> 7, i < 3 ? (base & 127) + i + 1 : -1, false); }
#endif
        GRID_BAR();
        {
            pg8::Gemm g{MIX, (const bf16*)(wl + WO_OUT), T, DM, DM}; pg8::StaticOrder S; S.init(T, DM, G, bx);
            if (l == 0) { pg8::EpiRes<true> E{IN_F(0), XB, RSS + (size_t)(3 * l + 1) * T * 16}; pg8::gemm_phase<pg8::EpiRes<true>, pg8::StaticOrder, true, true>(ldsl, g, S, E); }
            else { pg8::EpiRes<false> E{nullptr, XB, RSS + (size_t)(3 * l + 1) * T * 16}; pg8::gemm_phase<pg8::EpiRes<false>, pg8::StaticOrder, true, true>(ldsl, g, S, E); }
        }
        GRID_BAR();
        for (int rep_ = 0; rep_ < REP_Q; ++rep_) {
            pg8::Gemm g{XB, (const bf16*)(wl + WO_Q), T, DM, DM}; pg8::StaticOrder S; S.init(T, DM, G, bx);
            pg8::EpiScale<2> E{QX, DM, RSS + (size_t)(3 * l + 1) * T * 16, 0.0625f * LOG2E, nullptr};
            pg8::gemm_phase<pg8::EpiScale<2>, pg8::StaticOrder, true, true>(ldsl, g, S, E);
        }
        {
            pg8::StaticOrder S; S.init(T, DM, G, bx); pg8::Unit u;
            for (int rep_ = 0; rep_ < REP_XA; ++rep_)
            for (int i = 0; S.next(i, u); ++i)
            {
                    const int b = u.pm >> 4, qb = u.pm & 15, h = u.pn;
                    const bf16* KV = (const bf16*)(ws + WS_KVX) + (size_t)l * TM * 2048 + (size_t)b * NMEM * 2048;
                    const bf16* Qp = QX + ((size_t)b * SEQ + qb * 256) * DM + h * 256;
                    bf16* Op = OX + ((size_t)b * SEQ + qb * 256) * DM + h * 256;
#ifndef NO_FA256
                    fa::xattn_unit(Qp, KV + h * 256, KV + 1024 + h * 256, Op, (char*)lds);
#endif
            }
        }
        GRID_BAR();
        {
            pg8::Gemm g{OX, (const bf16*)(wl + WO_O), T, DM, DM}; pg8::StaticOrder S; S.init(T, DM, G, bx);
            pg8::EpiRes<false> E{nullptr, XB, RSS + (size_t)(3 * l + 2) * T * 16};
            pg8::gemm_phase<pg8::EpiRes<false>, pg8::StaticOrder, true, true>(ldsl, g, S, E);
        }
        GRID_BAR();
        for (int rep_ = 0; rep_ < REP_UP; ++rep_) {
            pg8::Gemm g{XB, (const bf16*)(wl + WO_1), T, DFF, DM}; pg8::StaticOrder S; S.init(T, DFF, G, bx);
            pg8::EpiScale<3> E{Hb, DFF, RSS + (size_t)(3 * l + 2) * T * 16, 1.f, nullptr};
            pg8::gemm_phase<pg8::EpiScale<3>, pg8::StaticOrder, true, true>(ldsl, g, S, E);
        }
        GRID_BAR();
        {
            pg8::Gemm g{Hb, (const bf16*)(wl + WO_2), T, DM, DFF}; pg8::StaticOrder S; S.init(T, DM, G, bx);
            pg8::EpiRes<false> E{nullptr, XB, RSS + (size_t)(3 * l + 3) * T * 16};
            pg8::gemm_phase<pg8::EpiRes<false>, pg8::StaticOrder, true, true>(ldsl, g, S, E);
        }
        GRID_BAR();
    }
    for (int rep_ = 0; rep_ < REP_SYNC; ++rep_) GRID_BAR();
    {
        const int gw = vcu * NWAVES + wave, NGW = G * NWAVES; const float* rss = RSS + (size_t)6 * T * 16; const f32x4* gr = (const f32x4*)IN_F(28) + lane;
        f32x4 gv[4];
#pragma unroll
        for (int j = 0; j < 4; ++j) gv[j] = gr[64 * j];
        for (int m0 = gw * 4; m0 < T; m0 += NGW * 4) { unsigned long long q[4][4]; float ssv[4];
#pragma unroll
            for (int r = 0; r < 4; ++r) { const unsigned long long* xr = (const unsigned long long*)(XB + (size_t)(m0 + r) * DM) + lane; ssv[r] = lane < 16 ? rss[(size_t)(m0 + r) * 16 + lane] : 0.f;
#pragma unroll
                for (int j = 0; j < 4; ++j) q[r][j] = xr[64 * j]; }
#pragma unroll
            for (int r = 0; r < 4; ++r) { const float rs = rsqrtf(wave_sum(ssv[r]) * (1.f / DM) + 1e-6f); f32x4* orow = (f32x4*)(XF + (size_t)(m0 + r) * DM) + lane;
#pragma unroll
                for (int j = 0; j < 4; ++j) { const unsigned lo = (unsigned)q[r][j], hi2 = (unsigned)(q[r][j] >> 32);
                    const f32x4 v = {__uint_as_float(lo << 16), __uint_as_float(lo & 0xffff0000u), __uint_as_float(hi2 << 16), __uint_as_float(hi2 & 0xffff0000u)};
                    orow[64 * j] = v * rs * gv[j]; } } }
    }
}

extern "C" void kernel_launch(void* const* d_in, const int* in_sizes, int n_in, void* d_out, int out_size, void* d_ws, size_t ws_size, hipStream_t stream) {
    static int grid = 0;
    if (grid == 0) {
        if (n_in != 29 || in_sizes[0] != T * DM || out_size != T * DM || ws_size < WS_END) { fprintf(stderr, "kernel_launch: unexpected shapes (n_in %d, in0 %d, out %d, ws %zu, need %zu)\n", n_in, n_in > 0 ? in_sizes[0] : -1, out_size, ws_size, (size_t)WS_END); grid = -1; return; }
        int dev = 0, cus = 0, per_cu = 0;
        if (hipGetDevice(&dev) != hipSuccess || hipDeviceGetAttribute(&cus, hipDeviceAttributeMultiprocessorCount, dev) != hipSuccess) { fprintf(stderr, "kernel_launch: device query failed\n"); grid = -1; return; }
        if (hipFuncSetAttribute((const void*)mega_fwd, hipFuncAttributeMaxDynamicSharedMemorySize, LDS_BYTES) != hipSuccess) { fprintf(stderr, "kernel_launch: hipFuncSetAttribute failed\n"); grid = -1; return; }
        if (hipOccupancyMaxActiveBlocksPerMultiprocessor(&per_cu, (const void*)mega_fwd, NTHR, LDS_BYTES) != hipSuccess || per_cu < 1) { fprintf(stderr, "kernel_launch: occupancy query says %d blocks per CU\n", per_cu); (void)hipGetLastError(); per_cu = 1; }
        grid = cus;
    }
    if (grid < 0) return;
    Args a{};
    for (int i = 0; i < 29; ++i) a.in[i] = d_in[i];
    a.out = (float*)d_out; a.ws = (unsigned char*)d_ws;
    void* kargs[] = {&a};
    const hipError_t e = hipLaunchCooperativeKernel((const void*)mega_fwd, dim3(grid), dim3(NTHR), kargs, LDS_BYTES, stream);
    if (e != hipSuccess) fprintf(stderr, "kernel_launch: cooperative launch failed: %s (grid %d)\n", hipGetErrorString(e), grid);
}
```

```cpp
#include <hip/hip_runtime.h>
#include <hip/hip_cooperative_groups.h>
#include <cstdio>
#include <cstdint>
namespace cg = cooperative_groups;
#ifndef REP_FA
#define REP_FA 1
#endif
#ifndef REP_LRUA
#define REP_LRUA 1
#endif
#ifndef REP_LRUC
#define REP_LRUC 1
#endif
#ifndef REP_PRO
#define REP_PRO 1
#endif
#ifndef REP_Q
#define REP_Q 1
#endif
#ifndef REP_SYNC
#define REP_SYNC 0
#endif
#ifndef REP_XA
#define REP_XA 1
#endif
#ifndef REP_UP
#define REP_UP 1
#endif
#ifndef REP_IN
#define REP_IN 1
#endif
__device__ __forceinline__ int opaque_tid() { int t = threadIdx.x; asm volatile("" : "+v"(t)); return t; }
namespace pg8 {
#define PG8_LAS __attribute__((address_space(3)))
typedef unsigned short bf16_t;
typedef short bf16x8 __attribute__((ext_vector_type(8)));
typedef float f32x4 __attribute__((ext_vector_type(4)));
typedef unsigned u32x4 __attribute__((ext_vector_type(4)));
constexpr int BM = 256, BK = 64, HALF = 128, HTB = HALF * BK * 2  , STAGE_BYTES = 8 * HTB, NXCD = 8, WGM = 8;

__host__ __device__ __forceinline__ int lds_byte(int r, int c) { const int st = (r >> 4) * 2 + (c >> 5), rr = r & 15, cc = c & 31, ob = rr * 64 + cc * 2; return st * 1024 + (ob ^ (((ob >> 9) & 1) << 5)); }
__host__ __device__ __forceinline__ void stage_rc(int b, int& R, int& C) { const int st = b / 1024, sb = b % 1024, swz = sb ^ (((sb >> 9) & 1) << 5); R = (st >> 1) * 16 + swz / 64; C = (st & 1) * 32 + (swz % 64) / 2; }
__host__ __device__ __forceinline__ int perm32(int rho) { const int n = rho >> 4, i = rho & 15; return 8 * (i >> 2) + 4 * n + (i & 3); }

struct Unit { int pm, pn; };
struct Gemm { const bf16_t* A; const bf16_t* Bt; int M, N, K; };

struct StaticOrder {
    int nM, nN, nwg, G, c;
    __host__ __device__ void init(int M, int N, int G_, int c_) { nM = M / BM; nN = N / BM; nwg = nM * nN; G = G_; c = c_; }
    __host__ __device__ bool next(int i, Unit& u) const {
        const long L = (long)i * G + c; if (L >= nwg) return false;
        int wgid = (int)L; { const int q = nwg / NXCD, r = nwg % NXCD, xcd = wgid % NXCD, off = wgid / NXCD; wgid = (xcd < r ? xcd * (q + 1) : r * (q + 1) + (xcd - r) * q) + off; }
        const int nig = WGM * nN, gid = wgid / nig, fm = gid * WGM, gsz = (nM - fm) < WGM ? (nM - fm) : WGM;
        u.pm = fm + ((wgid % nig) % gsz); u.pn = (wgid % nig) / gsz; return true;
    }
    __device__ __forceinline__ void a_ready(const Unit&) const {}
    __device__ __forceinline__ void done(const Unit&) const {}
};

__device__ __forceinline__ unsigned cvt_pk_bf16(float lo, float hi) { unsigned r; asm volatile("v_cvt_pk_bf16_f32 %0, %1, %2" : "=v"(r) : "v"(lo), "v"(hi)); return r; }
template <class Epi, class Sched, bool ALIGN_EPI = false, bool SP2 = false>
__device__ __forceinline__ void gemm_phase(PG8_LAS unsigned char* lds, const Gemm g, const Sched& S, const Epi& E) {
    const int tid = opaque_tid(), wid = __builtin_amdgcn_readfirstlane(tid >> 6), lane = tid & 63, wr = wid >> 2, wc = wid & 3, fr = lane & 15, fq = lane >> 4;
    const int K = g.K, nt = K / BK;
    unsigned voffA[2], voffB[2];
#pragma unroll
    for (int i = 0; i < 2; ++i) { int R, C; stage_rc(tid * 16 + i * 8192, R, C); const int Rb = Epi::PERM ? ((R & ~31) + perm32(R & 31)) : R;
        voffA[i] = (unsigned)(R * K + C) * 2u; voffB[i] = (unsigned)(Rb * K + C) * 2u; }
    const size_t kstep = (size_t)(BK * 2);
    const size_t hstep = (size_t)HALF * K * 2;
    const size_t tstep = 2 * hstep;
    const unsigned ldsw = (unsigned)wid * 1024u;
    const int aoff = lds_byte(wr * 64 + fr, fq * 8), boff = lds_byte(wc * 32 + fr, fq * 8);
#define PG8_SA(b, h) (((b) * 2 + (h)) * HTB)
#define PG8_SB(b, h) ((4 + (b) * 2 + (h)) * HTB)
#define PG8_STAGE(bufoff, gbase, voff) do { _Pragma("unroll") for (int _i = 0; _i < 2; ++_i) \
        __builtin_amdgcn_global_load_lds((const unsigned*)((const char*)(gbase) + (voff)[_i]), (PG8_LAS unsigned*)(lds + (bufoff) + ldsw + _i * 8192), 16, 0, 0); } while (0)
#define PG8_LDA(dst, b, h) do { _Pragma("unroll") for (int m = 0; m < 4; ++m) _Pragma("unroll") for (int k = 0; k < 2; ++k) dst[m][k] = *(const PG8_LAS bf16x8*)(lds + PG8_SA(b, h) + aoff + m * 2048 + k * 1024); } while (0)
#define PG8_LDB(dst, b, h) do { _Pragma("unroll") for (int n = 0; n < 2; ++n) _Pragma("unroll") for (int k = 0; k < 2; ++k) dst[n][k] = *(const PG8_LAS bf16x8*)(lds + PG8_SB(b, h) + boff + n * 2048 + k * 1024); } while (0)
#define PG8_MMA(ai, bj, At, Bt) do { __builtin_amdgcn_s_setprio(1); _Pragma("unroll") for (int m = 0; m < 4; ++m) _Pragma("unroll") for (int n = 0; n < 2; ++n) _Pragma("unroll") for (int k = 0; k < 2; ++k) \
        acc[ai][bj][m][n] = __builtin_amdgcn_mfma_f32_16x16x32_bf16(Bt[n][k], At[m][k], acc[ai][bj][m][n], 0, 0, 0); __builtin_amdgcn_s_setprio(0); } while (0)
#define PG8_WAIT_V(n) asm volatile("s_waitcnt vmcnt(" #n ")" ::: "memory")
#define PG8_WAIT_L(n) asm volatile("s_waitcnt lgkmcnt(" #n ")" ::: "memory")
#define PG8_BAR __builtin_amdgcn_s_barrier()
#define PG8_SCHED __builtin_amdgcn_sched_barrier(0)
    Unit cur, nxt; int ui = 0;
    if (!S.next(0, cur)) return;
    f32x4 acc[2][2][4][2];
#pragma unroll
    for (int a = 0; a < 2; ++a)
#pragma unroll
        for (int b = 0; b < 2; ++b)
#pragma unroll
            for (int m = 0; m < 4; ++m)
#pragma unroll
                for (int n = 0; n < 2; ++n) acc[a][b][m][n] = (f32x4){0.f, 0.f, 0.f, 0.f};
    bf16x8 At[4][2], B0[2][2], B1[2][2];
    const char* cA = (const char*)g.A + (size_t)cur.pm * tstep; const char* cB = (const char*)g.Bt + (size_t)cur.pn * tstep;
    S.a_ready(cur);
    if constexpr (SP2) {
        PG8_STAGE(PG8_SB(0, 0), cB, voffB); PG8_STAGE(PG8_SB(0, 1), cB + hstep, voffB); PG8_STAGE(PG8_SA(0, 0), cA, voffA); PG8_STAGE(PG8_SA(0, 1), cA + hstep, voffA);
        if (wr == 1) PG8_BAR;
        PG8_WAIT_V(2); PG8_BAR;
        PG8_STAGE(PG8_SB(1, 0), cB + kstep, voffB); PG8_STAGE(PG8_SA(1, 0), cA + kstep, voffA); PG8_STAGE(PG8_SB(1, 1), cB + hstep + kstep, voffB);
        PG8_WAIT_V(6); PG8_BAR;
    } else {
        PG8_STAGE(PG8_SB(0, 0), cB, voffB); PG8_STAGE(PG8_SA(0, 0), cA, voffA); PG8_STAGE(PG8_SB(0, 1), cB + hstep, voffB); PG8_STAGE(PG8_SA(0, 1), cA + hstep, voffA);
        if (wr == 1) PG8_BAR;
        PG8_WAIT_V(4); PG8_BAR;
        PG8_STAGE(PG8_SB(1, 0), cB + kstep, voffB); PG8_STAGE(PG8_SA(1, 0), cA + kstep, voffA); PG8_STAGE(PG8_SB(1, 1), cB + hstep + kstep, voffB);
        PG8_WAIT_V(6); PG8_BAR;
    }
    for (;;) {
        const bool has_next = S.next(ui + 1, nxt);
        const char* nA = has_next ? (const char*)g.A + (size_t)nxt.pm * tstep : cA; const char* nB = has_next ? (const char*)g.Bt + (size_t)nxt.pn * tstep : cB;
        for (int t = 0; t < nt; t += 2) {
            const bool last = (t == nt - 2);
            const char* a1 = cA + (size_t)(t + 1) * kstep;
            const char* a2 = last ? nA : cA + (size_t)(t + 2) * kstep; const char* b2 = last ? nB : cB + (size_t)(t + 2) * kstep;
            const char* a3 = a2 + kstep; const char* b3 = b2 + kstep;
            if (last && has_next) S.a_ready(nxt);
            if constexpr (SP2) {
            PG8_LDB(B0, 0, 0); PG8_LDB(B1, 0, 1); PG8_SCHED; PG8_LDA(At, 0, 0); PG8_STAGE(PG8_SA(1, 1), a1 + hstep, voffA);
            PG8_WAIT_V(8); PG8_WAIT_L(0); PG8_BAR; PG8_MMA(0, 0, At, B0); PG8_MMA(0, 1, At, B1); PG8_BAR; PG8_SCHED;
            PG8_LDA(At, 0, 1); PG8_STAGE(PG8_SB(0, 0), b2, voffB); PG8_STAGE(PG8_SB(0, 1), b2 + hstep, voffB); PG8_STAGE(PG8_SA(0, 0), a2, voffA);
            PG8_WAIT_V(8); PG8_WAIT_L(0); PG8_BAR; PG8_MMA(1, 0, At, B0); PG8_MMA(1, 1, At, B1); PG8_BAR; PG8_SCHED;
            PG8_LDB(B0, 1, 0); PG8_LDB(B1, 1, 1); PG8_SCHED; PG8_LDA(At, 1, 0); PG8_STAGE(PG8_SA(0, 1), a2 + hstep, voffA);
            PG8_WAIT_V(8); PG8_WAIT_L(0); PG8_BAR; PG8_MMA(0, 0, At, B0); PG8_MMA(0, 1, At, B1); PG8_BAR; PG8_SCHED;
            PG8_LDA(At, 1, 1); PG8_STAGE(PG8_SB(1, 0), b3, voffB); PG8_STAGE(PG8_SB(1, 1), b3 + hstep, voffB); PG8_STAGE(PG8_SA(1, 0), a3, voffA);
            PG8_WAIT_V(8); PG8_WAIT_L(0); PG8_BAR; PG8_MMA(1, 0, At, B0); PG8_MMA(1, 1, At, B1); PG8_BAR; PG8_SCHED;
            } else {
            PG8_LDB(B0, 0, 0); PG8_SCHED; PG8_LDA(At, 0, 0); PG8_STAGE(PG8_SA(1, 1), a1 + hstep, voffA);
            PG8_WAIT_L(8); PG8_BAR; PG8_WAIT_L(0); PG8_MMA(0, 0, At, B0); PG8_BAR; PG8_SCHED;
            PG8_LDB(B1, 0, 1); PG8_STAGE(PG8_SB(0, 0), b2, voffB);
            PG8_BAR; PG8_WAIT_L(0); PG8_MMA(0, 1, At, B1); PG8_BAR;
            PG8_LDA(At, 0, 1); PG8_STAGE(PG8_SA(0, 0), a2, voffA);
            PG8_BAR; PG8_WAIT_L(0); PG8_MMA(1, 0, At, B0); PG8_BAR; PG8_SCHED;
            PG8_STAGE(PG8_SB(0, 1), b2 + hstep, voffB);
            PG8_WAIT_V(6); PG8_BAR; PG8_MMA(1, 1, At, B1); PG8_BAR;
            PG8_LDB(B0, 1, 0); PG8_SCHED; PG8_LDA(At, 1, 0); PG8_STAGE(PG8_SA(0, 1), a2 + hstep, voffA);
            PG8_WAIT_L(8); PG8_BAR; PG8_WAIT_L(0); PG8_MMA(0, 0, At, B0); PG8_BAR; PG8_SCHED;
            PG8_LDB(B1, 1, 1); PG8_STAGE(PG8_SB(1, 0), b3, voffB);
            PG8_BAR; PG8_WAIT_L(0); PG8_MMA(0, 1, At, B1); PG8_BAR;
            PG8_LDA(At, 1, 1); PG8_STAGE(PG8_SA(1, 0), a3, voffA);
            PG8_BAR; PG8_WAIT_L(0); PG8_MMA(1, 0, At, B0); PG8_BAR; PG8_SCHED;
            PG8_STAGE(PG8_SB(1, 1), b3 + hstep, voffB);
            PG8_WAIT_V(6); PG8_BAR; PG8_MMA(1, 1, At, B1); PG8_BAR;
            }
        }
        if constexpr (ALIGN_EPI) { if (wr == 0) PG8_BAR; }
        if constexpr (!Epi::AFTER_DRAIN) { E(acc, cur, wr, wc, fr, fq); S.done(cur); }
        if (!has_next) break;
#pragma unroll
        for (int a = 0; a < 2; ++a)
#pragma unroll
            for (int b = 0; b < 2; ++b)
#pragma unroll
                for (int m = 0; m < 4; ++m)
#pragma unroll
                    for (int n = 0; n < 2; ++n) acc[a][b][m][n] = (f32x4){0.f, 0.f, 0.f, 0.f};
        cur = nxt; cA = nA; cB = nB; ++ui;
        if constexpr (ALIGN_EPI) { if (wr == 1) PG8_BAR; }
    }
    PG8_WAIT_V(0);
    if constexpr (!ALIGN_EPI) { if (wr == 0) PG8_BAR; }
    PG8_BAR;
    if constexpr (Epi::AFTER_DRAIN) { E.fused(acc, cur, wr, wc, fr, fq, lds, wid, lane); S.done(cur); }
#undef PG8_SA
#undef PG8_SB
#undef PG8_STAGE
#undef PG8_LDA
#undef PG8_LDB
#undef PG8_MMA
#undef PG8_WAIT_V
#undef PG8_WAIT_L
#undef PG8_BAR
#undef PG8_SCHED
}
}
namespace pg8 {
typedef unsigned u32x4e __attribute__((ext_vector_type(4)));
template <int MODE> struct EpiScale {
    static constexpr bool PERM = true, AFTER_DRAIN = false;
    bf16_t* O; int ldc; const float* rss; float cs; const float* rope;
    __device__ __forceinline__ void operator()(const f32x4 (&acc)[2][2][4][2], const Unit& u, int wr, int wc, int fr, int fq) const {
        const int row0 = u.pm * BM + wr * 64 + fr, col0 = u.pn * BM + wc * 32 + 8 * fq;
        const bool ropew = (MODE == 1) && (u.pn < 4) && ((wc & 1) == 0);
#pragma unroll
        for (int ai = 0; ai < 2; ++ai)
#pragma unroll
            for (int m = 0; m < 4; ++m) {
                const int row = row0 + ai * HALF + m * 16;
                float rs = 1.f;
                if (MODE != 0) { const f32x4 q0 = *((const f32x4*)(rss + (size_t)row * 16) + fq);
                    float sq = (q0[0] + q0[1]) + (q0[2] + q0[3]); sq += __shfl_xor(sq, 16); sq += __shfl_xor(sq, 32);
                    rs = rsqrtf(sq * (1.f / 1024.f) + 1e-6f); }
                if (MODE == 2) rs *= cs;
                f32x4 cv0 = {1.f, 1.f, 1.f, 1.f}, cv1 = cv0, sv0 = {0.f, 0.f, 0.f, 0.f}, sv1 = sv0;
                if (ropew) { const float* rp = rope + (size_t)row * 16; cv0 = *(const f32x4*)rp; cv1 = *(const f32x4*)(rp + 4); sv0 = *(const f32x4*)(rp + 8); sv1 = *(const f32x4*)(rp + 12); }
#pragma unroll
                for (int bj = 0; bj < 2; ++bj) {
                    f32x4 v0 = acc[ai][bj][m][0] * rs, v1 = acc[ai][bj][m][1] * rs;
                    if (MODE == 1) {
                        if (ropew) {
                            f32x4 o0, o1;
#pragma unroll
                            for (int j = 0; j < 4; ++j) { o0[j] = __shfl_xor(v0[j], 16); o1[j] = __shfl_xor(v1[j], 16); }
                            if (fq == 0) { v0 = v0 * cv0 - o0 * sv0; v1 = v1 * cv1 - o1 * sv1; }
                            else if (fq == 1) { v0 = v0 * cv0 + o0 * sv0; v1 = v1 * cv1 + o1 * sv1; }
                        }
                        if (u.pn < 2) { v0 = v0 * cs; v1 = v1 * cs; }
                    }
                    if (MODE == 3) {
#pragma unroll
                        for (int j = 0; j < 4; ++j) { const float a = fmaxf(v0[j], 0.f), b = fmaxf(v1[j], 0.f); v0[j] = a * a; v1[j] = b * b; }
                    }
                    u32x4e w; w.x = cvt_pk_bf16(v0[0], v0[1]); w.y = cvt_pk_bf16(v0[2], v0[3]); w.z = cvt_pk_bf16(v1[0], v1[1]); w.w = cvt_pk_bf16(v1[2], v1[3]);
                    *(u32x4e*)(O + (size_t)row * ldc + col0 + bj * HALF) = w;
                }
            }
    }
};
template <bool F32BASE> struct EpiRes {
    static constexpr bool PERM = true, AFTER_DRAIN = false;
    const float* basef; bf16_t* xb; float* rss;
    __device__ __forceinline__ void operator()(const f32x4 (&acc)[2][2][4][2], const Unit& u, int wr, int wc, int fr, int fq) const {
        const int row0 = u.pm * BM + wr * 64 + fr, col0 = u.pn * BM + wc * 32 + 8 * fq;
#pragma unroll
        for (int ai = 0; ai < 2; ++ai)
#pragma unroll
            for (int m = 0; m < 4; ++m) {
                const int row = row0 + ai * HALF + m * 16; float ss = 0.f;
#pragma unroll
                for (int bj = 0; bj < 2; ++bj) {
                    const size_t off = (size_t)row * 1024 + col0 + bj * HALF;
                    f32x4 b0, b1;
                    if (F32BASE) { b0 = *(const f32x4*)(basef + off); b1 = *(const f32x4*)(basef + off + 4); }
                    else { const u32x4e q = *(const u32x4e*)(xb + off);
                        b0 = (f32x4){__uint_as_float(q.x << 16), __uint_as_float(q.x & 0xffff0000u), __uint_as_float(q.y << 16), __uint_as_float(q.y & 0xffff0000u)};
                        b1 = (f32x4){__uint_as_float(q.z << 16), __uint_as_float(q.z & 0xffff0000u), __uint_as_float(q.w << 16), __uint_as_float(q.w & 0xffff0000u)}; }
                    const f32x4 v0 = acc[ai][bj][m][0] + b0, v1 = acc[ai][bj][m][1] + b1;
                    u32x4e w; w.x = cvt_pk_bf16(v0[0], v0[1]); w.y = cvt_pk_bf16(v0[2], v0[3]); w.z = cvt_pk_bf16(v1[0], v1[1]); w.w = cvt_pk_bf16(v1[2], v1[3]);
                    *(u32x4e*)(xb + off) = w;
                    ss += (v0[0] * v0[0] + v0[1] * v0[1]) + (v0[2] * v0[2] + v0[3] * v0[3]) + (v1[0] * v1[0] + v1[1] * v1[1]) + (v1[2] * v1[2] + v1[3] * v1[3]);
                }
                ss += __shfl_xor(ss, 16); ss += __shfl_xor(ss, 32);
                if (fq == 0) rss[(size_t)row * 16 + u.pn * 4 + wc] = ss;
            }
    }
};
}
namespace fa {
typedef unsigned short bf16_t;
using bf16x8 = __attribute__((ext_vector_type(8))) short;
using s16x4  = __attribute__((ext_vector_type(4))) short;
using f32x16 = __attribute__((ext_vector_type(16))) float;
using u32x4  = __attribute__((ext_vector_type(4))) unsigned;
#define FA_SBAR() __builtin_amdgcn_sched_barrier(0)
__device__ __forceinline__ int crow(int r, int hi) { return (r & 3) + 8 * (r >> 2) + 4 * hi; }
__device__ __forceinline__ unsigned cvtpk(float lo, float hi) { unsigned r; asm volatile("v_cvt_pk_bf16_f32 %0, %1, %2" : "=v"(r) : "v"(lo), "v"(hi)); return r; }
__device__ __forceinline__ int v_st(int k, int c) { const int kk = (k & ~0xC) | ((k & 4) << 1) | ((k & 8) >> 1); return ((kk >> 3) * 4 + (c >> 5)) * 512 + ((kk & 7) * 32 + (c & 31)) * 2; }
__device__ __forceinline__ int v_rd_base(int lane) { return ((lane & 3) << 3) | (((lane >> 2) & 3) << 6) | (((lane >> 4) & 1) << 5) | (((lane >> 5) & 1) << 8); }
constexpr int v_rd_off(int d0, int ks, int half) { return d0 * 512 + ks * 4096 + half * 2048; }
template <int OFF> __device__ __forceinline__ s16x4 tr_read(int vb) { s16x4 r; asm volatile("ds_read_b64_tr_b16 %0, %1 offset:%2" : "=&v"(r) : "v"(vb), "i"(OFF) : "memory"); return r; }
template <int D0> __device__ __forceinline__ void pv_one(f32x16& od, int vb, bf16x8 pa0, bf16x8 pa1, bf16x8 pa2, bf16x8 pa3) {
  const s16x4 l0 = tr_read<v_rd_off(D0, 0, 0)>(vb), h0 = tr_read<v_rd_off(D0, 0, 1)>(vb), l1 = tr_read<v_rd_off(D0, 1, 0)>(vb), h1 = tr_read<v_rd_off(D0, 1, 1)>(vb);
  const s16x4 l2 = tr_read<v_rd_off(D0, 2, 0)>(vb), h2 = tr_read<v_rd_off(D0, 2, 1)>(vb), l3 = tr_read<v_rd_off(D0, 3, 0)>(vb), h3 = tr_read<v_rd_off(D0, 3, 1)>(vb);
  asm volatile("s_waitcnt lgkmcnt(0)" ::: "memory"); FA_SBAR();
#define FA_PK(L, H) (bf16x8){L[0], L[1], L[2], L[3], H[0], H[1], H[2], H[3]}
  od = __builtin_amdgcn_mfma_f32_32x32x16_bf16(pa0, FA_PK(l0, h0), od, 0, 0, 0);
  od = __builtin_amdgcn_mfma_f32_32x32x16_bf16(pa1, FA_PK(l1, h1), od, 0, 0, 0);
  od = __builtin_amdgcn_mfma_f32_32x32x16_bf16(pa2, FA_PK(l2, h2), od, 0, 0, 0);
  od = __builtin_amdgcn_mfma_f32_32x32x16_bf16(pa3, FA_PK(l3, h3), od, 0, 0, 0);
#undef FA_PK
}
__device__ __forceinline__ void pv_d0(f32x16* o, int vb, bf16x8 pa0, bf16x8 pa1, bf16x8 pa2, bf16x8 pa3) {
  pv_one<0>(o[0], vb, pa0, pa1, pa2, pa3); pv_one<1>(o[1], vb, pa0, pa1, pa2, pa3); pv_one<2>(o[2], vb, pa0, pa1, pa2, pa3); pv_one<3>(o[3], vb, pa0, pa1, pa2, pa3);
}
template <int DQK, bool QREG> __device__ __forceinline__ void qkt(f32x16& p0, f32x16& p1, const char* Ks, const bf16x8* qr, const bf16_t* qsrc, int r32, int hi) {
  constexpr int KROWB = DQK * 2;
  p0 = f32x16{}; p1 = f32x16{};
  if constexpr (QREG) {
#pragma unroll
    for (int d0 = 0; d0 < DQK / 16; ++d0) { const int cb = (d0 * 16 + hi * 8) * 2;
      const int sw = (DQK == 64) ? (((r32 >> 1) & 7) << 4) : ((r32 & 7) << 4);
      const bf16x8 b0 = *reinterpret_cast<const bf16x8*>(Ks + r32 * KROWB + (cb ^ sw));
      const bf16x8 b1 = *reinterpret_cast<const bf16x8*>(Ks + (32 + r32) * KROWB + (cb ^ sw));
      p0 = __builtin_amdgcn_mfma_f32_32x32x16_bf16(b0, qr[d0], p0, 0, 0, 0);
      p1 = __builtin_amdgcn_mfma_f32_32x32x16_bf16(b1, qr[d0], p1, 0, 0, 0); }
  } else {
    typedef __attribute__((address_space(1))) const bf16x8 gq_t;
#pragma unroll
    for (int g = 0; g < DQK / 128; ++g) { bf16x8 qv[8];
#pragma unroll
      for (int i = 0; i < 8; ++i) qv[i] = *(gq_t*)(qsrc + (g * 8 + i) * 16);
#pragma unroll
      for (int i = 0; i < 8; ++i) { const int d0 = g * 8 + i, cb = (d0 * 16 + hi * 8) * 2;
        const bf16x8 b0 = *reinterpret_cast<const bf16x8*>(Ks + r32 * KROWB + (cb ^ ((r32 & 7) << 4)));
        const bf16x8 b1 = *reinterpret_cast<const bf16x8*>(Ks + (32 + r32) * KROWB + (cb ^ ((r32 & 7) << 4)));
        p0 = __builtin_amdgcn_mfma_f32_32x32x16_bf16(b0, qv[i], p0, 0, 0, 0);
        p1 = __builtin_amdgcn_mfma_f32_32x32x16_bf16(b1, qv[i], p1, 0, 0, 0); } }
  }
}
__device__ __forceinline__ void softmax_tile(f32x16& p0, f32x16& p1, float& m_reg, float& l_reg, float& alpha, bf16x8& pa0, bf16x8& pa1, bf16x8& pa2, bf16x8& pa3) {
  float pmax = p0[0];
#pragma unroll
  for (int r = 1; r < 16; ++r) pmax = fmaxf(pmax, p0[r]);
#pragma unroll
  for (int r = 0; r < 16; ++r) pmax = fmaxf(pmax, p1[r]);
  { auto rr = __builtin_amdgcn_permlane32_swap(__float_as_uint(pmax), __float_as_uint(pmax), false, false); pmax = fmaxf(__uint_as_float(rr[0]), __uint_as_float(rr[1])); }
  if (__builtin_expect(__all(pmax - m_reg <= 8.f), 1)) { alpha = 1.f; }
  else { const float mn = fmaxf(m_reg, pmax); alpha = __builtin_amdgcn_exp2f(m_reg - mn); m_reg = mn; }
  const float mneg = -m_reg;
#pragma unroll
  for (int r = 0; r < 16; ++r) { p0[r] = __builtin_amdgcn_exp2f(p0[r] + mneg); p1[r] = __builtin_amdgcn_exp2f(p1[r] + mneg); }
  float ps = 0.f;
#pragma unroll
  for (int r = 0; r < 16; ++r) ps += p0[r];
#pragma unroll
  for (int r = 0; r < 16; ++r) ps += p1[r];
  { auto rr = __builtin_amdgcn_permlane32_swap(__float_as_uint(ps), __float_as_uint(ps), false, false); ps = __uint_as_float(rr[0]) + __uint_as_float(rr[1]); }
  l_reg = l_reg * alpha + ps;
#define FA_PK4(P, BASE, OUT) do { unsigned a0 = cvtpk(P[BASE + 0], P[BASE + 1]), a1 = cvtpk(P[BASE + 2], P[BASE + 3]);   \
    unsigned b0 = cvtpk(P[BASE + 4], P[BASE + 5]), b1 = cvtpk(P[BASE + 6], P[BASE + 7]);                              \
    auto r0 = __builtin_amdgcn_permlane32_swap(a0, b0, false, false); auto r1 = __builtin_amdgcn_permlane32_swap(a1, b1, false, false); \
    u32x4 w = {r0[0], r1[0], r0[1], r1[1]}; OUT = *reinterpret_cast<bf16x8*>(&w); } while (0)
  FA_PK4(p0, 0, pa0); FA_PK4(p0, 8, pa1); FA_PK4(p1, 0, pa2); FA_PK4(p1, 8, pa3);
#undef FA_PK4
}
template <int DQK>
__device__ __forceinline__ void flash_unit(const bf16_t* __restrict__ Qb, int ldq, const bf16_t* __restrict__ Kh, int ldk,
                                           const bf16_t* __restrict__ Vh, int ldv, bf16_t* __restrict__ Ob, int ldo, int nkeys, char* lds) {
  constexpr int KROWB = DQK * 2, SHM_K = 64 * KROWB, SHM_V = 16384, ND = DQK / 16, NKL = DQK / 64, CPR = DQK / 8;
  const int tid = opaque_tid(), wid = tid >> 6, lane = tid & 63, r32 = lane & 31, hi = lane >> 5;
  char* V_lds = lds; char* K_lds = lds + 2 * SHM_V;
  float* ws = (float*)(lds + 2 * SHM_V + 2 * SHM_K) + wid * 64; float* li_l = ws; float* al_l = ws + 32;
  constexpr bool QREG = (DQK <= 64);
  float m_reg = -1e30f, l_reg = 0.f; f32x16 o[4] = {}; bf16x8 qr[QREG ? ND : 1];
  const bf16_t* Qw = Qb + (long)(wid * 32 + r32) * ldq + hi * 8;
#pragma unroll
  for (int d0 = 0; d0 < (QREG ? ND : 1); ++d0) qr[d0] = *reinterpret_cast<const bf16x8*>(Qw + d0 * 16);
  const int vr = tid >> 4, vc = (tid & 15) * 8, vst0 = v_st(vr, vc), vst1 = v_st(32 + vr, vc);
  const int vb0 = (int)(uintptr_t)V_lds + v_rd_base(lane);
  bf16x8 vs0, vs1, ksg[NKL];
#define FA_SLOAD(k0) do { vs0 = *reinterpret_cast<const bf16x8*>(Vh + (long)((k0) + vr) * ldv + vc); vs1 = *reinterpret_cast<const bf16x8*>(Vh + (long)((k0) + 32 + vr) * ldv + vc); \
    _Pragma("unroll") for (int i_ = 0; i_ < NKL; ++i_) { const int q_ = tid + 512 * i_, row_ = q_ / CPR, ch_ = q_ % CPR; ksg[i_] = *reinterpret_cast<const bf16x8*>(Kh + (long)((k0) + row_) * ldk + ch_ * 8); } } while (0)
#define FA_SWRITE(b) do { *(bf16x8*)(V_lds + (b) * SHM_V + vst0) = vs0; *(bf16x8*)(V_lds + (b) * SHM_V + vst1) = vs1; \
    _Pragma("unroll") for (int i_ = 0; i_ < NKL; ++i_) { const int q_ = tid + 512 * i_, row_ = q_ / CPR, ch_ = q_ % CPR; \
      *(bf16x8*)(K_lds + (b) * SHM_K + row_ * KROWB + ((ch_ * 16) ^ ((DQK == 64 ? ((row_ >> 1) & 7) : (row_ & 7)) << 4))) = ksg[i_]; } } while (0)
#define FA_RESC(a) do { if (__any((a) < 1.f)) { if (hi == 0) al_l[r32] = (a); asm volatile("s_waitcnt lgkmcnt(0)" ::: "memory"); \
    _Pragma("unroll") for (int d_ = 0; d_ < 4; ++d_) _Pragma("unroll") for (int r_ = 0; r_ < 16; ++r_) o[d_][r_] *= al_l[crow(r_, hi)]; } } while (0)
#define FA_TILE(b) do { f32x16 p0, p1; float alpha; bf16x8 pa0, pa1, pa2, pa3; \
    const bf16_t* qs_ = Qw; asm volatile("" : "+v"(qs_)); qkt<DQK, QREG>(p0, p1, K_lds + (b) * SHM_K, qr, qs_, r32, hi); softmax_tile(p0, p1, m_reg, l_reg, alpha, pa0, pa1, pa2, pa3); FA_RESC(alpha); \
    pv_d0(o, vb0 + (b) * SHM_V, pa0, pa1, pa2, pa3); } while (0)
  const int NT = nkeys / 64;
  FA_SLOAD(0); FA_SWRITE(0); __syncthreads();
  for (int j = 0; j < NT; j += 2) {
    FA_SLOAD((j + 1) * 64);
    FA_TILE(0);
    FA_SWRITE(1); __syncthreads();
    if (j + 2 < NT) FA_SLOAD((j + 2) * 64);
    FA_TILE(1);
    if (j + 2 < NT) FA_SWRITE(0);
    __syncthreads();
  }
  if (hi == 0) li_l[r32] = l_reg; asm volatile("s_waitcnt lgkmcnt(0)" ::: "memory");
  float rli[16];
#pragma unroll
  for (int r = 0; r < 16; ++r) rli[r] = __builtin_amdgcn_rcpf(li_l[crow(r, hi)]);
  bf16_t* Ow = Ob + (long)(wid * 32) * ldo;
#pragma unroll
  for (int r = 0; r < 16; ++r) { const int orow = crow(r, hi);
#pragma unroll
    for (int d0 = 0; d0 < 4; ++d0) { const float v = o[d0][r] * rli[r]; Ow[(long)orow * ldo + d0 * 32 + r32] = (bf16_t)(cvtpk(v, v) & 0xffffu); } }
  __syncthreads();
#undef FA_SLOAD
#undef FA_SWRITE
#undef FA_RESC
#undef FA_TILE
}

__device__ __forceinline__ void partialSM(f32x16& p0, f32x16& p1, float& m_reg, float& alpha) {
  float pmax = p0[0];
#pragma unroll
  for (int r = 1; r < 16; ++r) pmax = fmaxf(pmax, p0[r]);
#pragma unroll
  for (int r = 0; r < 16; ++r) pmax = fmaxf(pmax, p1[r]);
  { auto rr = __builtin_amdgcn_permlane32_swap(__float_as_uint(pmax), __float_as_uint(pmax), false, false); pmax = fmaxf(__uint_as_float(rr[0]), __uint_as_float(rr[1])); }
  if (__builtin_expect(__all(pmax - m_reg <= 8.f), 1)) { alpha = 1.f; }
  else { const float mn = fmaxf(m_reg, pmax); alpha = __builtin_amdgcn_exp2f(m_reg - mn); m_reg = mn; }
  const float mneg = -m_reg;
#pragma unroll
  for (int r = 0; r < 16; ++r) { p0[r] += mneg; p1[r] += mneg; }
#pragma unroll
  for (int r = 0; r < 16; ++r) p0[r] = __builtin_amdgcn_exp2f(p0[r]);
}
__device__ __forceinline__ void finishSM(f32x16& p0, f32x16& p1, float alpha, float& l_reg, bf16x8& pa0, bf16x8& pa1, bf16x8& pa2, bf16x8& pa3) {
#pragma unroll
  for (int r = 0; r < 16; ++r) p1[r] = __builtin_amdgcn_exp2f(p1[r]);
  float ps = 0.f;
#pragma unroll
  for (int r = 0; r < 16; ++r) ps += p0[r];
#pragma unroll
  for (int r = 0; r < 16; ++r) ps += p1[r];
  { auto rr = __builtin_amdgcn_permlane32_swap(__float_as_uint(ps), __float_as_uint(ps), false, false); ps = __uint_as_float(rr[0]) + __uint_as_float(rr[1]); }
  l_reg = l_reg * alpha + ps;
#define FA_PK4(P, BASE, OUT) do { unsigned a0 = cvtpk(P[BASE + 0], P[BASE + 1]), a1 = cvtpk(P[BASE + 2], P[BASE + 3]);   \
    unsigned b0 = cvtpk(P[BASE + 4], P[BASE + 5]), b1 = cvtpk(P[BASE + 6], P[BASE + 7]);                              \
    auto r0 = __builtin_amdgcn_permlane32_swap(a0, b0, false, false); auto r1 = __builtin_amdgcn_permlane32_swap(a1, b1, false, false); \
    u32x4 w = {r0[0], r1[0], r0[1], r1[1]}; OUT = *reinterpret_cast<bf16x8*>(&w); } while (0)
  FA_PK4(p0, 0, pa0); FA_PK4(p0, 8, pa1); FA_PK4(p1, 0, pa2); FA_PK4(p1, 8, pa3);
#undef FA_PK4
}
__device__ __forceinline__ void flash_unit64(const bf16_t* __restrict__ Qb, int ldq, const bf16_t* __restrict__ Kh, int ldk,
                                             const bf16_t* __restrict__ Vh, int ldv, bf16_t* __restrict__ Ob, int ldo, int nkeys, char* lds) {
  constexpr int DQK = 64, KROWB = 128, SHM_K = 8192, SHM_V = 16384;
  const int tid = opaque_tid(), wid = tid >> 6, lane = tid & 63, r32 = lane & 31, hi = lane >> 5;
  char* V_lds = lds; char* K_lds = lds + 2 * SHM_V;
  float* ws = (float*)(lds + 2 * SHM_V + 2 * SHM_K) + wid * 64; float* li_l = ws; float* al_l = ws + 32;
  float m_reg = -1e30f, l_reg = 0.f; f32x16 o[4] = {}; bf16x8 qr[4];
  const bf16_t* Qw = Qb + (long)(wid * 32 + r32) * ldq + hi * 8;
#pragma unroll
  for (int d0 = 0; d0 < 4; ++d0) qr[d0] = *reinterpret_cast<const bf16x8*>(Qw + d0 * 16);
  const int vr = tid >> 4, vc = (tid & 15) * 8, vst0 = v_st(vr, vc), vst1 = v_st(32 + vr, vc);
  const int kr = tid >> 3, kc = tid & 7, kst = kr * KROWB + ((kc * 16) ^ (((kr >> 1) & 7) << 4));
  const int vb0 = (int)(uintptr_t)V_lds + v_rd_base(lane);
  bf16x8 vsA0, vsA1, ksA, vsB0, vsB1, ksB;
#define F2_SLOAD(S, k0) do { vs##S##0 = *reinterpret_cast<const bf16x8*>(Vh + (long)((k0) + vr) * ldv + vc); vs##S##1 = *reinterpret_cast<const bf16x8*>(Vh + (long)((k0) + 32 + vr) * ldv + vc); \
    ks##S = *reinterpret_cast<const bf16x8*>(Kh + (long)((k0) + kr) * ldk + kc * 8); } while (0)
#define F2_SWRITE(b, S) do { *(bf16x8*)(V_lds + (b) * SHM_V + vst0) = vs##S##0; *(bf16x8*)(V_lds + (b) * SHM_V + vst1) = vs##S##1; *(bf16x8*)(K_lds + (b) * SHM_K + kst) = ks##S; } while (0)
#define F2_RESC(a) do { if (__any((a) < 1.f)) { if (hi == 0) al_l[r32] = (a); asm volatile("s_waitcnt lgkmcnt(0)" ::: "memory"); \
    _Pragma("unroll") for (int d_ = 0; d_ < 4; ++d_) _Pragma("unroll") for (int r_ = 0; r_ < 16; ++r_) o[d_][r_] *= al_l[crow(r_, hi)]; } } while (0)
  f32x16 pA0, pA1, pB0, pB1; float alA, alB; bf16x8 pa0, pa1, pa2, pa3; const int NT = nkeys / 64;
  F2_SLOAD(A, 0); F2_SWRITE(0, A); __syncthreads();
  qkt<DQK, true>(pA0, pA1, K_lds, qr, nullptr, r32, hi); partialSM(pA0, pA1, m_reg, alA);
  F2_SLOAD(B, 64); if (2 < NT) F2_SLOAD(A, 128);
  F2_SWRITE(1, B); __syncthreads();
  for (int j = 1; j + 1 < NT; j += 2) {
    FA_SBAR(); qkt<DQK, true>(pB0, pB1, K_lds + SHM_K, qr, nullptr, r32, hi);
    finishSM(pA0, pA1, alA, l_reg, pa0, pa1, pa2, pa3); FA_SBAR();
    F2_SLOAD(B, (j + 2) * 64); FA_SBAR();
    pv_d0(o, vb0, pa0, pa1, pa2, pa3); partialSM(pB0, pB1, m_reg, alB);
    __syncthreads(); F2_SWRITE(0, A);
    F2_RESC(alB); __syncthreads();
    FA_SBAR(); qkt<DQK, true>(pA0, pA1, K_lds, qr, nullptr, r32, hi);
    finishSM(pB0, pB1, alB, l_reg, pa0, pa1, pa2, pa3); FA_SBAR();
    if (j + 3 < NT) F2_SLOAD(A, (j + 3) * 64);
    FA_SBAR();
    pv_d0(o, vb0 + SHM_V, pa0, pa1, pa2, pa3); partialSM(pA0, pA1, m_reg, alA);
    __syncthreads(); F2_SWRITE(1, B);
    F2_RESC(alA); __syncthreads();
  }
  FA_SBAR(); qkt<DQK, true>(pB0, pB1, K_lds + SHM_K, qr, nullptr, r32, hi);
  finishSM(pA0, pA1, alA, l_reg, pa0, pa1, pa2, pa3); FA_SBAR();
  pv_d0(o, vb0, pa0, pa1, pa2, pa3); partialSM(pB0, pB1, m_reg, alB);
  __syncthreads(); F2_RESC(alB);
  finishSM(pB0, pB1, alB, l_reg, pa0, pa1, pa2, pa3); FA_SBAR();
  pv_d0(o, vb0 + SHM_V, pa0, pa1, pa2, pa3);
  if (hi == 0) li_l[r32] = l_reg; asm volatile("s_waitcnt lgkmcnt(0)" ::: "memory");
  float rli[16];
#pragma unroll
  for (int r = 0; r < 16; ++r) rli[r] = __builtin_amdgcn_rcpf(li_l[crow(r, hi)]);
  bf16_t* Ow = Ob + (long)(wid * 32) * ldo;
#pragma unroll
  for (int r = 0; r < 16; ++r) { const int orow = crow(r, hi);
#pragma unroll
    for (int d0 = 0; d0 < 4; ++d0) { const float v = o[d0][r] * rli[r]; Ow[(long)orow * ldo + d0 * 32 + r32] = (bf16_t)(cvtpk(v, v) & 0xffffu); } }
  __syncthreads();
#undef F2_SLOAD
#undef F2_SWRITE
#undef F2_RESC
}

__device__ __forceinline__ void xattn_unit(const bf16_t* __restrict__ Qb, const bf16_t* __restrict__ Kh, const bf16_t* __restrict__ Vh, bf16_t* __restrict__ Ob, char* lds) {
  const int tid = opaque_tid(), wid = __builtin_amdgcn_readfirstlane(tid >> 6), lane = tid & 63, r32 = lane & 31, hi = lane >> 5;
  float* li_l = (float*)(lds + 131072 + 256) + wid * 32;
  { bf16x8 st[16];
#pragma unroll
    for (int i = 0; i < 16; ++i) { const int q = tid + 512 * i, row = q >> 5, ch = q & 31; st[i] = *reinterpret_cast<const bf16x8*>(Kh + (long)row * 2048 + ch * 8); }
#pragma unroll
    for (int i = 0; i < 16; ++i) { const int q = tid + 512 * i, row = q >> 5, ch = q & 31; *(bf16x8*)(lds + row * 512 + ((ch * 16) ^ ((row & 15) << 4))) = st[i]; } }
  __syncthreads();
  f32x16 S[8];
#pragma unroll
  for (int kb = 0; kb < 8; ++kb) S[kb] = f32x16{};
  const bf16_t* Qw = Qb + (long)(wid * 32 + r32) * 1024 + hi * 8;
#pragma unroll
  for (int g = 0; g < 2; ++g) { bf16x8 qv[8];
#pragma unroll
    for (int i = 0; i < 8; ++i) qv[i] = *reinterpret_cast<const bf16x8*>(Qw + (g * 8 + i) * 16);
#pragma unroll
    for (int i = 0; i < 8; ++i) { const int cb = ((g * 8 + i) * 16 + hi * 8) * 2;
#pragma unroll
      for (int kb = 0; kb < 8; ++kb) { const bf16x8 kf = *reinterpret_cast<const bf16x8*>(lds + (kb * 32 + r32) * 512 + (cb ^ ((r32 & 15) << 4)));
        S[kb] = __builtin_amdgcn_mfma_f32_32x32x16_bf16(kf, qv[i], S[kb], 0, 0, 0); } } }
  float m = S[0][0];
#pragma unroll
  for (int kb = 0; kb < 8; ++kb)
#pragma unroll
    for (int r = 0; r < 16; ++r) m = fmaxf(m, S[kb][r]);
  { auto rr = __builtin_amdgcn_permlane32_swap(__float_as_uint(m), __float_as_uint(m), false, false); m = fmaxf(__uint_as_float(rr[0]), __uint_as_float(rr[1])); }
  float l = 0.f;
#pragma unroll
  for (int kb = 0; kb < 8; ++kb)
#pragma unroll
    for (int r = 0; r < 16; ++r) { S[kb][r] = __builtin_amdgcn_exp2f(S[kb][r] - m); l += S[kb][r]; }
  { auto rr = __builtin_amdgcn_permlane32_swap(__float_as_uint(l), __float_as_uint(l), false, false); l = __uint_as_float(rr[0]) + __uint_as_float(rr[1]); }
  bf16x8 pa[16];
#define XA_PK4(P, BASE, OUT) do { unsigned a0 = cvtpk(P[BASE + 0], P[BASE + 1]), a1 = cvtpk(P[BASE + 2], P[BASE + 3]);   \
    unsigned b0 = cvtpk(P[BASE + 4], P[BASE + 5]), b1 = cvtpk(P[BASE + 6], P[BASE + 7]);                              \
    auto r0 = __builtin_amdgcn_permlane32_swap(a0, b0, false, false); auto r1 = __builtin_amdgcn_permlane32_swap(a1, b1, false, false); \
    u32x4 w = {r0[0], r1[0], r0[1], r1[1]}; OUT = *reinterpret_cast<bf16x8*>(&w); } while (0)
#pragma unroll
  for (int kt = 0; kt < 4; ++kt) { XA_PK4(S[2 * kt], 0, pa[4 * kt]); XA_PK4(S[2 * kt], 8, pa[4 * kt + 1]); XA_PK4(S[2 * kt + 1], 0, pa[4 * kt + 2]); XA_PK4(S[2 * kt + 1], 8, pa[4 * kt + 3]); }
#undef XA_PK4
  { bf16x8 st[16];
#pragma unroll
    for (int i = 0; i < 16; ++i) { const int q = tid + 512 * i, row = q >> 5, c = (q & 31) * 8; st[i] = *reinterpret_cast<const bf16x8*>(Vh + (long)row * 2048 + c); }
    __syncthreads();
#pragma unroll
    for (int i = 0; i < 16; ++i) { const int q = tid + 512 * i, row = q >> 5, c = (q & 31) * 8; *(bf16x8*)(lds + ((row >> 6) * 2 + (c >> 7)) * 16384 + v_st(row & 63, c & 127)) = st[i]; } }
  if (hi == 0) li_l[r32] = l;
  __syncthreads();
  float rli[16];
#pragma unroll
  for (int r = 0; r < 16; ++r) rli[r] = __builtin_amdgcn_rcpf(li_l[crow(r, hi)]);
  const int vb0 = (int)(uintptr_t)lds + v_rd_base(lane);
  bf16_t* Ow = Ob + (long)(wid * 32) * 1024;
#pragma unroll
  for (int dvh = 0; dvh < 2; ++dvh) { f32x16 o[4] = {};
#pragma unroll
    for (int kt = 0; kt < 4; ++kt) pv_d0(o, vb0 + (kt * 2 + dvh) * 16384, pa[4 * kt], pa[4 * kt + 1], pa[4 * kt + 2], pa[4 * kt + 3]);
#pragma unroll
    for (int r = 0; r < 16; ++r) { const int orow = crow(r, hi);
#pragma unroll
      for (int d0 = 0; d0 < 4; ++d0) { const float v = o[d0][r] * rli[r]; Ow[(long)orow * 1024 + dvh * 128 + d0 * 32 + r32] = (bf16_t)(cvtpk(v, v) & 0xffffu); } } }
  __syncthreads();
}

__device__ __forceinline__ void flash_unit64c(const bf16_t* __restrict__ Qb, int ldq, const bf16_t* __restrict__ Kh, int ldk,
                                              const bf16_t* __restrict__ Vh, int ldv, bf16_t* __restrict__ Ob, int ldo, int nkeys, char* lds) {
  constexpr int KROWB = 128, SHM_K = 8192, SHM_V = 16384;
  const int tid = opaque_tid(), wid = tid >> 6, lane = tid & 63, r32 = lane & 31, hi = lane >> 5;
  char* V_lds = lds; char* K_lds = lds + 2 * SHM_V;
  float* ws = (float*)(lds + 2 * SHM_V + 2 * SHM_K) + wid * 64; float* li_l = ws; float* al_l = ws + 32;
  float m_run = 0.f, l_reg = 0.f; f32x16 o[4] = {}; bf16x8 qr[4]; f32x16 negm = {};
  const bf16_t* Qw = Qb + (long)(wid * 32 + r32) * ldq + hi * 8;
#pragma unroll
  for (int d0 = 0; d0 < 4; ++d0) qr[d0] = *reinterpret_cast<const bf16x8*>(Qw + d0 * 16);
  const int vr = 2 * (tid >> 5) + ((tid >> 2) & 1), vc = (((tid >> 3) & 3) * 4 + (tid & 3)) * 8, vst0 = v_st(vr, vc), vst1 = v_st(32 + vr, vc);
  const int kr = tid >> 3, kc = tid & 7, kst = kr * KROWB + ((kc * 16) ^ (((kr >> 1) & 7) << 4));
  const int vb0 = (int)(uintptr_t)V_lds + v_rd_base(lane);
  const int ksw = ((r32 >> 1) & 7) << 4;
  bf16x8 vs0, vs1, ks;
#define F4_SLOAD(k0) do { vs0 = *reinterpret_cast<const bf16x8*>(Vh + (long)((k0) + vr) * ldv + vc); vs1 = *reinterpret_cast<const bf16x8*>(Vh + (long)((k0) + 32 + vr) * ldv + vc); \
    ks = *reinterpret_cast<const bf16x8*>(Kh + (long)((k0) + kr) * ldk + kc * 8); } while (0)
#define F4_SWRITE(b) do { *(bf16x8*)(V_lds + (b) * SHM_V + vst0) = vs0; *(bf16x8*)(V_lds + (b) * SHM_V + vst1) = vs1; *(bf16x8*)(K_lds + (b) * SHM_K + kst) = ks; } while (0)
#define F4_PK4(P, BASE, OUT) do { unsigned a0 = cvtpk(P[BASE + 0], P[BASE + 1]), a1 = cvtpk(P[BASE + 2], P[BASE + 3]);   \
    unsigned b0 = cvtpk(P[BASE + 4], P[BASE + 5]), b1 = cvtpk(P[BASE + 6], P[BASE + 7]);                              \
    auto r0 = __builtin_amdgcn_permlane32_swap(a0, b0, false, false); auto r1 = __builtin_amdgcn_permlane32_swap(a1, b1, false, false); \
    u32x4 w = {r0[0], r1[0], r0[1], r1[1]}; OUT = *reinterpret_cast<bf16x8*>(&w); } while (0)
#define F4_TILE(b, FIRST) do { f32x16 p0, p1; bf16x8 pa0, pa1, pa2, pa3; const char* Ks_ = K_lds + (b) * SHM_K; \
    _Pragma("unroll") for (int d0 = 0; d0 < 4; ++d0) { const int cb = (d0 * 16 + hi * 8) * 2; \
      const bf16x8 b0 = *reinterpret_cast<const bf16x8*>(Ks_ + r32 * KROWB + (cb ^ ksw)); const bf16x8 b1 = *reinterpret_cast<const bf16x8*>(Ks_ + (32 + r32) * KROWB + (cb ^ ksw)); \
      if (d0 == 0) { p0 = __builtin_amdgcn_mfma_f32_32x32x16_bf16(b0, qr[0], negm, 0, 0, 0); p1 = __builtin_amdgcn_mfma_f32_32x32x16_bf16(b1, qr[0], negm, 0, 0, 0); } \
      else { p0 = __builtin_amdgcn_mfma_f32_32x32x16_bf16(b0, qr[d0], p0, 0, 0, 0); p1 = __builtin_amdgcn_mfma_f32_32x32x16_bf16(b1, qr[d0], p1, 0, 0, 0); } } \
    __builtin_amdgcn_sched_group_barrier(0x100, 8, 0); __builtin_amdgcn_sched_group_barrier(0x008, 8, 0); \
    float pmax = p0[0]; \
    _Pragma("unroll") for (int r = 1; r < 16; ++r) pmax = fmaxf(pmax, p0[r]); \
    _Pragma("unroll") for (int r = 0; r < 16; ++r) pmax = fmaxf(pmax, p1[r]); \
    { auto rr = __builtin_amdgcn_permlane32_swap(__float_as_uint(pmax), __float_as_uint(pmax), false, false); pmax = fmaxf(__uint_as_float(rr[0]), __uint_as_float(rr[1])); } \
    if ((FIRST) || !__builtin_expect(__all(pmax <= 8.f), 1)) { const float dl = (FIRST) ? pmax : fmaxf(pmax, 0.f); const float alpha = __builtin_amdgcn_exp2f(-dl); m_run += dl; l_reg *= alpha; \
      _Pragma("unroll") for (int r = 0; r < 16; ++r) { p0[r] -= dl; p1[r] -= dl; negm[r] = -m_run; } \
      if (!(FIRST)) { if (hi == 0) al_l[r32] = alpha; asm volatile("s_waitcnt lgkmcnt(0)" ::: "memory"); \
        _Pragma("unroll") for (int d_ = 0; d_ < 4; ++d_) _Pragma("unroll") for (int r_ = 0; r_ < 16; ++r_) o[d_][r_] *= al_l[crow(r_, hi)]; } } \
    _Pragma("unroll") for (int r = 0; r < 16; ++r) { p0[r] = __builtin_amdgcn_exp2f(p0[r]); p1[r] = __builtin_amdgcn_exp2f(p1[r]); } \
    float ps = 0.f; \
    _Pragma("unroll") for (int r = 0; r < 16; ++r) ps += p0[r]; \
    _Pragma("unroll") for (int r = 0; r < 16; ++r) ps += p1[r]; \
    { auto rr = __builtin_amdgcn_permlane32_swap(__float_as_uint(ps), __float_as_uint(ps), false, false); ps = __uint_as_float(rr[0]) + __uint_as_float(rr[1]); } \
    l_reg += ps; \
    F4_PK4(p0, 0, pa0); F4_PK4(p0, 8, pa1); F4_PK4(p1, 0, pa2); F4_PK4(p1, 8, pa3); \
    pv_d0(o, vb0 + (b) * SHM_V, pa0, pa1, pa2, pa3); } while (0)
  const int NT = nkeys / 64;
  F4_SLOAD(0); F4_SWRITE(0); F4_SLOAD(64); F4_SWRITE(1); F4_SLOAD(128); __syncthreads();
  F4_TILE(0, true);
  __syncthreads();
  F4_SWRITE(0); F4_SLOAD(192);
  for (int j = 1; j + 1 < NT; j += 2) {
    F4_TILE(1, false);
    __syncthreads();
    if (j + 2 < NT) { F4_SWRITE(1); if (j + 3 < NT) F4_SLOAD((j + 3) * 64); }
    F4_TILE(0, false);
    __syncthreads();
    if (j + 3 < NT) { F4_SWRITE(0); if (j + 4 < NT) F4_SLOAD((j + 4) * 64); }
  }
  F4_TILE(1, false);
  __syncthreads();
  if (hi == 0) li_l[r32] = l_reg; asm volatile("s_waitcnt lgkmcnt(0)" ::: "memory");
  float rli[16];
#pragma unroll
  for (int r = 0; r < 16; ++r) rli[r] = __builtin_amdgcn_rcpf(li_l[crow(r, hi)]);
  bf16_t* Ow = Ob + (long)(wid * 32) * ldo;
  { bf16_t* stg = (bf16_t*)(lds + 65536) + wid * 4096;
#pragma unroll
    for (int r = 0; r < 16; ++r) { const int orow = crow(r, hi);
#pragma unroll
      for (int d0 = 0; d0 < 4; ++d0) { const float v = o[d0][r] * rli[r]; stg[orow * 128 + d0 * 32 + r32] = (bf16_t)(cvtpk(v, v) & 0xffffu); } }
    asm volatile("s_waitcnt lgkmcnt(0)" ::: "memory");
#pragma unroll
    for (int i = 0; i < 8; ++i) { const int row = i * 4 + (lane >> 4), ch = lane & 15; const u32x4 v = *(const u32x4*)(stg + row * 128 + ch * 8); *(u32x4*)(Ow + (long)row * ldo + ch * 8) = v; } }
  __syncthreads();
#undef F4_SLOAD
#undef F4_SWRITE
#undef F4_PK4
#undef F4_TILE
}
}
typedef unsigned short bf16;
typedef float f32x4 __attribute__((ext_vector_type(4)));
typedef unsigned v4u __attribute__((ext_vector_type(4)));
typedef short bf16x8 __attribute__((ext_vector_type(8)));
typedef float f32x16 __attribute__((ext_vector_type(16)));
#define LAS __attribute__((address_space(3)))
constexpr int BATCH = 8, SEQ = 4096, DM = 1024, T = BATCH * SEQ, DEPTH = 2, NMEM = 256, TM = BATCH * NMEM, INW = 2560, DFF = 4096;
constexpr int NWAVES = 8, NTHR = 512;
constexpr size_t MiB = 1u << 20;
constexpr size_t WS_W = 0, W_LAYER = 32 * MiB;
constexpr size_t WO_IN = 0, WO_OUT = 5 * MiB, WO_Q = 7 * MiB, WO_KV = 9 * MiB, WO_O = 13 * MiB, WO_1 = 15 * MiB, WO_2 = 23 * MiB;
constexpr size_t WS_GATE = 64 * MiB;
constexpr size_t WS_ROPE = 65 * MiB;
constexpr size_t WS_RSS = 67 * MiB;
constexpr size_t WS_MEMN = 68 * MiB;
constexpr size_t WS_KVX = 76 * MiB;
constexpr size_t WS_SUM = 92 * MiB;
constexpr size_t WS_XB = 108 * MiB;
constexpr size_t WS_Z = 172 * MiB, WS_OC = 332 * MiB, WS_MIX = 396 * MiB, WS_CIN = 460 * MiB, WS_RSSP = 464 * MiB, WS_END = 480 * MiB;
constexpr size_t WS_BAR = WS_RSS + 964 * 1024;
constexpr size_t WS_CNT = WS_RSS + 960 * 1024;
constexpr size_t WS_H = WS_Z, WS_QX = WS_Z, WS_OX = WS_Z + 64 * MiB;
constexpr int LDS_BYTES = 147456;
constexpr float LOG2E = 1.4426950408889634f;

__device__ __forceinline__ float bf2f(short v) { return __uint_as_float(((unsigned)(unsigned short)v) << 16); }
__device__ __forceinline__ unsigned f2bf(float f) { unsigned u = __builtin_bit_cast(unsigned, f); return (u + 0x7fffu + ((u >> 16) & 1u)) >> 16; }
__device__ __forceinline__ unsigned pk2(float lo, float hi) { return f2bf(lo) | (f2bf(hi) << 16); }
__device__ __forceinline__ float wave_sum(float v) {
#pragma unroll
    for (int o = 1; o < 64; o <<= 1) v += __shfl_xor(v, o);
    return v;
}
__device__ __forceinline__ float sigm(float x) { return __builtin_amdgcn_rcpf(1.f + __expf(-x)); }
__device__ __forceinline__ float gelu_tanh(float x) { const float y = 0.7978845608028654f * (x + 0.044715f * x * x * x); const float e = __expf(2.f * y); const float th = 1.f - 2.f * __builtin_amdgcn_rcpf(e + 1.f); return 0.5f * x * (1.f + th); }

struct LruArgs { const float* spl; float* CIN; unsigned* CNT; const bf16* Z; const float *conv_w, *conv_b, *b_r, *b_i, *a_param, *norm_g; const bf16* WG; float* SUM; bf16* MIX; const bf16* OC; const float* subln_g; float lam, oml; };
constexpr int CSB = 1040, CFS = 516, CF_OFF = 34816;
__device__ __forceinline__ int crow16(int r, int hi) { return (r & 3) + 8 * (r >> 2) + 4 * hi; }

template <bool REV> __device__ __forceinline__ void lru_scan(f32x16& a, f32x16& u, float cin, float& Atot, float& Htot, int hi) {
    float P[16], As[4], Hs[4];
#pragma unroll
    for (int s = 0; s < 4; ++s) { float h = 0.f, p = 1.f;
#pragma unroll
        for (int q = 0; q < 4; ++q) { const int r = REV ? 4 * s + 3 - q : 4 * s + q; h = a[r] * h + u[r]; p *= a[r]; u[r] = h; P[r] = p; }
        As[s] = p; Hs[s] = h; }
    float pA[4], pH[4];
#pragma unroll
    for (int s = 0; s < 4; ++s) { pA[s] = __shfl_xor(As[s], 32); pH[s] = __shfl_xor(Hs[s], 32); }
    float c = cin, at = 1.f, cm[4] = {0.f, 0.f, 0.f, 0.f};
#pragma unroll
    for (int gg = 0; gg < 8; ++gg) { const int g = REV ? 7 - gg : gg; const int s = g >> 1; const bool own = ((g & 1) == hi);
        const float Ag = own ? As[s] : pA[s], Hg = own ? Hs[s] : pH[s];
        cm[s] = own ? c : cm[s];
        c = Ag * c + Hg; at *= Ag; }
    Atot = at; Htot = c;
#pragma unroll
    for (int r = 0; r < 16; ++r) u[r] = u[r] + P[r] * cm[r >> 2];
}
template <bool REV> __device__ __forceinline__ float lru_carry(const float* sb  , int j) {
    const int n = REV ? 127 - j : j; float c = 0.f;
    for (int k0 = 0; k0 < n; k0 += 8) { float Av[8], Hv[8];
#pragma unroll
        for (int q = 0; q < 8; ++q) { const int k = k0 + q; const bool ok = k < n; const int i = ok ? (REV ? 127 - k : k) : (REV ? 127 : 0);
            const float av = sb[(size_t)i * 2048], hv = sb[(size_t)i * 2048 + 512]; Av[q] = ok ? av : 1.f; Hv[q] = ok ? hv : 0.f; }
#pragma unroll
        for (int q = 0; q < 8; ++q) c = Av[q] * c + Hv[q];
    }
    return c;
}
__device__ __forceinline__ void lru_xload(bf16x8 (&xr)[7], const LruArgs& A, int b, int j, int w, int lane) {
    const int t0 = j * 32 + 4 * w; const long rowb = (long)b * SEQ;
#pragma unroll
    for (int rr = 0; rr < 7; ++rr) { const int t = t0 + rr - 2; const int tc = t < 0 ? 0 : (t >= SEQ ? SEQ - 1 : t);
        const bf16x8 raw = *(const bf16x8*)(A.Z + (rowb + tc) * INW + 1536 + 8 * lane); xr[rr] = (t >= 0 && t < SEQ) ? raw : (bf16x8){0, 0, 0, 0, 0, 0, 0, 0}; }
}
template <bool FINAL> __device__ __forceinline__ void lru_chunk(const LruArgs& A, int b, int j, char* lds, bf16x8 (&xr)[7], int nb_, int nj_, bool publish) {
    const int tid = opaque_tid(), w = __builtin_amdgcn_readfirstlane(tid >> 6), lane = tid & 63, n32 = lane & 31, hi = lane >> 5;
    char* Cs = lds; float* Cf = (float*)(lds + CF_OFF);
    const long rowb = (long)b * SEQ;
    {
        const int tl = 4 * w;
        float xv[7][8];
#pragma unroll
        for (int rr = 0; rr < 7; ++rr) {
#pragma unroll
            for (int e = 0; e < 8; ++e) xv[rr][e] = bf2f(xr[rr][e]); }
        float cw[4][8], cb[8];
#pragma unroll
        for (int jj = 0; jj < 4; ++jj) { const f32x4 a0 = *(const f32x4*)(A.conv_w + jj * 512 + 8 * lane), a1 = *(const f32x4*)(A.conv_w + jj * 512 + 8 * lane + 4);
#pragma unroll
            for (int e = 0; e < 4; ++e) { cw[jj][e] = a0[e]; cw[jj][4 + e] = a1[e]; } }
        { const f32x4 a0 = *(const f32x4*)(A.conv_b + 8 * lane), a1 = *(const f32x4*)(A.conv_b + 8 * lane + 4);
#pragma unroll
            for (int e = 0; e < 4; ++e) { cb[e] = a0[e]; cb[4 + e] = a1[e]; } }
#pragma unroll
        for (int tt = 0; tt < 4; ++tt) { float c[8];
#pragma unroll
            for (int e = 0; e < 8; ++e) c[e] = cb[e] + cw[0][e] * xv[tt][e] + cw[1][e] * xv[tt + 1][e] + cw[2][e] * xv[tt + 2][e] + cw[3][e] * xv[tt + 3][e];
            v4u pk; pk.x = pk2(c[0], c[1]); pk.y = pk2(c[2], c[3]); pk.z = pk2(c[4], c[5]); pk.w = pk2(c[6], c[7]);
            *(v4u*)(Cs + (tl + tt) * CSB + lane * 16) = pk;
            *(f32x4*)(Cf + (tl + tt) * CFS + 8 * lane) = (f32x4){c[0], c[1], c[2], c[3]};
            *(f32x4*)(Cf + (tl + tt) * CFS + 8 * lane + 4) = (f32x4){c[4], c[5], c[6], c[7]}; }
    }
    __syncthreads();
    if (nj_ >= 0) lru_xload(xr, A, nb_, nj_, w, lane);
    bf16x8 gpre[4], o1pre[4], o2pre[4];
    if (FINAL) {
#pragma unroll
        for (int tt = 0; tt < 4; ++tt) { const long grow = rowb + j * 32 + 4 * w + tt;
            gpre[tt] = *(const bf16x8*)(A.Z + grow * INW + 2048 + 8 * lane); o1pre[tt] = *(const bf16x8*)(A.OC + grow * 512 + 8 * lane); o2pre[tt] = *(const bf16x8*)(A.OC + (size_t)T * 512 + grow * 512 + 8 * lane); } }
    bf16x8 af[4];
#pragma unroll
    for (int ks = 0; ks < 4; ++ks) af[ks] = *(const bf16x8*)(Cs + n32 * CSB + (64 * w + 16 * ks + 8 * hi) * 2);
#pragma unroll
    for (int nb = 0; nb < 2; ++nb) {
        const int cl = 32 * nb + n32, ch = 64 * w + cl;
        f32x16 hs = {};
#pragma unroll
        for (int dir = 0; dir < 2; ++dir) {
            const bf16* wg_r = A.WG + ((size_t)((dir * 2 + 0) * 8 + w) * 64 + cl) * 64 + 8 * hi;
            const bf16* wg_i = A.WG + ((size_t)((dir * 2 + 1) * 8 + w) * 64 + cl) * 64 + 8 * hi;
            f32x16 dr = {}, di = {};
#pragma unroll
            for (int ks = 0; ks < 4; ++ks) {
                dr = __builtin_amdgcn_mfma_f32_32x32x16_bf16(af[ks], *(const bf16x8*)(wg_r + 16 * ks), dr, 0, 0, 0);
                di = __builtin_amdgcn_mfma_f32_32x32x16_bf16(af[ks], *(const bf16x8*)(wg_i + 16 * ks), di, 0, 0, 0); }
            const float spl = A.spl[dir * 512 + ch], br = -LOG2E * A.b_r[dir * 512 + ch], bi = -LOG2E * A.b_i[dir * 512 + ch];
#pragma unroll
            for (int r = 0; r < 16; ++r) { const int tok = crow16(r, hi);
                const float rg = __builtin_amdgcn_rcpf(1.f + __builtin_amdgcn_exp2f(dr[r] + br)), ig = __builtin_amdgcn_rcpf(1.f + __builtin_amdgcn_exp2f(di[r] + bi));
                const float a = __builtin_amdgcn_exp2f(rg * spl), mult = __builtin_amdgcn_sqrtf(fmaf(-a, a, 1.f));
                dr[r] = a; di[r] = Cf[tok * CFS + ch] * ig * mult; }
            float cin = 0.f;
            if (FINAL) cin = A.CIN[((size_t)(b * 128 + j) * 2 + dir) * 512 + ch];
            float At, Ht;
            if (dir) lru_scan<true>(dr, di, cin, At, Ht, hi); else lru_scan<false>(dr, di, cin, At, Ht, hi);
            if (!FINAL) { if (hi == 0) { float* sp_ = A.SUM + ((size_t)(b * 128 + j) * 2 + dir) * 1024 + ch;
                __hip_atomic_store(sp_, At, __ATOMIC_RELAXED, __HIP_MEMORY_SCOPE_AGENT); __hip_atomic_store(sp_ + 512, Ht, __ATOMIC_RELAXED, __HIP_MEMORY_SCOPE_AGENT); } }
            else { hs = dir ? hs + di : di; }
        }
        if (FINAL) {
#pragma unroll
            for (int r = 0; r < 16; ++r) Cf[crow16(r, hi) * CFS + ch] = hs[r];
        }
    }
    if (!FINAL && publish) {
        asm volatile("s_waitcnt vmcnt(0)" ::: "memory");
        __syncthreads();
        LAS unsigned* flag = (LAS unsigned*)(lds + 131072 - 16);
        if (tid == 0) { const unsigned old = __hip_atomic_fetch_add(A.CNT + b, 4u, __ATOMIC_RELAXED, __HIP_MEMORY_SCOPE_AGENT); *flag = (old == 124u) ? 1u : 0u; }
        __syncthreads();
        const bool last = (*flag != 0u);
        if (last) {
            __builtin_amdgcn_fence(__ATOMIC_ACQUIRE, "agent");
            const float* sb = A.SUM + (size_t)b * 128 * 2048 + tid;
            float* cb_ = A.CIN + (size_t)b * 128 * 1024 + tid;
            float cf = 0.f, cr = 0.f;
            for (int k0 = 0; k0 < 128; k0 += 32) { float Af[32], Hf[32], Ar[32], Hr[32];
#pragma unroll
                for (int q = 0; q < 32; ++q) { const int jf = k0 + q, jr = 127 - jf;
                    Af[q] = __hip_atomic_load(sb + (size_t)jf * 2048, __ATOMIC_RELAXED, __HIP_MEMORY_SCOPE_AGENT); Hf[q] = __hip_atomic_load(sb + (size_t)jf * 2048 + 512, __ATOMIC_RELAXED, __HIP_MEMORY_SCOPE_AGENT);
                    Ar[q] = __hip_atomic_load(sb + (size_t)jr * 2048 + 1024, __ATOMIC_RELAXED, __HIP_MEMORY_SCOPE_AGENT); Hr[q] = __hip_atomic_load(sb + (size_t)jr * 2048 + 1536, __ATOMIC_RELAXED, __HIP_MEMORY_SCOPE_AGENT); }
#pragma unroll
                for (int q = 0; q < 32; ++q) { const int jf = k0 + q, jr = 127 - jf;
                    cb_[(size_t)jf * 1024] = cf; cf = Af[q] * cf + Hf[q];
                    cb_[(size_t)jr * 1024 + 512] = cr; cr = Ar[q] * cr + Hr[q]; }
            }
        }
    }
    __syncthreads();
    if (FINAL) {
#pragma unroll
        for (int tt = 0; tt < 4; ++tt) { const int tl = 4 * w + tt; const long grow = rowb + j * 32 + tl;
            const f32x4 y0 = *(const f32x4*)(Cf + tl * CFS + 8 * lane), y1 = *(const f32x4*)(Cf + tl * CFS + 8 * lane + 4);
            const bf16x8 g = gpre[tt];
            float y[8]; float ss = 0.f;
#pragma unroll
            for (int e = 0; e < 8; ++e) { const float yv = e < 4 ? y0[e] : y1[e - 4]; y[e] = yv * gelu_tanh(bf2f(g[e])); ss += y[e] * y[e]; }
            ss = wave_sum(ss); const float rs = rsqrtf(ss * (1.f / 512.f) + 1e-6f);
            const f32x4 g0 = *(const f32x4*)(A.norm_g + 8 * lane), g1 = *(const f32x4*)(A.norm_g + 8 * lane + 4);
            v4u pk; pk.x = pk2(y[0] * rs * g0[0], y[1] * rs * g0[1]); pk.y = pk2(y[2] * rs * g0[2], y[3] * rs * g0[3]); pk.z = pk2(y[4] * rs * g1[0], y[5] * rs * g1[1]); pk.w = pk2(y[6] * rs * g1[2], y[7] * rs * g1[3]);
            *(v4u*)(A.MIX + grow * DM + 512 + 8 * lane) = pk;
            const bf16x8 o1 = o1pre[tt], o2 = o2pre[tt];
            float d[8]; float s2 = 0.f;
#pragma unroll
            for (int e = 0; e < 8; ++e) { d[e] = bf2f(o1[e]) - A.lam * bf2f(o2[e]); s2 += d[e] * d[e]; }
            s2 += __shfl_xor(s2, 1); s2 += __shfl_xor(s2, 2); s2 += __shfl_xor(s2, 4); s2 += __shfl_xor(s2, 8);
            const float r2 = rsqrtf(s2 * (1.f / 128.f) + 1e-6f) * A.oml;
            const int gc = (8 * lane) & 127;
            const f32x4 s0 = *(const f32x4*)(A.subln_g + gc), s1 = *(const f32x4*)(A.subln_g + gc + 4);
            v4u pq; pq.x = pk2(d[0] * r2 * s0[0], d[1] * r2 * s0[1]); pq.y = pk2(d[2] * r2 * s0[2], d[3] * r2 * s0[3]); pq.z = pk2(d[4] * r2 * s1[0], d[5] * r2 * s1[1]); pq.w = pk2(d[6] * r2 * s1[2], d[7] * r2 * s1[3]);
            *(v4u*)(A.MIX + grow * DM + 8 * lane) = pq; }
        __syncthreads();
    }
}
#define XB_TMO      128
#define XB_XCNT(j)  (256  + 64 * (j))
#define XB_XSUB(j)  (1280 + 64 * (j))
#define XB_XGEN(j)  (2304 + 64 * (j))
#define XB_TOP      3328
#define XB_TOPGEN   3392
#define XCD_BAR_WORDS 3456
#define XB_SPIN_CAP (1u << 18)

__device__ __forceinline__ unsigned xb_ld(unsigned* p)              { return __hip_atomic_load(p, __ATOMIC_RELAXED, __HIP_MEMORY_SCOPE_AGENT); }
__device__ __forceinline__ unsigned xb_add(unsigned* p, unsigned v) { return __hip_atomic_fetch_add(p, v, __ATOMIC_RELAXED, __HIP_MEMORY_SCOPE_AGENT); }
__device__ __forceinline__ unsigned xb_xcc_id() { return (unsigned)__builtin_amdgcn_s_getreg((3 << 11) | 20) & 0xFu; }
#define XB_SPIN(cond, bar) do { unsigned _sp = 0; while (cond) { __builtin_amdgcn_s_sleep(1); \
    if ((++_sp & 255u) == 0u) { if (xb_ld(&(bar)[XB_TMO])) break; if (_sp > XB_SPIN_CAP) { atomicAdd(&(bar)[XB_TMO], 1u); break; } } } } while (0)

struct XcdBarrier {
    unsigned* bar; unsigned x;
    volatile LAS unsigned* st;
};

__device__ __forceinline__ XcdBarrier xcd_barrier_post(unsigned* bar, volatile LAS unsigned* st) {
    XcdBarrier b; b.bar = bar; b.x = xb_xcc_id(); b.st = st;
    if (threadIdx.x == 0) (void)xb_add(&bar[XB_XCNT(b.x)], 1u);
    return b;
}
__device__ __forceinline__ void xcd_barrier_complete(unsigned* bar, unsigned x, unsigned& nloc, unsigned& nx) {
    const unsigned G = gridDim.x * gridDim.y * gridDim.z;
    unsigned sum, cnt, mine, sp = 0u;
    for (;;) {
        sum = 0u; cnt = 0u; mine = 0u;
#pragma unroll
        for (unsigned j = 0; j < 16; ++j) { const unsigned c = xb_ld(&bar[XB_XCNT(j)]); sum += c; cnt += (c > 0u) ? 1u : 0u; mine = (j == x) ? c : mine; }
        if (sum == G) break;
        __builtin_amdgcn_s_sleep(1);
        if ((++sp & 255u) == 0u) { if (xb_ld(&bar[XB_TMO])) break; if (sp > XB_SPIN_CAP) { atomicAdd(&bar[XB_TMO], 1u); break; } }
    }
    nloc = mine > 0u ? mine : 1u; nx = cnt > 0u ? cnt : 1u;
}

__device__ __forceinline__ void xcd_barrier(const XcdBarrier& b) {
    asm volatile("s_waitcnt vmcnt(0)" ::: "memory");
    __syncthreads();
    if (threadIdx.x == 0) {
        unsigned* bar = b.bar;
        __builtin_amdgcn_s_waitcnt(0);
        unsigned nloc = b.st[0], nx = b.st[1];
        if (nloc == 0u) { xcd_barrier_complete(bar, b.x, nloc, nx); b.st[0] = nloc; b.st[1] = nx; }
        const unsigned old = xb_add(&bar[XB_XSUB(b.x)], 1u);
        const unsigned gen = old / nloc;
        if (old + 1u == (gen + 1u) * nloc) {
            __builtin_amdgcn_fence(__ATOMIC_RELEASE, "agent");
            asm volatile("s_waitcnt vmcnt(0)" ::: "memory");
            const unsigned og = xb_add(&bar[XB_TOP], 1u);
            const unsigned tg = og / nx;
            if (og + 1u == (tg + 1u) * nx) xb_add(&bar[XB_TOPGEN], 1u);
            else XB_SPIN(xb_ld(&bar[XB_TOPGEN]) == tg, bar);
            __builtin_amdgcn_fence(__ATOMIC_ACQUIRE, "agent");
            xb_add(&bar[XB_XGEN(b.x)], 1u);
            asm volatile("s_waitcnt vmcnt(0)" ::: "memory");
        } else {
            XB_SPIN(xb_ld(&bar[XB_XGEN(b.x)]) == gen, bar);
            __builtin_amdgcn_fence(__ATOMIC_ACQUIRE, "agent");
            asm volatile("s_waitcnt vmcnt(0)" ::: "memory");
        }
    }
    __syncthreads();
}

struct Args { const void* in[29]; float* out; unsigned char* ws; };
__device__ __forceinline__ void transpose_item(const float* W, int K, int N, bf16* WT, int row_off, const float* gain, LAS float* scr, int item, int lane) {
    const int nblk = N / 32, kb = item / nblk, nb = item % nblk, k0 = 64 * kb, n0 = 32 * nb;
    float wv_[32];
#pragma unroll
    for (int i = 0; i < 32; ++i) wv_[i] = W[(size_t)(k0 + 2 * i + (lane >> 5)) * N + n0 + (lane & 31)];
#pragma unroll
    for (int i = 0; i < 32; ++i) { const int kk = 2 * i + (lane >> 5); const float gv = gain ? gain[k0 + kk] : 1.f; scr[kk * 33 + (lane & 31)] = wv_[i] * gv; }
    asm volatile("s_waitcnt lgkmcnt(0)" ::: "memory");
    const int c = lane & 7;
#pragma unroll
    for (int j = 0; j < 4; ++j) { const int n = (lane >> 3) + 8 * j; const LAS float* s = scr + (8 * c) * 33 + n;
        v4u o; o.x = pk2(s[0 * 33], s[1 * 33]); o.y = pk2(s[2 * 33], s[3 * 33]); o.z = pk2(s[4 * 33], s[5 * 33]); o.w = pk2(s[6 * 33], s[7 * 33]);
        *(v4u*)(WT + (size_t)(row_off + n0 + n) * K + k0 + 8 * c) = o; }
    asm volatile("s_waitcnt lgkmcnt(0)" ::: "memory");
}
#define IN_F(i) ((const float*)args.in[i])

__global__ void __launch_bounds__(NTHR, 2) mega_fwd(Args args) {
    extern __shared__ __attribute__((aligned(16))) unsigned char lds[];
    cg::grid_group grid = cg::this_grid();
    const int tid = threadIdx.x, lane = tid & 63, wave = __builtin_amdgcn_readfirstlane(tid >> 6);
    const int G = gridDim.x, bx = blockIdx.x;
    const int vcu = (G % 8 == 0) ? (bx % 8) * (G / 8) + bx / 8 : bx;
    unsigned char* ws = args.ws;
    float* XF = args.out;
    bf16* XB = (bf16*)(ws + WS_XB);
    float* RSS = (float*)(ws + WS_RSSP);
    float* ROPE = (float*)(ws + WS_ROPE);
    bf16* Zb = (bf16*)(ws + WS_Z); bf16* OC = (bf16*)(ws + WS_OC); bf16* MIX = (bf16*)(ws + WS_MIX);
    bf16* Hb = (bf16*)(ws + WS_H); bf16* QX = (bf16*)(ws + WS_QX); bf16* OX = (bf16*)(ws + WS_OX);
    LAS unsigned char* ldsl = (LAS unsigned char*)lds;

    volatile LAS unsigned* bst = (volatile LAS unsigned*)(ldsl + 131072 + 64);
    if (tid < 2) bst[tid] = 0u;
    __syncthreads();
    for (int rep_ = 0; rep_ < REP_PRO; ++rep_) {
        const int gw = vcu * NWAVES + wave, NGW = G * NWAVES;
        LAS float* scr = (LAS float*)(ldsl + wave * 16384);
        constexpr int I_IN = 16 * 80, I_SQ = 16 * 32, I_1 = 16 * 128, I_2 = 64 * 32, IPL = I_IN + 5 * I_SQ + I_1 + I_2;
        for (int it = gw; it < DEPTH * IPL; it += NGW) {
            const int l = it / IPL; int r = it % IPL; unsigned char* wl = ws + WS_W + (size_t)l * W_LAYER;
            if (r < I_IN) { transpose_item(IN_F(4) + (size_t)l * DM * INW, DM, INW, (bf16*)(wl + WO_IN), 0, IN_F(3) + l * DM, scr, r, lane); continue; } r -= I_IN;
            if (r < I_SQ) { transpose_item(IN_F(18) + (size_t)l * DM * DM, DM, DM, (bf16*)(wl + WO_OUT), 0, nullptr, scr, r, lane); continue; } r -= I_SQ;
            if (r < I_SQ) { transpose_item(IN_F(21) + (size_t)l * DM * DM, DM, DM, (bf16*)(wl + WO_Q), 0, IN_F(19) + l * DM, scr, r, lane); continue; } r -= I_SQ;
            if (r < I_SQ) { transpose_item(IN_F(22) + (size_t)l * DM * DM, DM, DM, (bf16*)(wl + WO_KV), 0, nullptr, scr, r, lane); continue; } r -= I_SQ;
            if (r < I_SQ) { transpose_item(IN_F(23) + (size_t)l * DM * DM, DM, DM, (bf16*)(wl + WO_KV), DM, nullptr, scr, r, lane); continue; } r -= I_SQ;
            if (r < I_SQ) { transpose_item(IN_F(24) + (size_t)l * DM * DM, DM, DM, (bf16*)(wl + WO_O), 0, nullptr, scr, r, lane); continue; } r -= I_SQ;
            if (r < I_1) { transpose_item(IN_F(26) + (size_t)l * DM * DFF, DM, DFF, (bf16*)(wl + WO_1), 0, IN_F(25) + l * DM, scr, r, lane); continue; } r -= I_1;
            transpose_item(IN_F(27) + (size_t)l * DFF * DM, DFF, DM, (bf16*)(wl + WO_2), 0, nullptr, scr, r, lane);
        }
        const int gt = vcu * NTHR + tid, NGT = G * NTHR;
        { bf16* WG = (bf16*)(ws + WS_GATE);
          for (int o = gt; o < DEPTH * 2 * 2 * 8 * 64 * 64; o += NGT) { const int i = o & 63, jx = (o >> 6) & 63, n = (o >> 12) & 7, gate = (o >> 15) & 1, dir = (o >> 16) & 1, l = o >> 17;
              const float* src = gate ? IN_F(14) : IN_F(12);
              WG[o] = (bf16)f2bf(-LOG2E * src[((((size_t)l * 2 + dir) * 8 + n) * 64 + i) * 64 + jx]); } }
        { float* SPL = (float*)(ws + WS_GATE + 768 * 1024); for (int o = gt; o < DEPTH * 2 * 512; o += NGT) SPL[o] = -8.f * LOG2E * log1pf(expf(-IN_F(16)[o])); }
        { const int* pos = (const int*)args.in[2];
          for (int o = gt; o < T * 8; o += NGT) { const int row = o >> 3, i = o & 7; const float inv = powf(500000.f, -(float)i * 0.125f); const float ang = (float)pos[row] * inv;
              ROPE[row * 16 + i] = cosf(ang); ROPE[row * 16 + 8 + i] = sinf(ang); } }
        if (gt < DEPTH * BATCH) ((unsigned*)(ws + WS_CNT))[gt] = 0u;
        if (gt < XCD_BAR_WORDS) ((unsigned*)(ws + WS_BAR))[gt] = 0u;
        for (int m0 = gw * 4; m0 < T; m0 += NGW * 4) { f32x4 v[4][4];
#pragma unroll
            for (int q = 0; q < 4; ++q) { const f32x4* xr = (const f32x4*)(IN_F(0) + (size_t)(m0 + q) * DM) + lane;
#pragma unroll
                for (int j = 0; j < 4; ++j) v[q][j] = xr[64 * j]; }
#pragma unroll
            for (int q = 0; q < 4; ++q) { float s = 0.f;
#pragma unroll
                for (int j = 0; j < 4; ++j) s += (v[q][j].x * v[q][j].x + v[q][j].y * v[q][j].y) + (v[q][j].z * v[q][j].z + v[q][j].w * v[q][j].w);
                s = wave_sum(s); if (lane < 16) RSS[(size_t)(m0 + q) * 16 + lane] = (lane == 0) ? s : 0.f;
                unsigned long long* o8 = (unsigned long long*)(XB + (size_t)(m0 + q) * DM) + lane;
#pragma unroll
                for (int j = 0; j < 4; ++j) o8[64 * j] = (unsigned long long)pk2(v[q][j].x, v[q][j].y) | ((unsigned long long)pk2(v[q][j].z, v[q][j].w) << 32); } }
        for (int m = gw; m < DEPTH * TM; m += NGW) { const int l = m / TM, row = m % TM; const f32x4* xr = (const f32x4*)(IN_F(1) + (size_t)row * DM) + lane; const f32x4* gr = (const f32x4*)(IN_F(20) + l * DM) + lane; f32x4 v[4]; float s = 0.f;
#pragma unroll
            for (int j = 0; j < 4; ++j) { v[j] = xr[64 * j]; s += (v[j].x * v[j].x + v[j].y * v[j].y) + (v[j].z * v[j].z + v[j].w * v[j].w); }
            const float rs = rsqrtf(wave_sum(s) * (1.f / DM) + 1e-6f);
            unsigned long long* o8 = (unsigned long long*)((bf16*)(ws + WS_MEMN) + (size_t)m * DM) + lane;
#pragma unroll
            for (int j = 0; j < 4; ++j) { const f32x4 g = gr[64 * j]; o8[64 * j] = (unsigned long long)pk2(v[j].x * rs * g.x, v[j].y * rs * g.y) | ((unsigned long long)pk2(v[j].z * rs * g.z, v[j].w * rs * g.w) << 32); } }
    }
    grid.sync();
    const XcdBarrier xbar = xcd_barrier_post((unsigned*)(ws + WS_BAR), bst);
#define GRID_BAR() xcd_barrier(xbar)

    for (int l = 0; l < DEPTH; ++l) {
        pg8::Gemm g{(const bf16*)(ws + WS_MEMN) + (size_t)l * TM * DM, (const bf16*)(ws + WS_W + (size_t)l * W_LAYER + WO_KV), TM, 2048, DM};
        pg8::StaticOrder S; S.init(TM, 2048, G, bx);
        pg8::EpiScale<0> E{(bf16*)(ws + WS_KVX) + (size_t)l * TM * 2048, 2048, nullptr, 1.f, nullptr};
        pg8::gemm_phase<pg8::EpiScale<0>, pg8::StaticOrder, true, true>(ldsl, g, S, E);
    }

#pragma unroll
    for (int l = 0; l < DEPTH; ++l) {
        unsigned char* wl = ws + WS_W + (size_t)l * W_LAYER;
        for (int rep_ = 0; rep_ < REP_IN; ++rep_) {
            pg8::Gemm g{XB, (const bf16*)(wl + WO_IN), T, INW, DM}; pg8::StaticOrder S; S.init(T, INW, G, bx);
            pg8::EpiScale<1> E{Zb, INW, RSS + (size_t)(3 * l) * T * 16, 0.125f * LOG2E, ROPE};
            pg8::gemm_phase<pg8::EpiScale<1>, pg8::StaticOrder, true, true>(ldsl, g, S, E);
        }
        GRID_BAR();
        const float lam_init = 0.8f - 0.6f * expf(-0.3f * (float)l);
        float lam;
        { const float a = wave_sum(IN_F(5)[l * 64 + lane] * IN_F(6)[l * 64 + lane]), b2 = wave_sum(IN_F(7)[l * 64 + lane] * IN_F(8)[l * 64 + lane]); lam = expf(a) - expf(b2) + lam_init; }
        LruArgs LA{(const float*)(ws + WS_GATE + 768 * 1024) + l * 1024, (float*)(ws + WS_CIN), (unsigned*)(ws + WS_CNT) + l * BATCH, Zb, IN_F(10) + (size_t)l * 4 * 512, IN_F(11) + l * 512, IN_F(13) + l * 1024, IN_F(15) + l * 1024, IN_F(16) + l * 1024, IN_F(17) + l * 512,
                   (const bf16*)(ws + WS_GATE) + (size_t)l * 131072, (float*)(ws + WS_SUM), MIX, OC, IN_F(9) + l * 128, lam, 1.f - lam_init};
#ifndef NO_LRUA
        for (int rep_ = 0; rep_ < REP_LRUA; ++rep_)
        for (int base = vcu * 4; base < BATCH * 128; base += G * 4) { bf16x8 xr[7]; lru_xload(xr, LA, base >> 7, base & 127, wave, lane);
#pragma unroll 1
            for (int i = 0; i < 4; ++i) lru_chunk<false>(LA, base >> 7, (base & 127) + i, (char*)lds, xr, base >> 7, i < 3 ? (base & 127) + i + 1 : -1, i == 3); }
#endif
        for (int rep_ = 0; rep_ < REP_FA; ++rep_)
        for (int i = 0; i * G < 1024; ++i) {
            const int L = i * G + vcu; if (L >= 1024) break;
            const int uid = (G == 256) ? (((vcu >> 5) * 4 + i) * 32 + (vcu & 31)) : L;
            const int bh = uid >> 5, wi = uid & 31, c = wi >> 4, qb = wi & 15, b = bh >> 2, h = bh & 3;
            const bf16* Qp = Zb + ((size_t)b * SEQ + qb * 256) * INW + h * 128 + c * 64;
            const bf16* Kp = Zb + ((size_t)b * SEQ) * INW + 512 + h * 128 + c * 64;
            const bf16* Vp = Zb + ((size_t)b * SEQ) * INW + 1024 + h * 128;
            bf16* Op = OC + (size_t)c * T * 512 + ((size_t)b * SEQ + qb * 256) * 512 + h * 128;
#ifndef NO_FA64
            fa::flash_unit64c(Qp, INW, Kp, INW, Vp, INW, Op, 512, SEQ, (char*)lds);
#endif
        }
        GRID_BAR();
#ifndef NO_LRUC
        for (int rep_ = 0; rep_ < REP_LRUC; ++rep_)
        for (int base = vcu * 4; base < BATCH * 128; base += G * 4) { bf16x8 xr[7]; lru_xload(xr, LA, base >> 7, base & 127, wave, lane);
#pragma unroll 1
            for (int i = 0; i < 4; ++i) lru_chunk<true>(LA, base >> 7, (base & 127) + i, (char*)lds, xr, base >> 7, i < 3 ? (base & 127) + i + 1 : -1, false); }
#endif
        GRID_BAR();
        {
            pg8::Gemm g{MIX, (const bf16*)(wl + WO_OUT), T, DM, DM}; pg8::StaticOrder S; S.init(T, DM, G, bx);
            if (l == 0) { pg8::EpiRes<true> E{IN_F(0), XB, RSS + (size_t)(3 * l + 1) * T * 16}; pg8::gemm_phase<pg8::EpiRes<true>, pg8::StaticOrder, true, true>(ldsl, g, S, E); }
            else { pg8::EpiRes<false> E{nullptr, XB, RSS + (size_t)(3 * l + 1) * T * 16}; pg8::gemm_phase<pg8::EpiRes<false>, pg8::StaticOrder, true, true>(ldsl, g, S, E); }
        }
        GRID_BAR();
        for (int rep_ = 0; rep_ < REP_Q; ++rep_) {
            pg8::Gemm g{XB, (const bf16*)(wl + WO_Q), T, DM, DM}; pg8::StaticOrder S; S.init(T, DM, G, bx);
            pg8::EpiScale<2> E{QX, DM, RSS + (size_t)(3 * l + 1) * T * 16, 0.0625f * LOG2E, nullptr};
            pg8::gemm_phase<pg8::EpiScale<2>, pg8::StaticOrder, true, true>(ldsl, g, S, E);
        }
        {
            pg8::StaticOrder S; S.init(T, DM, G, bx); pg8::Unit u;
            for (int rep_ = 0; rep_ < REP_XA; ++rep_)
            for (int i = 0; S.next(i, u); ++i)
            {
                    const int b = u.pm >> 4, qb = u.pm & 15, h = u.pn;
                    const bf16* KV = (const bf16*)(ws + WS_KVX) + (size_t)l * TM * 2048 + (size_t)b * NMEM * 2048;
                    const bf16* Qp = QX + ((size_t)b * SEQ + qb * 256) * DM + h * 256;
                    bf16* Op = OX + ((size_t)b * SEQ + qb * 256) * DM + h * 256;
#ifndef NO_FA256
                    fa::xattn_unit(Qp, KV + h * 256, KV + 1024 + h * 256, Op, (char*)lds);
#endif
            }
        }
        GRID_BAR();
        {
            pg8::Gemm g{OX, (const bf16*)(wl + WO_O), T, DM, DM}; pg8::StaticOrder S; S.init(T, DM, G, bx);
            pg8::EpiRes<false> E{nullptr, XB, RSS + (size_t)(3 * l + 2) * T * 16};
            pg8::gemm_phase<pg8::EpiRes<false>, pg8::StaticOrder, true, true>(ldsl, g, S, E);
        }
        GRID_BAR();
        for (int rep_ = 0; rep_ < REP_UP; ++rep_) {
            pg8::Gemm g{XB, (const bf16*)(wl + WO_1), T, DFF, DM}; pg8::StaticOrder S; S.init(T, DFF, G, bx);
            pg8::EpiScale<3> E{Hb, DFF, RSS + (size_t)(3 * l + 2) * T * 16, 1.f, nullptr};
            pg8::gemm_phase<pg8::EpiScale<3>, pg8::StaticOrder, true, true>(ldsl, g, S, E);
        }
        GRID_BAR();
        {
            pg8::Gemm g{Hb, (const bf16*)(wl + WO_2), T, DM, DFF}; pg8::StaticOrder S; S.init(T, DM, G, bx);
            pg8::EpiRes<false> E{nullptr, XB, RSS + (size_t)(3 * l + 3) * T * 16};
            pg8::gemm_phase<pg8::EpiRes<false>, pg8::StaticOrder, true, true>(ldsl, g, S, E);
        }
        GRID_BAR();
    }
    for (int rep_ = 0; rep_ < REP_SYNC; ++rep_) GRID_BAR();
    {
        const int gw = vcu * NWAVES + wave, NGW = G * NWAVES; const float* rss = RSS + (size_t)6 * T * 16; const f32x4* gr = (const f32x4*)IN_F(28) + lane;
        f32x4 gv[4];
#pragma unroll
        for (int j = 0; j < 4; ++j) gv[j] = gr[64 * j];
        for (int m0 = gw * 4; m0 < T; m0 += NGW * 4) { unsigned long long q[4][4]; float ssv[4];
#pragma unroll
            for (int r = 0; r < 4; ++r) { const unsigned long long* xr = (const unsigned long long*)(XB + (size_t)(m0 + r) * DM) + lane; ssv[r] = lane < 16 ? rss[(size_t)(m0 + r) * 16 + lane] : 0.f;
#pragma unroll
                for (int j = 0; j < 4; ++j) q[r][j] = xr[64 * j]; }
#pragma unroll
            for (int r = 0; r < 4; ++r) { const float rs = rsqrtf(wave_sum(ssv[r]) * (1.f / DM) + 1e-6f); f32x4* orow = (f32x4*)(XF + (size_t)(m0 + r) * DM) + lane;
#pragma unroll
                for (int j = 0; j < 4; ++j) { const unsigned lo = (unsigned)q[r][j], hi2 = (unsigned)(q[r][j] >> 32);
                    const f32x4 v = {__uint_as_float(lo << 16), __uint_as_float(lo & 0xffff0000u), __uint_as_float(hi2 << 16), __uint_as_float(hi2 & 0xffff0000u)};
                    orow[64 * j] = v * rs * gv[j]; } } }
    }
}

extern "C" void kernel_launch(void* const* d_in, const int* in_sizes, int n_in, void* d_out, int out_size, void* d_ws, size_t ws_size, hipStream_t stream) {
    static int grid = 0;
    if (grid == 0) {
        if (n_in != 29 || in_sizes[0] != T * DM || out_size != T * DM || ws_size < WS_END) { fprintf(stderr, "kernel_launch: unexpected shapes (n_in %d, in0 %d, out %d, ws %zu, need %zu)\n", n_in, n_in > 0 ? in_sizes[0] : -1, out_size, ws_size, (size_t)WS_END); grid = -1; return; }
        int dev = 0, cus = 0, per_cu = 0;
        if (hipGetDevice(&dev) != hipSuccess || hipDeviceGetAttribute(&cus, hipDeviceAttributeMultiprocessorCount, dev) != hipSuccess) { fprintf(stderr, "kernel_launch: device query failed\n"); grid = -1; return; }
        if (hipFuncSetAttribute((const void*)mega_fwd, hipFuncAttributeMaxDynamicSharedMemorySize, LDS_BYTES) != hipSuccess) { fprintf(stderr, "kernel_launch: hipFuncSetAttribute failed\n"); grid = -1; return; }
        if (hipOccupancyMaxActiveBlocksPerMultiprocessor(&per_cu, (const void*)mega_fwd, NTHR, LDS_BYTES) != hipSuccess || per_cu < 1) { fprintf(stderr, "kernel_launch: occupancy query says %d blocks per CU\n", per_cu); (void)hipGetLastError(); per_cu = 1; }
        grid = cus;
    }
    if (grid < 0) return;
    Args a{};
    for (int i = 0; i < 29; ++i) a.in[i] = d_in[i];
    a.out = (float*)d_out; a.ws = (unsigned char*)d_ws;
    void* kargs[] = {&a};
    const hipError_t e = hipLaunchCooperativeKernel((const void*)mega_fwd, dim3(grid), dim3(NTHR), kargs, LDS_BYTES, stream);
    if (e != hipSuccess) fprintf(stderr, "kernel_launch: cooperative launch failed: %s (grid %d)\n", hipGetErrorString(e), grid);
}
```

```cpp
#include <hip/hip_runtime.h>
#include <hip/hip_cooperative_groups.h>
#include <cstdio>
#include <cstdint>
namespace cg = cooperative_groups;
#ifndef REP_FA
#define REP_FA 1
#endif
#ifndef REP_LRUA
#define REP_LRUA 1
#endif
#ifndef REP_LRUC
#define REP_LRUC 1
#endif
#ifndef REP_PRO
#define REP_PRO 1
#endif
#ifndef REP_Q
#define REP_Q 1
#endif
#ifndef REP_SYNC
#define REP_SYNC 0
#endif
#ifndef REP_XA
#define REP_XA 1
#endif
#ifndef REP_UP
#define REP_UP 1
#endif
#ifndef REP_IN
#define REP_IN 1
#endif
__device__ __forceinline__ int opaque_tid() { int t = threadIdx.x; asm volatile("" : "+v"(t)); return t; }
namespace pg8 {
#define PG8_LAS __attribute__((address_space(3)))
typedef unsigned short bf16_t;
typedef short bf16x8 __attribute__((ext_vector_type(8)));
typedef float f32x4 __attribute__((ext_vector_type(4)));
typedef unsigned u32x4 __attribute__((ext_vector_type(4)));
constexpr int BM = 256, BK = 64, HALF = 128, HTB = HALF * BK * 2  , STAGE_BYTES = 8 * HTB, NXCD = 8, WGM = 8;

__host__ __device__ __forceinline__ int lds_byte(int r, int c) { const int st = (r >> 4) * 2 + (c >> 5), rr = r & 15, cc = c & 31, ob = rr * 64 + cc * 2; return st * 1024 + (ob ^ (((ob >> 9) & 1) << 5)); }
__host__ __device__ __forceinline__ void stage_rc(int b, int& R, int& C) { const int st = b / 1024, sb = b % 1024, swz = sb ^ (((sb >> 9) & 1) << 5); R = (st >> 1) * 16 + swz / 64; C = (st & 1) * 32 + (swz % 64) / 2; }
__host__ __device__ __forceinline__ int perm32(int rho) { const int n = rho >> 4, i = rho & 15; return 8 * (i >> 2) + 4 * n + (i & 3); }

struct Unit { int pm, pn; };
struct Gemm { const bf16_t* A; const bf16_t* Bt; int M, N, K; };

struct StaticOrder {
    int nM, nN, nwg, G, c;
    __host__ __device__ void init(int M, int N, int G_, int c_) { nM = M / BM; nN = N / BM; nwg = nM * nN; G = G_; c = c_; }
    __host__ __device__ bool next(int i, Unit& u) const {
        const long L = (long)i * G + c; if (L >= nwg) return false;
        int wgid = (int)L; { const int q = nwg / NXCD, r = nwg % NXCD, xcd = wgid % NXCD, off = wgid / NXCD; wgid = (xcd < r ? xcd * (q + 1) : r * (q + 1) + (xcd - r) * q) + off; }
        const int nig = WGM * nN, gid = wgid / nig, fm = gid * WGM, gsz = (nM - fm) < WGM ? (nM - fm) : WGM;
        u.pm = fm + ((wgid % nig) % gsz); u.pn = (wgid % nig) / gsz; return true;
    }
    __device__ __forceinline__ void a_ready(const Unit&) const {}
    __device__ __forceinline__ void done(const Unit&) const {}
};

__device__ __forceinline__ unsigned cvt_pk_bf16(float lo, float hi) { unsigned r; asm volatile("v_cvt_pk_bf16_f32 %0, %1, %2" : "=v"(r) : "v"(lo), "v"(hi)); return r; }
template <class Epi, class Sched, bool ALIGN_EPI = false, bool SP2 = false>
__device__ __forceinline__ void gemm_phase(PG8_LAS unsigned char* lds, const Gemm g, const Sched& S, const Epi& E) {
    const int tid = opaque_tid(), wid = __builtin_amdgcn_readfirstlane(tid >> 6), lane = tid & 63, wr = wid >> 2, wc = wid & 3, fr = lane & 15, fq = lane >> 4;
    const int K = g.K, nt = K / BK;
    unsigned voffA[2], voffB[2];
#pragma unroll
    for (int i = 0; i < 2; ++i) { int R, C; stage_rc(tid * 16 + i * 8192, R, C); const int Rb = Epi::PERM ? ((R & ~31) + perm32(R & 31)) : R;
        voffA[i] = (unsigned)(R * K + C) * 2u; voffB[i] = (unsigned)(Rb * K + C) * 2u; }
    const size_t kstep = (size_t)(BK * 2);
    const size_t hstep = (size_t)HALF * K * 2;
    const size_t tstep = 2 * hstep;
    const unsigned ldsw = (unsigned)wid * 1024u;
    const int aoff = lds_byte(wr * 64 + fr, fq * 8), boff = lds_byte(wc * 32 + fr, fq * 8);
#define PG8_SA(b, h) (((b) * 2 + (h)) * HTB)
#define PG8_SB(b, h) ((4 + (b) * 2 + (h)) * HTB)
#define PG8_STAGE(bufoff, gbase, voff) do { _Pragma("unroll") for (int _i = 0; _i < 2; ++_i) \
        __builtin_amdgcn_global_load_lds((const unsigned*)((const char*)(gbase) + (voff)[_i]), (PG8_LAS unsigned*)(lds + (bufoff) + ldsw + _i * 8192), 16, 0, 0); } while (0)
#define PG8_LDA(dst, b, h) do { _Pragma("unroll") for (int m = 0; m < 4; ++m) _Pragma("unroll") for (int k = 0; k < 2; ++k) dst[m][k] = *(const PG8_LAS bf16x8*)(lds + PG8_SA(b, h) + aoff + m * 2048 + k * 1024); } while (0)
#define PG8_LDB(dst, b, h) do { _Pragma("unroll") for (int n = 0; n < 2; ++n) _Pragma("unroll") for (int k = 0; k < 2; ++k) dst[n][k] = *(const PG8_LAS bf16x8*)(lds + PG8_SB(b, h) + boff + n * 2048 + k * 1024); } while (0)
#define PG8_MMA(ai, bj, At, Bt) do { __builtin_amdgcn_s_setprio(1); _Pragma("unroll") for (int m = 0; m < 4; ++m) _Pragma("unroll") for (int n = 0; n < 2; ++n) _Pragma("unroll") for (int k = 0; k < 2; ++k) \
        acc[ai][bj][m][n] = __builtin_amdgcn_mfma_f32_16x16x32_bf16(Bt[n][k], At[m][k], acc[ai][bj][m][n], 0, 0, 0); __builtin_amdgcn_s_setprio(0); } while (0)
#define PG8_WAIT_V(n) asm volatile("s_waitcnt vmcnt(" #n ")" ::: "memory")
#define PG8_WAIT_L(n) asm volatile("s_waitcnt lgkmcnt(" #n ")" ::: "memory")
#define PG8_BAR __builtin_amdgcn_s_barrier()
#define PG8_SCHED __builtin_amdgcn_sched_barrier(0)
    Unit cur, nxt; int ui = 0;
    if (!S.next(0, cur)) return;
    f32x4 acc[2][2][4][2];
#pragma unroll
    for (int a = 0; a < 2; ++a)
#pragma unroll
        for (int b = 0; b < 2; ++b)
#pragma unroll
            for (int m = 0; m < 4; ++m)
#pragma unroll
                for (int n = 0; n < 2; ++n) acc[a][b][m][n] = (f32x4){0.f, 0.f, 0.f, 0.f};
    bf16x8 At[4][2], B0[2][2], B1[2][2];
    const char* cA = (const char*)g.A + (size_t)cur.pm * tstep; const char* cB = (const char*)g.Bt + (size_t)cur.pn * tstep;
    S.a_ready(cur);
    if constexpr (SP2) {
        PG8_STAGE(PG8_SB(0, 0), cB, voffB); PG8_STAGE(PG8_SB(0, 1), cB + hstep, voffB); PG8_STAGE(PG8_SA(0, 0), cA, voffA); PG8_STAGE(PG8_SA(0, 1), cA + hstep, voffA);
        if (wr == 1) PG8_BAR;
        PG8_WAIT_V(2); PG8_BAR;
        PG8_STAGE(PG8_SB(1, 0), cB + kstep, voffB); PG8_STAGE(PG8_SA(1, 0), cA + kstep, voffA); PG8_STAGE(PG8_SB(1, 1), cB + hstep + kstep, voffB);
        PG8_WAIT_V(6); PG8_BAR;
    } else {
        PG8_STAGE(PG8_SB(0, 0), cB, voffB); PG8_STAGE(PG8_SA(0, 0), cA, voffA); PG8_STAGE(PG8_SB(0, 1), cB + hstep, voffB); PG8_STAGE(PG8_SA(0, 1), cA + hstep, voffA);
        if (wr == 1) PG8_BAR;
        PG8_WAIT_V(4); PG8_BAR;
        PG8_STAGE(PG8_SB(1, 0), cB + kstep, voffB); PG8_STAGE(PG8_SA(1, 0), cA + kstep, voffA); PG8_STAGE(PG8_SB(1, 1), cB + hstep + kstep, voffB);
        PG8_WAIT_V(6); PG8_BAR;
    }
    for (;;) {
        const bool has_next = S.next(ui + 1, nxt);
        const char* nA = has_next ? (const char*)g.A + (size_t)nxt.pm * tstep : cA; const char* nB = has_next ? (const char*)g.Bt + (size_t)nxt.pn * tstep : cB;
        for (int t = 0; t < nt; t += 2) {
            const bool last = (t == nt - 2);
            const char* a1 = cA + (size_t)(t + 1) * kstep;
            const char* a2 = last ? nA : cA + (size_t)(t + 2) * kstep; const char* b2 = last ? nB : cB + (size_t)(t + 2) * kstep;
            const char* a3 = a2 + kstep; const char* b3 = b2 + kstep;
            if (last && has_next) S.a_ready(nxt);
            if constexpr (SP2) {
            PG8_LDB(B0, 0, 0); PG8_LDB(B1, 0, 1); PG8_SCHED; PG8_LDA(At, 0, 0); PG8_STAGE(PG8_SA(1, 1), a1 + hstep, voffA);
            PG8_WAIT_V(8); PG8_WAIT_L(0); PG8_BAR; PG8_MMA(0, 0, At, B0); PG8_MMA(0, 1, At, B1); PG8_BAR; PG8_SCHED;
            PG8_LDA(At, 0, 1); PG8_STAGE(PG8_SB(0, 0), b2, voffB); PG8_STAGE(PG8_SB(0, 1), b2 + hstep, voffB); PG8_STAGE(PG8_SA(0, 0), a2, voffA);
            PG8_WAIT_V(8); PG8_WAIT_L(0); PG8_BAR; PG8_MMA(1, 0, At, B0); PG8_MMA(1, 1, At, B1); PG8_BAR; PG8_SCHED;
            PG8_LDB(B0, 1, 0); PG8_LDB(B1, 1, 1); PG8_SCHED; PG8_LDA(At, 1, 0); PG8_STAGE(PG8_SA(0, 1), a2 + hstep, voffA);
            PG8_WAIT_V(8); PG8_WAIT_L(0); PG8_BAR; PG8_MMA(0, 0, At, B0); PG8_MMA(0, 1, At, B1); PG8_BAR; PG8_SCHED;
            PG8_LDA(At, 1, 1); PG8_STAGE(PG8_SB(1, 0), b3, voffB); PG8_STAGE(PG8_SB(1, 1), b3 + hstep, voffB); PG8_STAGE(PG8_SA(1, 0), a3, voffA);
            PG8_WAIT_V(8); PG8_WAIT_L(0); PG8_BAR; PG8_MMA(1, 0, At, B0); PG8_MMA(1, 1, At, B1); PG8_BAR; PG8_SCHED;
            } else {
            PG8_LDB(B0, 0, 0); PG8_SCHED; PG8_LDA(At, 0, 0); PG8_STAGE(PG8_SA(1, 1), a1 + hstep, voffA);
            PG8_WAIT_L(8); PG8_BAR; PG8_WAIT_L(0); PG8_MMA(0, 0, At, B0); PG8_BAR; PG8_SCHED;
            PG8_LDB(B1, 0, 1); PG8_STAGE(PG8_SB(0, 0), b2, voffB);
            PG8_BAR; PG8_WAIT_L(0); PG8_MMA(0, 1, At, B1); PG8_BAR;
            PG8_LDA(At, 0, 1); PG8_STAGE(PG8_SA(0, 0), a2, voffA);
            PG8_BAR; PG8_WAIT_L(0); PG8_MMA(1, 0, At, B0); PG8_BAR; PG8_SCHED;
            PG8_STAGE(PG8_SB(0, 1), b2 + hstep, voffB);
            PG8_WAIT_V(6); PG8_BAR; PG8_MMA(1, 1, At, B1); PG8_BAR;
            PG8_LDB(B0, 1, 0); PG8_SCHED; PG8_LDA(At, 1, 0); PG8_STAGE(PG8_SA(0, 1), a2 + hstep, voffA);
            PG8_WAIT_L(8); PG8_BAR; PG8_WAIT_L(0); PG8_MMA(0, 0, At, B0); PG8_BAR; PG8_SCHED;
            PG8_LDB(B1, 1, 1); PG8_STAGE(PG8_SB(1, 0), b3, voffB);
            PG8_BAR; PG8_WAIT_L(0); PG8_MMA(0, 1, At, B1); PG8_BAR;
            PG8_LDA(At, 1, 1); PG8_STAGE(PG8_SA(1, 0), a3, voffA);
            PG8_BAR; PG8_WAIT_L(0); PG8_MMA(1, 0, At, B0); PG8_BAR; PG8_SCHED;
            PG8_STAGE(PG8_SB(1, 1), b3 + hstep, voffB);
            PG8_WAIT_V(6); PG8_BAR; PG8_MMA(1, 1, At, B1); PG8_BAR;
            }
        }
        if constexpr (ALIGN_EPI) { if (wr == 0) PG8_BAR; }
        if constexpr (!Epi::AFTER_DRAIN) { E(acc, cur, wr, wc, fr, fq); S.done(cur); }
        if (!has_next) break;
#pragma unroll
        for (int a = 0; a < 2; ++a)
#pragma unroll
            for (int b = 0; b < 2; ++b)
#pragma unroll
                for (int m = 0; m < 4; ++m)
#pragma unroll
                    for (int n = 0; n < 2; ++n) acc[a][b][m][n] = (f32x4){0.f, 0.f, 0.f, 0.f};
        cur = nxt; cA = nA; cB = nB; ++ui;
        if constexpr (ALIGN_EPI) { if (wr == 1) PG8_BAR; }
    }
    PG8_WAIT_V(0);
    if constexpr (!ALIGN_EPI) { if (wr == 0) PG8_BAR; }
    PG8_BAR;
    if constexpr (Epi::AFTER_DRAIN) { E.fused(acc, cur, wr, wc, fr, fq, lds, wid, lane); S.done(cur); }
#undef PG8_SA
#undef PG8_SB
#undef PG8_STAGE
#undef PG8_LDA
#undef PG8_LDB
#undef PG8_MMA
#undef PG8_WAIT_V
#undef PG8_WAIT_L
#undef PG8_BAR
#undef PG8_SCHED
}
}
namespace pg8 {
typedef unsigned u32x4e __attribute__((ext_vector_type(4)));
template <int MODE> struct EpiScale {
    static constexpr bool PERM = true, AFTER_DRAIN = false;
    bf16_t* O; int ldc; const float* rss; float cs; const float* rope;
    __device__ __forceinline__ void operator()(const f32x4 (&acc)[2][2][4][2], const Unit& u, int wr, int wc, int fr, int fq) const {
        const int row0 = u.pm * BM + wr * 64 + fr, col0 = u.pn * BM + wc * 32 + 8 * fq;
        const bool ropew = (MODE == 1) && (u.pn < 4) && ((wc & 1) == 0);
#pragma unroll
        for (int ai = 0; ai < 2; ++ai)
#pragma unroll
            for (int m = 0; m < 4; ++m) {
                const int row = row0 + ai * HALF + m * 16;
                float rs = 1.f;
                if (MODE != 0) { const f32x4 q0 = *((const f32x4*)(rss + (size_t)row * 16) + fq);
                    float sq = (q0[0] + q0[1]) + (q0[2] + q0[3]); sq += __shfl_xor(sq, 16); sq += __shfl_xor(sq, 32);
                    rs = rsqrtf(sq * (1.f / 1024.f) + 1e-6f); }
                if (MODE == 2) rs *= cs;
                f32x4 cv0 = {1.f, 1.f, 1.f, 1.f}, cv1 = cv0, sv0 = {0.f, 0.f, 0.f, 0.f}, sv1 = sv0;
                if (ropew) { const float* rp = rope + (size_t)row * 16; cv0 = *(const f32x4*)rp; cv1 = *(const f32x4*)(rp + 4); sv0 = *(const f32x4*)(rp + 8); sv1 = *(const f32x4*)(rp + 12); }
#pragma unroll
                for (int bj = 0; bj < 2; ++bj) {
                    f32x4 v0 = acc[ai][bj][m][0] * rs, v1 = acc[ai][bj][m][1] * rs;
                    if (MODE == 1) {
                        if (ropew) {
                            f32x4 o0, o1;
#pragma unroll
                            for (int j = 0; j < 4; ++j) { o0[j] = __shfl_xor(v0[j], 16); o1[j] = __shfl_xor(v1[j], 16); }
                            if (fq == 0) { v0 = v0 * cv0 - o0 * sv0; v1 = v1 * cv1 - o1 * sv1; }
                            else if (fq == 1) { v0 = v0 * cv0 + o0 * sv0; v1 = v1 * cv1 + o1 * sv1; }
                        }
                        if (u.pn < 2) { v0 = v0 * cs; v1 = v1 * cs; }
                    }
                    if (MODE == 3) {
#pragma unroll
                        for (int j = 0; j < 4; ++j) { const float a = fmaxf(v0[j], 0.f), b = fmaxf(v1[j], 0.f); v0[j] = a * a; v1[j] = b * b; }
                    }
                    u32x4e w; w.x = cvt_pk_bf16(v0[0], v0[1]); w.y = cvt_pk_bf16(v0[2], v0[3]); w.z = cvt_pk_bf16(v1[0], v1[1]); w.w = cvt_pk_bf16(v1[2], v1[3]);
                    *(u32x4e*)(O + (size_t)row * ldc + col0 + bj * HALF) = w;
                }
            }
    }
};
template <bool F32BASE> struct EpiRes {
    static constexpr bool PERM = true, AFTER_DRAIN = false;
    const float* basef; bf16_t* xb; float* rss;
    __device__ __forceinline__ void operator()(const f32x4 (&acc)[2][2][4][2], const Unit& u, int wr, int wc, int fr, int fq) const {
        const int row0 = u.pm * BM + wr * 64 + fr, col0 = u.pn * BM + wc * 32 + 8 * fq;
#pragma unroll
        for (int ai = 0; ai < 2; ++ai)
#pragma unroll
            for (int m = 0; m < 4; ++m) {
                const int row = row0 + ai * HALF + m * 16; float ss = 0.f;
#pragma unroll
                for (int bj = 0; bj < 2; ++bj) {
                    const size_t off = (size_t)row * 1024 + col0 + bj * HALF;
                    f32x4 b0, b1;
                    if (F32BASE) { b0 = *(const f32x4*)(basef + off); b1 = *(const f32x4*)(basef + off + 4); }
                    else { const u32x4e q = *(const u32x4e*)(xb + off);
                        b0 = (f32x4){__uint_as_float(q.x << 16), __uint_as_float(q.x & 0xffff0000u), __uint_as_float(q.y << 16), __uint_as_float(q.y & 0xffff0000u)};
                        b1 = (f32x4){__uint_as_float(q.z << 16), __uint_as_float(q.z & 0xffff0000u), __uint_as_float(q.w << 16), __uint_as_float(q.w & 0xffff0000u)}; }
                    const f32x4 v0 = acc[ai][bj][m][0] + b0, v1 = acc[ai][bj][m][1] + b1;
                    u32x4e w; w.x = cvt_pk_bf16(v0[0], v0[1]); w.y = cvt_pk_bf16(v0[2], v0[3]); w.z = cvt_pk_bf16(v1[0], v1[1]); w.w = cvt_pk_bf16(v1[2], v1[3]);
                    *(u32x4e*)(xb + off) = w;
                    ss += (v0[0] * v0[0] + v0[1] * v0[1]) + (v0[2] * v0[2] + v0[3] * v0[3]) + (v1[0] * v1[0] + v1[1] * v1[1]) + (v1[2] * v1[2] + v1[3] * v1[3]);
                }
                ss += __shfl_xor(ss, 16); ss += __shfl_xor(ss, 32);
                if (fq == 0) rss[(size_t)row * 16 + u.pn * 4 + wc] = ss;
            }
    }
};
}
namespace fa {
typedef unsigned short bf16_t;
using bf16x8 = __attribute__((ext_vector_type(8))) short;
using s16x4  = __attribute__((ext_vector_type(4))) short;
using f32x16 = __attribute__((ext_vector_type(16))) float;
using u32x4  = __attribute__((ext_vector_type(4))) unsigned;
#define FA_SBAR() __builtin_amdgcn_sched_barrier(0)
__device__ __forceinline__ int crow(int r, int hi) { return (r & 3) + 8 * (r >> 2) + 4 * hi; }
__device__ __forceinline__ unsigned cvtpk(float lo, float hi) { unsigned r; asm volatile("v_cvt_pk_bf16_f32 %0, %1, %2" : "=v"(r) : "v"(lo), "v"(hi)); return r; }
__device__ __forceinline__ int v_st(int k, int c) { const int kk = (k & ~0xC) | ((k & 4) << 1) | ((k & 8) >> 1); return ((kk >> 3) * 4 + (c >> 5)) * 512 + ((kk & 7) * 32 + (c & 31)) * 2; }
__device__ __forceinline__ int v_rd_base(int lane) { return ((lane & 3) << 3) | (((lane >> 2) & 3) << 6) | (((lane >> 4) & 1) << 5) | (((lane >> 5) & 1) << 8); }
constexpr int v_rd_off(int d0, int ks, int half) { return d0 * 512 + ks * 4096 + half * 2048; }
template <int OFF> __device__ __forceinline__ s16x4 tr_read(int vb) { s16x4 r; asm volatile("ds_read_b64_tr_b16 %0, %1 offset:%2" : "=&v"(r) : "v"(vb), "i"(OFF) : "memory"); return r; }
template <int D0> __device__ __forceinline__ void pv_one(f32x16& od, int vb, bf16x8 pa0, bf16x8 pa1, bf16x8 pa2, bf16x8 pa3) {
  const s16x4 l0 = tr_read<v_rd_off(D0, 0, 0)>(vb), h0 = tr_read<v_rd_off(D0, 0, 1)>(vb), l1 = tr_read<v_rd_off(D0, 1, 0)>(vb), h1 = tr_read<v_rd_off(D0, 1, 1)>(vb);
  const s16x4 l2 = tr_read<v_rd_off(D0, 2, 0)>(vb), h2 = tr_read<v_rd_off(D0, 2, 1)>(vb), l3 = tr_read<v_rd_off(D0, 3, 0)>(vb), h3 = tr_read<v_rd_off(D0, 3, 1)>(vb);
  asm volatile("s_waitcnt lgkmcnt(0)" ::: "memory"); FA_SBAR();
#define FA_PK(L, H) (bf16x8){L[0], L[1], L[2], L[3], H[0], H[1], H[2], H[3]}
  od = __builtin_amdgcn_mfma_f32_32x32x16_bf16(pa0, FA_PK(l0, h0), od, 0, 0, 0);
  od = __builtin_amdgcn_mfma_f32_32x32x16_bf16(pa1, FA_PK(l1, h1), od, 0, 0, 0);
  od = __builtin_amdgcn_mfma_f32_32x32x16_bf16(pa2, FA_PK(l2, h2), od, 0, 0, 0);
  od = __builtin_amdgcn_mfma_f32_32x32x16_bf16(pa3, FA_PK(l3, h3), od, 0, 0, 0);
#undef FA_PK
}
__device__ __forceinline__ void pv_d0(f32x16* o, int vb, bf16x8 pa0, bf16x8 pa1, bf16x8 pa2, bf16x8 pa3) {
  pv_one<0>(o[0], vb, pa0, pa1, pa2, pa3); pv_one<1>(o[1], vb, pa0, pa1, pa2, pa3); pv_one<2>(o[2], vb, pa0, pa1, pa2, pa3); pv_one<3>(o[3], vb, pa0, pa1, pa2, pa3);
}
template <int DQK, bool QREG> __device__ __forceinline__ void qkt(f32x16& p0, f32x16& p1, const char* Ks, const bf16x8* qr, const bf16_t* qsrc, int r32, int hi) {
  constexpr int KROWB = DQK * 2;
  p0 = f32x16{}; p1 = f32x16{};
  if constexpr (QREG) {
#pragma unroll
    for (int d0 = 0; d0 < DQK / 16; ++d0) { const int cb = (d0 * 16 + hi * 8) * 2;
      const int sw = (DQK == 64) ? (((r32 >> 1) & 7) << 4) : ((r32 & 7) << 4);
      const bf16x8 b0 = *reinterpret_cast<const bf16x8*>(Ks + r32 * KROWB + (cb ^ sw));
      const bf16x8 b1 = *reinterpret_cast<const bf16x8*>(Ks + (32 + r32) * KROWB + (cb ^ sw));
      p0 = __builtin_amdgcn_mfma_f32_32x32x16_bf16(b0, qr[d0], p0, 0, 0, 0);
      p1 = __builtin_amdgcn_mfma_f32_32x32x16_bf16(b1, qr[d0], p1, 0, 0, 0); }
  } else {
    typedef __attribute__((address_space(1))) const bf16x8 gq_t;
#pragma unroll
    for (int g = 0; g < DQK / 128; ++g) { bf16x8 qv[8];
#pragma unroll
      for (int i = 0; i < 8; ++i) qv[i] = *(gq_t*)(qsrc + (g * 8 + i) * 16);
#pragma unroll
      for (int i = 0; i < 8; ++i) { const int d0 = g * 8 + i, cb = (d0 * 16 + hi * 8) * 2;
        const bf16x8 b0 = *reinterpret_cast<const bf16x8*>(Ks + r32 * KROWB + (cb ^ ((r32 & 7) << 4)));
        const bf16x8 b1 = *reinterpret_cast<const bf16x8*>(Ks + (32 + r32) * KROWB + (cb ^ ((r32 & 7) << 4)));
        p0 = __builtin_amdgcn_mfma_f32_32x32x16_bf16(b0, qv[i], p0, 0, 0, 0);
        p1 = __builtin_amdgcn_mfma_f32_32x32x16_bf16(b1, qv[i], p1, 0, 0, 0); } }
  }
}
__device__ __forceinline__ void softmax_tile(f32x16& p0, f32x16& p1, float& m_reg, float& l_reg, float& alpha, bf16x8& pa0, bf16x8& pa1, bf16x8& pa2, bf16x8& pa3) {
  float pmax = p0[0];
#pragma unroll
  for (int r = 1; r < 16; ++r) pmax = fmaxf(pmax, p0[r]);
#pragma unroll
  for (int r = 0; r < 16; ++r) pmax = fmaxf(pmax, p1[r]);
  { auto rr = __builtin_amdgcn_permlane32_swap(__float_as_uint(pmax), __float_as_uint(pmax), false, false); pmax = fmaxf(__uint_as_float(rr[0]), __uint_as_float(rr[1])); }
  if (__builtin_expect(__all(pmax - m_reg <= 8.f), 1)) { alpha = 1.f; }
  else { const float mn = fmaxf(m_reg, pmax); alpha = __builtin_amdgcn_exp2f(m_reg - mn); m_reg = mn; }
  const float mneg = -m_reg;
#pragma unroll
  for (int r = 0; r < 16; ++r) { p0[r] = __builtin_amdgcn_exp2f(p0[r] + mneg); p1[r] = __builtin_amdgcn_exp2f(p1[r] + mneg); }
  float ps = 0.f;
#pragma unroll
  for (int r = 0; r < 16; ++r) ps += p0[r];
#pragma unroll
  for (int r = 0; r < 16; ++r) ps += p1[r];
  { auto rr = __builtin_amdgcn_permlane32_swap(__float_as_uint(ps), __float_as_uint(ps), false, false); ps = __uint_as_float(rr[0]) + __uint_as_float(rr[1]); }
  l_reg = l_reg * alpha + ps;
#define FA_PK4(P, BASE, OUT) do { unsigned a0 = cvtpk(P[BASE + 0], P[BASE + 1]), a1 = cvtpk(P[BASE + 2], P[BASE + 3]);   \
    unsigned b0 = cvtpk(P[BASE + 4], P[BASE + 5]), b1 = cvtpk(P[BASE + 6], P[BASE + 7]);                              \
    auto r0 = __builtin_amdgcn_permlane32_swap(a0, b0, false, false); auto r1 = __builtin_amdgcn_permlane32_swap(a1, b1, false, false); \
    u32x4 w = {r0[0], r1[0], r0[1], r1[1]}; OUT = *reinterpret_cast<bf16x8*>(&w); } while (0)
  FA_PK4(p0, 0, pa0); FA_PK4(p0, 8, pa1); FA_PK4(p1, 0, pa2); FA_PK4(p1, 8, pa3);
#undef FA_PK4
}
template <int DQK>
__device__ __forceinline__ void flash_unit(const bf16_t* __restrict__ Qb, int ldq, const bf16_t* __restrict__ Kh, int ldk,
                                           const bf16_t* __restrict__ Vh, int ldv, bf16_t* __restrict__ Ob, int ldo, int nkeys, char* lds) {
  constexpr int KROWB = DQK * 2, SHM_K = 64 * KROWB, SHM_V = 16384, ND = DQK / 16, NKL = DQK / 64, CPR = DQK / 8;
  const int tid = opaque_tid(), wid = tid >> 6, lane = tid & 63, r32 = lane & 31, hi = lane >> 5;
  char* V_lds = lds; char* K_lds = lds + 2 * SHM_V;
  float* ws = (float*)(lds + 2 * SHM_V + 2 * SHM_K) + wid * 64; float* li_l = ws; float* al_l = ws + 32;
  constexpr bool QREG = (DQK <= 64);
  float m_reg = -1e30f, l_reg = 0.f; f32x16 o[4] = {}; bf16x8 qr[QREG ? ND : 1];
  const bf16_t* Qw = Qb + (long)(wid * 32 + r32) * ldq + hi * 8;
#pragma unroll
  for (int d0 = 0; d0 < (QREG ? ND : 1); ++d0) qr[d0] = *reinterpret_cast<const bf16x8*>(Qw + d0 * 16);
  const int vr = tid >> 4, vc = (tid & 15) * 8, vst0 = v_st(vr, vc), vst1 = v_st(32 + vr, vc);
  const int vb0 = (int)(uintptr_t)V_lds + v_rd_base(lane);
  bf16x8 vs0, vs1, ksg[NKL];
#define FA_SLOAD(k0) do { vs0 = *reinterpret_cast<const bf16x8*>(Vh + (long)((k0) + vr) * ldv + vc); vs1 = *reinterpret_cast<const bf16x8*>(Vh + (long)((k0) + 32 + vr) * ldv + vc); \
    _Pragma("unroll") for (int i_ = 0; i_ < NKL; ++i_) { const int q_ = tid + 512 * i_, row_ = q_ / CPR, ch_ = q_ % CPR; ksg[i_] = *reinterpret_cast<const bf16x8*>(Kh + (long)((k0) + row_) * ldk + ch_ * 8); } } while (0)
#define FA_SWRITE(b) do { *(bf16x8*)(V_lds + (b) * SHM_V + vst0) = vs0; *(bf16x8*)(V_lds + (b) * SHM_V + vst1) = vs1; \
    _Pragma("unroll") for (int i_ = 0; i_ < NKL; ++i_) { const int q_ = tid + 512 * i_, row_ = q_ / CPR, ch_ = q_ % CPR; \
      *(bf16x8*)(K_lds + (b) * SHM_K + row_ * KROWB + ((ch_ * 16) ^ ((DQK == 64 ? ((row_ >> 1) & 7) : (row_ & 7)) << 4))) = ksg[i_]; } } while (0)
#define FA_RESC(a) do { if (__any((a) < 1.f)) { if (hi == 0) al_l[r32] = (a); asm volatile("s_waitcnt lgkmcnt(0)" ::: "memory"); \
    _Pragma("unroll") for (int d_ = 0; d_ < 4; ++d_) _Pragma("unroll") for (int r_ = 0; r_ < 16; ++r_) o[d_][r_] *= al_l[crow(r_, hi)]; } } while (0)
#define FA_TILE(b) do { f32x16 p0, p1; float alpha; bf16x8 pa0, pa1, pa2, pa3; \
    const bf16_t* qs_ = Qw; asm volatile("" : "+v"(qs_)); qkt<DQK, QREG>(p0, p1, K_lds + (b) * SHM_K, qr, qs_, r32, hi); softmax_tile(p0, p1, m_reg, l_reg, alpha, pa0, pa1, pa2, pa3); FA_RESC(alpha); \
    pv_d0(o, vb0 + (b) * SHM_V, pa0, pa1, pa2, pa3); } while (0)
  const int NT = nkeys / 64;
  FA_SLOAD(0); FA_SWRITE(0); __syncthreads();
  for (int j = 0; j < NT; j += 2) {
    FA_SLOAD((j + 1) * 64);
    FA_TILE(0);
    FA_SWRITE(1); __syncthreads();
    if (j + 2 < NT) FA_SLOAD((j + 2) * 64);
    FA_TILE(1);
    if (j + 2 < NT) FA_SWRITE(0);
    __syncthreads();
  }
  if (hi == 0) li_l[r32] = l_reg; asm volatile("s_waitcnt lgkmcnt(0)" ::: "memory");
  float rli[16];
#pragma unroll
  for (int r = 0; r < 16; ++r) rli[r] = __builtin_amdgcn_rcpf(li_l[crow(r, hi)]);
  bf16_t* Ow = Ob + (long)(wid * 32) * ldo;
#pragma unroll
  for (int r = 0; r < 16; ++r) { const int orow = crow(r, hi);
#pragma unroll
    for (int d0 = 0; d0 < 4; ++d0) { const float v = o[d0][r] * rli[r]; Ow[(long)orow * ldo + d0 * 32 + r32] = (bf16_t)(cvtpk(v, v) & 0xffffu); } }
  __syncthreads();
#undef FA_SLOAD
#undef FA_SWRITE
#undef FA_RESC
#undef FA_TILE
}

__device__ __forceinline__ void partialSM(f32x16& p0, f32x16& p1, float& m_reg, float& alpha) {
  float pmax = p0[0];
#pragma unroll
  for (int r = 1; r < 16; ++r) pmax = fmaxf(pmax, p0[r]);
#pragma unroll
  for (int r = 0; r < 16; ++r) pmax = fmaxf(pmax, p1[r]);
  { auto rr = __builtin_amdgcn_permlane32_swap(__float_as_uint(pmax), __float_as_uint(pmax), false, false); pmax = fmaxf(__uint_as_float(rr[0]), __uint_as_float(rr[1])); }
  if (__builtin_expect(__all(pmax - m_reg <= 8.f), 1)) { alpha = 1.f; }
  else { const float mn = fmaxf(m_reg, pmax); alpha = __builtin_amdgcn_exp2f(m_reg - mn); m_reg = mn; }
  const float mneg = -m_reg;
#pragma unroll
  for (int r = 0; r < 16; ++r) { p0[r] += mneg; p1[r] += mneg; }
#pragma unroll
  for (int r = 0; r < 16; ++r) p0[r] = __builtin_amdgcn_exp2f(p0[r]);
}
__device__ __forceinline__ void finishSM(f32x16& p0, f32x16& p1, float alpha, float& l_reg, bf16x8& pa0, bf16x8& pa1, bf16x8& pa2, bf16x8& pa3) {
#pragma unroll
  for (int r = 0; r < 16; ++r) p1[r] = __builtin_amdgcn_exp2f(p1[r]);
  float ps = 0.f;
#pragma unroll
  for (int r = 0; r < 16; ++r) ps += p0[r];
#pragma unroll
  for (int r = 0; r < 16; ++r) ps += p1[r];
  { auto rr = __builtin_amdgcn_permlane32_swap(__float_as_uint(ps), __float_as_uint(ps), false, false); ps = __uint_as_float(rr[0]) + __uint_as_float(rr[1]); }
  l_reg = l_reg * alpha + ps;
#define FA_PK4(P, BASE, OUT) do { unsigned a0 = cvtpk(P[BASE + 0], P[BASE + 1]), a1 = cvtpk(P[BASE + 2], P[BASE + 3]);   \
    unsigned b0 = cvtpk(P[BASE + 4], P[BASE + 5]), b1 = cvtpk(P[BASE + 6], P[BASE + 7]);                              \
    auto r0 = __builtin_amdgcn_permlane32_swap(a0, b0, false, false); auto r1 = __builtin_amdgcn_permlane32_swap(a1, b1, false, false); \
    u32x4 w = {r0[0], r1[0], r0[1], r1[1]}; OUT = *reinterpret_cast<bf16x8*>(&w); } while (0)
  FA_PK4(p0, 0, pa0); FA_PK4(p0, 8, pa1); FA_PK4(p1, 0, pa2); FA_PK4(p1, 8, pa3);
#undef FA_PK4
}
__device__ __forceinline__ void flash_unit64(const bf16_t* __restrict__ Qb, int ldq, const bf16_t* __restrict__ Kh, int ldk,
                                             const bf16_t* __restrict__ Vh, int ldv, bf16_t* __restrict__ Ob, int ldo, int nkeys, char* lds) {
  constexpr int DQK = 64, KROWB = 128, SHM_K = 8192, SHM_V = 16384;
  const int tid = opaque_tid(), wid = tid >> 6, lane = tid & 63, r32 = lane & 31, hi = lane >> 5;
  char* V_lds = lds; char* K_lds = lds + 2 * SHM_V;
  float* ws = (float*)(lds + 2 * SHM_V + 2 * SHM_K) + wid * 64; float* li_l = ws; float* al_l = ws + 32;
  float m_reg = -1e30f, l_reg = 0.f; f32x16 o[4] = {}; bf16x8 qr[4];
  const bf16_t* Qw = Qb + (long)(wid * 32 + r32) * ldq + hi * 8;
#pragma unroll
  for (int d0 = 0; d0 < 4; ++d0) qr[d0] = *reinterpret_cast<const bf16x8*>(Qw + d0 * 16);
  const int vr = tid >> 4, vc = (tid & 15) * 8, vst0 = v_st(vr, vc), vst1 = v_st(32 + vr, vc);
  const int kr = tid >> 3, kc = tid & 7, kst = kr * KROWB + ((kc * 16) ^ (((kr >> 1) & 7) << 4));
  const int vb0 = (int)(uintptr_t)V_lds + v_rd_base(lane);
  bf16x8 vsA0, vsA1, ksA, vsB0, vsB1, ksB;
#define F2_SLOAD(S, k0) do { vs##S##0 = *reinterpret_cast<const bf16x8*>(Vh + (long)((k0) + vr) * ldv + vc); vs##S##1 = *reinterpret_cast<const bf16x8*>(Vh + (long)((k0) + 32 + vr) * ldv + vc); \
    ks##S = *reinterpret_cast<const bf16x8*>(Kh + (long)((k0) + kr) * ldk + kc * 8); } while (0)
#define F2_SWRITE(b, S) do { *(bf16x8*)(V_lds + (b) * SHM_V + vst0) = vs##S##0; *(bf16x8*)(V_lds + (b) * SHM_V + vst1) = vs##S##1; *(bf16x8*)(K_lds + (b) * SHM_K + kst) = ks##S; } while (0)
#define F2_RESC(a) do { if (__any((a) < 1.f)) { if (hi == 0) al_l[r32] = (a); asm volatile("s_waitcnt lgkmcnt(0)" ::: "memory"); \
    _Pragma("unroll") for (int d_ = 0; d_ < 4; ++d_) _Pragma("unroll") for (int r_ = 0; r_ < 16; ++r_) o[d_][r_] *= al_l[crow(r_, hi)]; } } while (0)
  f32x16 pA0, pA1, pB0, pB1; float alA, alB; bf16x8 pa0, pa1, pa2, pa3; const int NT = nkeys / 64;
  F2_SLOAD(A, 0); F2_SWRITE(0, A); __syncthreads();
  qkt<DQK, true>(pA0, pA1, K_lds, qr, nullptr, r32, hi); partialSM(pA0, pA1, m_reg, alA);
  F2_SLOAD(B, 64); if (2 < NT) F2_SLOAD(A, 128);
  F2_SWRITE(1, B); __syncthreads();
  for (int j = 1; j + 1 < NT; j += 2) {
    FA_SBAR(); qkt<DQK, true>(pB0, pB1, K_lds + SHM_K, qr, nullptr, r32, hi);
    finishSM(pA0, pA1, alA, l_reg, pa0, pa1, pa2, pa3); FA_SBAR();
    F2_SLOAD(B, (j + 2) * 64); FA_SBAR();
    pv_d0(o, vb0, pa0, pa1, pa2, pa3); partialSM(pB0, pB1, m_reg, alB);
    __syncthreads(); F2_SWRITE(0, A);
    F2_RESC(alB); __syncthreads();
    FA_SBAR(); qkt<DQK, true>(pA0, pA1, K_lds, qr, nullptr, r32, hi);
    finishSM(pB0, pB1, alB, l_reg, pa0, pa1, pa2, pa3); FA_SBAR();
    if (j + 3 < NT) F2_SLOAD(A, (j + 3) * 64);
    FA_SBAR();
    pv_d0(o, vb0 + SHM_V, pa0, pa1, pa2, pa3); partialSM(pA0, pA1, m_reg, alA);
    __syncthreads(); F2_SWRITE(1, B);
    F2_RESC(alA); __syncthreads();
  }
  FA_SBAR(); qkt<DQK, true>(pB0, pB1, K_lds + SHM_K, qr, nullptr, r32, hi);
  finishSM(pA0, pA1, alA, l_reg, pa0, pa1, pa2, pa3); FA_SBAR();
  pv_d0(o, vb0, pa0, pa1, pa2, pa3); partialSM(pB0, pB1, m_reg, alB);
  __syncthreads(); F2_RESC(alB);
  finishSM(pB0, pB1, alB, l_reg, pa0, pa1, pa2, pa3); FA_SBAR();
  pv_d0(o, vb0 + SHM_V, pa0, pa1, pa2, pa3);
  if (hi == 0) li_l[r32] = l_reg; asm volatile("s_waitcnt lgkmcnt(0)" ::: "memory");
  float rli[16];
#pragma unroll
  for (int r = 0; r < 16; ++r) rli[r] = __builtin_amdgcn_rcpf(li_l[crow(r, hi)]);
  bf16_t* Ow = Ob + (long)(wid * 32) * ldo;
#pragma unroll
  for (int r = 0; r < 16; ++r) { const int orow = crow(r, hi);
#pragma unroll
    for (int d0 = 0; d0 < 4; ++d0) { const float v = o[d0][r] * rli[r]; Ow[(long)orow * ldo + d0 * 32 + r32] = (bf16_t)(cvtpk(v, v) & 0xffffu); } }
  __syncthreads();
#undef F2_SLOAD
#undef F2_SWRITE
#undef F2_RESC
}

__device__ __forceinline__ void xattn_unit(const bf16_t* __restrict__ Qb, const bf16_t* __restrict__ Kh, const bf16_t* __restrict__ Vh, bf16_t* __restrict__ Ob, char* lds) {
  const int tid = opaque_tid(), wid = __builtin_amdgcn_readfirstlane(tid >> 6), lane = tid & 63, r32 = lane & 31, hi = lane >> 5;
  float* li_l = (float*)(lds + 131072 + 256) + wid * 32;
  { bf16x8 st[16];
#pragma unroll
    for (int i = 0; i < 16; ++i) { const int q = tid + 512 * i, row = q >> 5, ch = q & 31; st[i] = *reinterpret_cast<const bf16x8*>(Kh + (long)row * 2048 + ch * 8); }
#pragma unroll
    for (int i = 0; i < 16; ++i) { const int q = tid + 512 * i, row = q >> 5, ch = q & 31; *(bf16x8*)(lds + row * 512 + ((ch * 16) ^ ((row & 15) << 4))) = st[i]; } }
  __syncthreads();
  f32x16 S[8];
#pragma unroll
  for (int kb = 0; kb < 8; ++kb) S[kb] = f32x16{};
  const bf16_t* Qw = Qb + (long)(wid * 32 + r32) * 1024 + hi * 8;
#pragma unroll
  for (int g = 0; g < 2; ++g) { bf16x8 qv[8];
#pragma unroll
    for (int i = 0; i < 8; ++i) qv[i] = *reinterpret_cast<const bf16x8*>(Qw + (g * 8 + i) * 16);
#pragma unroll
    for (int i = 0; i < 8; ++i) { const int cb = ((g * 8 + i) * 16 + hi * 8) * 2;
#pragma unroll
      for (int kb = 0; kb < 8; ++kb) { const bf16x8 kf = *reinterpret_cast<const bf16x8*>(lds + (kb * 32 + r32) * 512 + (cb ^ ((r32 & 15) << 4)));
        S[kb] = __builtin_amdgcn_mfma_f32_32x32x16_bf16(kf, qv[i], S[kb], 0, 0, 0); } } }
  float m = S[0][0];
#pragma unroll
  for (int kb = 0; kb < 8; ++kb)
#pragma unroll
    for (int r = 0; r < 16; ++r) m = fmaxf(m, S[kb][r]);
  { auto rr = __builtin_amdgcn_permlane32_swap(__float_as_uint(m), __float_as_uint(m), false, false); m = fmaxf(__uint_as_float(rr[0]), __uint_as_float(rr[1])); }
  float l = 0.f;
#pragma unroll
  for (int kb = 0; kb < 8; ++kb)
#pragma unroll
    for (int r = 0; r < 16; ++r) { S[kb][r] = __builtin_amdgcn_exp2f(S[kb][r] - m); l += S[kb][r]; }
  { auto rr = __builtin_amdgcn_permlane32_swap(__float_as_uint(l), __float_as_uint(l), false, false); l = __uint_as_float(rr[0]) + __uint_as_float(rr[1]); }
  bf16x8 pa[16];
#define XA_PK4(P, BASE, OUT) do { unsigned a0 = cvtpk(P[BASE + 0], P[BASE + 1]), a1 = cvtpk(P[BASE + 2], P[BASE + 3]);   \
    unsigned b0 = cvtpk(P[BASE + 4], P[BASE + 5]), b1 = cvtpk(P[BASE + 6], P[BASE + 7]);                              \
    auto r0 = __builtin_amdgcn_permlane32_swap(a0, b0, false, false); auto r1 = __builtin_amdgcn_permlane32_swap(a1, b1, false, false); \
    u32x4 w = {r0[0], r1[0], r0[1], r1[1]}; OUT = *reinterpret_cast<bf16x8*>(&w); } while (0)
#pragma unroll
  for (int kt = 0; kt < 4; ++kt) { XA_PK4(S[2 * kt], 0, pa[4 * kt]); XA_PK4(S[2 * kt], 8, pa[4 * kt + 1]); XA_PK4(S[2 * kt + 1], 0, pa[4 * kt + 2]); XA_PK4(S[2 * kt + 1], 8, pa[4 * kt + 3]); }
#undef XA_PK4
  { bf16x8 st[16];
#pragma unroll
    for (int i = 0; i < 16; ++i) { const int q = tid + 512 * i, l_ = q & 63, row = 2 * (q >> 6) + ((l_ >> 2) & 1), c = ((l_ >> 3) * 4 + (l_ & 3)) * 8; st[i] = *reinterpret_cast<const bf16x8*>(Vh + (long)row * 2048 + c); }
    __syncthreads();
#pragma unroll
    for (int i = 0; i < 16; ++i) { const int q = tid + 512 * i, l_ = q & 63, row = 2 * (q >> 6) + ((l_ >> 2) & 1), c = ((l_ >> 3) * 4 + (l_ & 3)) * 8; *(bf16x8*)(lds + ((row >> 6) * 2 + (c >> 7)) * 16384 + v_st(row & 63, c & 127)) = st[i]; } }
  if (hi == 0) li_l[r32] = l;
  __syncthreads();
  float rli[16];
#pragma unroll
  for (int r = 0; r < 16; ++r) rli[r] = __builtin_amdgcn_rcpf(li_l[crow(r, hi)]);
  const int vb0 = (int)(uintptr_t)lds + v_rd_base(lane);
  bf16_t* Ow = Ob + (long)(wid * 32) * 1024;
#pragma unroll
  for (int dvh = 0; dvh < 2; ++dvh) { f32x16 o[4] = {};
#pragma unroll
    for (int kt = 0; kt < 4; ++kt) pv_d0(o, vb0 + (kt * 2 + dvh) * 16384, pa[4 * kt], pa[4 * kt + 1], pa[4 * kt + 2], pa[4 * kt + 3]);
#pragma unroll
    for (int r = 0; r < 16; ++r) { const int orow = crow(r, hi);
#pragma unroll
      for (int d0 = 0; d0 < 4; ++d0) { const float v = o[d0][r] * rli[r]; Ow[(long)orow * 1024 + dvh * 128 + d0 * 32 + r32] = (bf16_t)(cvtpk(v, v) & 0xffffu); } } }
  __syncthreads();
}

__device__ __forceinline__ void flash_unit64c(const bf16_t* __restrict__ Qb, int ldq, const bf16_t* __restrict__ Kh, int ldk,
                                              const bf16_t* __restrict__ Vh, int ldv, bf16_t* __restrict__ Ob, int ldo, int nkeys, char* lds) {
  constexpr int KROWB = 128, SHM_K = 8192, SHM_V = 16384;
  const int tid = opaque_tid(), wid = tid >> 6, lane = tid & 63, r32 = lane & 31, hi = lane >> 5;
  char* V_lds = lds; char* K_lds = lds + 2 * SHM_V;
  float* ws = (float*)(lds + 2 * SHM_V + 2 * SHM_K) + wid * 64; float* li_l = ws; float* al_l = ws + 32;
  float m_run = 0.f, l_reg = 0.f; f32x16 o[4] = {}; bf16x8 qr[4]; f32x16 negm = {};
  const bf16_t* Qw = Qb + (long)(wid * 32 + r32) * ldq + hi * 8;
#pragma unroll
  for (int d0 = 0; d0 < 4; ++d0) qr[d0] = *reinterpret_cast<const bf16x8*>(Qw + d0 * 16);
  const int vr = 2 * (tid >> 5) + ((tid >> 2) & 1), vc = (((tid >> 3) & 3) * 4 + (tid & 3)) * 8, vst0 = v_st(vr, vc), vst1 = v_st(32 + vr, vc);
  const int kr = tid >> 3, kc = tid & 7, kst = kr * KROWB + ((kc * 16) ^ (((kr >> 1) & 7) << 4));
  const int vb0 = (int)(uintptr_t)V_lds + v_rd_base(lane);
  const int ksw = ((r32 >> 1) & 7) << 4;
  bf16x8 vs0, vs1, ks;
#define F4_SLOAD(k0) do { vs0 = *reinterpret_cast<const bf16x8*>(Vh + (long)((k0) + vr) * ldv + vc); vs1 = *reinterpret_cast<const bf16x8*>(Vh + (long)((k0) + 32 + vr) * ldv + vc); \
    ks = *reinterpret_cast<const bf16x8*>(Kh + (long)((k0) + kr) * ldk + kc * 8); } while (0)
#define F4_SWRITE(b) do { *(bf16x8*)(V_lds + (b) * SHM_V + vst0) = vs0; *(bf16x8*)(V_lds + (b) * SHM_V + vst1) = vs1; *(bf16x8*)(K_lds + (b) * SHM_K + kst) = ks; } while (0)
#define F4_PK4(P, BASE, OUT) do { unsigned a0 = cvtpk(P[BASE + 0], P[BASE + 1]), a1 = cvtpk(P[BASE + 2], P[BASE + 3]);   \
    unsigned b0 = cvtpk(P[BASE + 4], P[BASE + 5]), b1 = cvtpk(P[BASE + 6], P[BASE + 7]);                              \
    auto r0 = __builtin_amdgcn_permlane32_swap(a0, b0, false, false); auto r1 = __builtin_amdgcn_permlane32_swap(a1, b1, false, false); \
    u32x4 w = {r0[0], r1[0], r0[1], r1[1]}; OUT = *reinterpret_cast<bf16x8*>(&w); } while (0)
#define F4_TILE(b, FIRST) do { f32x16 p0, p1; bf16x8 pa0, pa1, pa2, pa3; const char* Ks_ = K_lds + (b) * SHM_K; \
    _Pragma("unroll") for (int d0 = 0; d0 < 4; ++d0) { const int cb = (d0 * 16 + hi * 8) * 2; \
      const bf16x8 b0 = *reinterpret_cast<const bf16x8*>(Ks_ + r32 * KROWB + (cb ^ ksw)); const bf16x8 b1 = *reinterpret_cast<const bf16x8*>(Ks_ + (32 + r32) * KROWB + (cb ^ ksw)); \
      if (d0 == 0) { p0 = __builtin_amdgcn_mfma_f32_32x32x16_bf16(b0, qr[0], negm, 0, 0, 0); p1 = __builtin_amdgcn_mfma_f32_32x32x16_bf16(b1, qr[0], negm, 0, 0, 0); } \
      else { p0 = __builtin_amdgcn_mfma_f32_32x32x16_bf16(b0, qr[d0], p0, 0, 0, 0); p1 = __builtin_amdgcn_mfma_f32_32x32x16_bf16(b1, qr[d0], p1, 0, 0, 0); } } \
    float pmax = p0[0]; \
    _Pragma("unroll") for (int r = 1; r < 16; ++r) pmax = fmaxf(pmax, p0[r]); \
    _Pragma("unroll") for (int r = 0; r < 16; ++r) pmax = fmaxf(pmax, p1[r]); \
    { auto rr = __builtin_amdgcn_permlane32_swap(__float_as_uint(pmax), __float_as_uint(pmax), false, false); pmax = fmaxf(__uint_as_float(rr[0]), __uint_as_float(rr[1])); } \
    if ((FIRST) || !__builtin_expect(__all(pmax <= 8.f), 1)) { const float dl = (FIRST) ? pmax : fmaxf(pmax, 0.f); const float alpha = __builtin_amdgcn_exp2f(-dl); m_run += dl; l_reg *= alpha; \
      _Pragma("unroll") for (int r = 0; r < 16; ++r) { p0[r] -= dl; p1[r] -= dl; negm[r] = -m_run; } \
      if (!(FIRST)) { if (hi == 0) al_l[r32] = alpha; asm volatile("s_waitcnt lgkmcnt(0)" ::: "memory"); \
        _Pragma("unroll") for (int d_ = 0; d_ < 4; ++d_) _Pragma("unroll") for (int r_ = 0; r_ < 16; ++r_) o[d_][r_] *= al_l[crow(r_, hi)]; } } \
    _Pragma("unroll") for (int r = 0; r < 16; ++r) { p0[r] = __builtin_amdgcn_exp2f(p0[r]); p1[r] = __builtin_amdgcn_exp2f(p1[r]); } \
    float ps = 0.f; \
    _Pragma("unroll") for (int r = 0; r < 16; ++r) ps += p0[r]; \
    _Pragma("unroll") for (int r = 0; r < 16; ++r) ps += p1[r]; \
    { auto rr = __builtin_amdgcn_permlane32_swap(__float_as_uint(ps), __float_as_uint(ps), false, false); ps = __uint_as_float(rr[0]) + __uint_as_float(rr[1]); } \
    l_reg += ps; \
    F4_PK4(p0, 0, pa0); F4_PK4(p0, 8, pa1); F4_PK4(p1, 0, pa2); F4_PK4(p1, 8, pa3); \
    pv_d0(o, vb0 + (b) * SHM_V, pa0, pa1, pa2, pa3); } while (0)
  const int NT = nkeys / 64;
  F4_SLOAD(0); F4_SWRITE(0); F4_SLOAD(64); F4_SWRITE(1); F4_SLOAD(128); __syncthreads();
  F4_TILE(0, true);
  __syncthreads();
  F4_SWRITE(0); F4_SLOAD(192);
  for (int j = 1; j + 1 < NT; j += 2) {
    F4_TILE(1, false);
    __syncthreads();
    if (j + 2 < NT) { F4_SWRITE(1); if (j + 3 < NT) F4_SLOAD((j + 3) * 64); }
    F4_TILE(0, false);
    __syncthreads();
    if (j + 3 < NT) { F4_SWRITE(0); if (j + 4 < NT) F4_SLOAD((j + 4) * 64); }
  }
  F4_TILE(1, false);
  __syncthreads();
  if (hi == 0) li_l[r32] = l_reg; asm volatile("s_waitcnt lgkmcnt(0)" ::: "memory");
  float rli[16];
#pragma unroll
  for (int r = 0; r < 16; ++r) rli[r] = __builtin_amdgcn_rcpf(li_l[crow(r, hi)]);
  bf16_t* Ow = Ob + (long)(wid * 32) * ldo;
  { bf16_t* stg = (bf16_t*)(lds + 65536) + wid * 4096;
#pragma unroll
    for (int r = 0; r < 16; ++r) { const int orow = crow(r, hi);
#pragma unroll
      for (int d0 = 0; d0 < 4; ++d0) { const float v = o[d0][r] * rli[r]; stg[orow * 128 + d0 * 32 + r32] = (bf16_t)(cvtpk(v, v) & 0xffffu); } }
    asm volatile("s_waitcnt lgkmcnt(0)" ::: "memory");
#pragma unroll
    for (int i = 0; i < 8; ++i) { const int row = i * 4 + (lane >> 4), ch = lane & 15; const u32x4 v = *(const u32x4*)(stg + row * 128 + ch * 8); *(u32x4*)(Ow + (long)row * ldo + ch * 8) = v; } }
  __syncthreads();
#undef F4_SLOAD
#undef F4_SWRITE
#undef F4_PK4
#undef F4_TILE
}
}
typedef unsigned short bf16;
typedef float f32x4 __attribute__((ext_vector_type(4)));
typedef unsigned v4u __attribute__((ext_vector_type(4)));
typedef short bf16x8 __attribute__((ext_vector_type(8)));
typedef float f32x16 __attribute__((ext_vector_type(16)));
#define LAS __attribute__((address_space(3)))
constexpr int BATCH = 8, SEQ = 4096, DM = 1024, T = BATCH * SEQ, DEPTH = 2, NMEM = 256, TM = BATCH * NMEM, INW = 2560, DFF = 4096;
constexpr int NWAVES = 8, NTHR = 512;
constexpr size_t MiB = 1u << 20;
constexpr size_t WS_W = 0, W_LAYER = 32 * MiB;
constexpr size_t WO_IN = 0, WO_OUT = 5 * MiB, WO_Q = 7 * MiB, WO_KV = 9 * MiB, WO_O = 13 * MiB, WO_1 = 15 * MiB, WO_2 = 23 * MiB;
constexpr size_t WS_GATE = 64 * MiB;
constexpr size_t WS_ROPE = 65 * MiB;
constexpr size_t WS_RSS = 67 * MiB;
constexpr size_t WS_MEMN = 68 * MiB;
constexpr size_t WS_KVX = 76 * MiB;
constexpr size_t WS_SUM = 92 * MiB;
constexpr size_t WS_XB = 108 * MiB;
constexpr size_t WS_Z = 172 * MiB, WS_OC = 332 * MiB, WS_MIX = 396 * MiB, WS_CIN = 460 * MiB, WS_RSSP = 464 * MiB, WS_END = 480 * MiB;
constexpr size_t WS_BAR = WS_RSS + 964 * 1024;
constexpr size_t WS_CNT = WS_RSS + 960 * 1024;
constexpr size_t WS_H = WS_Z, WS_QX = WS_Z, WS_OX = WS_Z + 64 * MiB;
constexpr int LDS_BYTES = 147456;
constexpr float LOG2E = 1.4426950408889634f;

__device__ __forceinline__ float bf2f(short v) { return __uint_as_float(((unsigned)(unsigned short)v) << 16); }
__device__ __forceinline__ unsigned f2bf(float f) { unsigned u = __builtin_bit_cast(unsigned, f); return (u + 0x7fffu + ((u >> 16) & 1u)) >> 16; }
__device__ __forceinline__ unsigned pk2(float lo, float hi) { return f2bf(lo) | (f2bf(hi) << 16); }
__device__ __forceinline__ float wave_sum(float v) {
#pragma unroll
    for (int o = 1; o < 64; o <<= 1) v += __shfl_xor(v, o);
    return v;
}
__device__ __forceinline__ float sigm(float x) { return __builtin_amdgcn_rcpf(1.f + __expf(-x)); }
__device__ __forceinline__ float gelu_tanh(float x) { const float y = 0.7978845608028654f * (x + 0.044715f * x * x * x); const float e = __expf(2.f * y); const float th = 1.f - 2.f * __builtin_amdgcn_rcpf(e + 1.f); return 0.5f * x * (1.f + th); }

struct LruArgs { const float* spl; float* CIN; unsigned* CNT; const bf16* Z; const float *conv_w, *conv_b, *b_r, *b_i, *a_param, *norm_g; const bf16* WG; float* SUM; bf16* MIX; const bf16* OC; const float* subln_g; float lam, oml; };
constexpr int CSB = 1040, CFS = 516, CF_OFF = 34816;
__device__ __forceinline__ int crow16(int r, int hi) { return (r & 3) + 8 * (r >> 2) + 4 * hi; }

template <bool REV> __device__ __forceinline__ void lru_scan(f32x16& a, f32x16& u, float cin, float& Atot, float& Htot, int hi) {
    float P[16], As[4], Hs[4];
#pragma unroll
    for (int s = 0; s < 4; ++s) { float h = 0.f, p = 1.f;
#pragma unroll
        for (int q = 0; q < 4; ++q) { const int r = REV ? 4 * s + 3 - q : 4 * s + q; h = a[r] * h + u[r]; p *= a[r]; u[r] = h; P[r] = p; }
        As[s] = p; Hs[s] = h; }
    float pA[4], pH[4];
#pragma unroll
    for (int s = 0; s < 4; ++s) { pA[s] = __shfl_xor(As[s], 32); pH[s] = __shfl_xor(Hs[s], 32); }
    float c = cin, at = 1.f, cm[4] = {0.f, 0.f, 0.f, 0.f};
#pragma unroll
    for (int gg = 0; gg < 8; ++gg) { const int g = REV ? 7 - gg : gg; const int s = g >> 1; const bool own = ((g & 1) == hi);
        const float Ag = own ? As[s] : pA[s], Hg = own ? Hs[s] : pH[s];
        cm[s] = own ? c : cm[s];
        c = Ag * c + Hg; at *= Ag; }
    Atot = at; Htot = c;
#pragma unroll
    for (int r = 0; r < 16; ++r) u[r] = u[r] + P[r] * cm[r >> 2];
}
template <bool REV> __device__ __forceinline__ float lru_carry(const float* sb  , int j) {
    const int n = REV ? 127 - j : j; float c = 0.f;
    for (int k0 = 0; k0 < n; k0 += 8) { float Av[8], Hv[8];
#pragma unroll
        for (int q = 0; q < 8; ++q) { const int k = k0 + q; const bool ok = k < n; const int i = ok ? (REV ? 127 - k : k) : (REV ? 127 : 0);
            const float av = sb[(size_t)i * 2048], hv = sb[(size_t)i * 2048 + 512]; Av[q] = ok ? av : 1.f; Hv[q] = ok ? hv : 0.f; }
#pragma unroll
        for (int q = 0; q < 8; ++q) c = Av[q] * c + Hv[q];
    }
    return c;
}
__device__ __forceinline__ void lru_xload(bf16x8 (&xr)[7], const LruArgs& A, int b, int j, int w, int lane) {
    const int t0 = j * 32 + 4 * w; const long rowb = (long)b * SEQ;
#pragma unroll
    for (int rr = 0; rr < 7; ++rr) { const int t = t0 + rr - 2; const int tc = t < 0 ? 0 : (t >= SEQ ? SEQ - 1 : t);
        const bf16x8 raw = *(const bf16x8*)(A.Z + (rowb + tc) * INW + 1536 + 8 * lane); xr[rr] = (t >= 0 && t < SEQ) ? raw : (bf16x8){0, 0, 0, 0, 0, 0, 0, 0}; }
}
template <bool FINAL> __device__ __forceinline__ void lru_chunk(const LruArgs& A, int b, int j, char* lds, bf16x8 (&xr)[7], int nb_, int nj_, bool publish) {
    const int tid = opaque_tid(), w = __builtin_amdgcn_readfirstlane(tid >> 6), lane = tid & 63, n32 = lane & 31, hi = lane >> 5;
    char* Cs = lds; float* Cf = (float*)(lds + CF_OFF);
    const long rowb = (long)b * SEQ;
    {
        const int tl = 4 * w;
        float xv[7][8];
#pragma unroll
        for (int rr = 0; rr < 7; ++rr) {
#pragma unroll
            for (int e = 0; e < 8; ++e) xv[rr][e] = bf2f(xr[rr][e]); }
        float cw[4][8], cb[8];
#pragma unroll
        for (int jj = 0; jj < 4; ++jj) { const f32x4 a0 = *(const f32x4*)(A.conv_w + jj * 512 + 8 * lane), a1 = *(const f32x4*)(A.conv_w + jj * 512 + 8 * lane + 4);
#pragma unroll
            for (int e = 0; e < 4; ++e) { cw[jj][e] = a0[e]; cw[jj][4 + e] = a1[e]; } }
        { const f32x4 a0 = *(const f32x4*)(A.conv_b + 8 * lane), a1 = *(const f32x4*)(A.conv_b + 8 * lane + 4);
#pragma unroll
            for (int e = 0; e < 4; ++e) { cb[e] = a0[e]; cb[4 + e] = a1[e]; } }
#pragma unroll
        for (int tt = 0; tt < 4; ++tt) { float c[8];
#pragma unroll
            for (int e = 0; e < 8; ++e) c[e] = cb[e] + cw[0][e] * xv[tt][e] + cw[1][e] * xv[tt + 1][e] + cw[2][e] * xv[tt + 2][e] + cw[3][e] * xv[tt + 3][e];
            v4u pk; pk.x = pk2(c[0], c[1]); pk.y = pk2(c[2], c[3]); pk.z = pk2(c[4], c[5]); pk.w = pk2(c[6], c[7]);
            *(v4u*)(Cs + (tl + tt) * CSB + lane * 16) = pk;
            *(f32x4*)(Cf + (tl + tt) * CFS + 8 * lane) = (f32x4){c[0], c[1], c[2], c[3]};
            *(f32x4*)(Cf + (tl + tt) * CFS + 8 * lane + 4) = (f32x4){c[4], c[5], c[6], c[7]}; }
    }
    __syncthreads();
    if (nj_ >= 0) lru_xload(xr, A, nb_, nj_, w, lane);
    bf16x8 gpre[4], o1pre[4], o2pre[4];
    if (FINAL) {
#pragma unroll
        for (int tt = 0; tt < 4; ++tt) { const long grow = rowb + j * 32 + 4 * w + tt;
            gpre[tt] = *(const bf16x8*)(A.Z + grow * INW + 2048 + 8 * lane); o1pre[tt] = *(const bf16x8*)(A.OC + grow * 512 + 8 * lane); o2pre[tt] = *(const bf16x8*)(A.OC + (size_t)T * 512 + grow * 512 + 8 * lane); } }
    bf16x8 af[4];
#pragma unroll
    for (int ks = 0; ks < 4; ++ks) af[ks] = *(const bf16x8*)(Cs + n32 * CSB + (64 * w + 16 * ks + 8 * hi) * 2);
#pragma unroll
    for (int nb = 0; nb < 2; ++nb) {
        const int cl = 32 * nb + n32, ch = 64 * w + cl;
        f32x16 hs = {};
#pragma unroll
        for (int dir = 0; dir < 2; ++dir) {
            const bf16* wg_r = A.WG + ((size_t)((dir * 2 + 0) * 8 + w) * 64 + cl) * 64 + 8 * hi;
            const bf16* wg_i = A.WG + ((size_t)((dir * 2 + 1) * 8 + w) * 64 + cl) * 64 + 8 * hi;
            f32x16 dr = {}, di = {};
#pragma unroll
            for (int ks = 0; ks < 4; ++ks) {
                dr = __builtin_amdgcn_mfma_f32_32x32x16_bf16(af[ks], *(const bf16x8*)(wg_r + 16 * ks), dr, 0, 0, 0);
                di = __builtin_amdgcn_mfma_f32_32x32x16_bf16(af[ks], *(const bf16x8*)(wg_i + 16 * ks), di, 0, 0, 0); }
            const float spl = A.spl[dir * 512 + ch], br = -LOG2E * A.b_r[dir * 512 + ch], bi = -LOG2E * A.b_i[dir * 512 + ch];
#pragma unroll
            for (int r = 0; r < 16; ++r) { const int tok = crow16(r, hi);
                const float rg = __builtin_amdgcn_rcpf(1.f + __builtin_amdgcn_exp2f(dr[r] + br)), ig = __builtin_amdgcn_rcpf(1.f + __builtin_amdgcn_exp2f(di[r] + bi));
                const float a = __builtin_amdgcn_exp2f(rg * spl), mult = __builtin_amdgcn_sqrtf(fmaf(-a, a, 1.f));
                dr[r] = a; di[r] = Cf[tok * CFS + ch] * ig * mult; }
            float cin = 0.f;
            if (FINAL) cin = A.CIN[((size_t)(b * 128 + j) * 2 + dir) * 512 + ch];
            float At, Ht;
            if (dir) lru_scan<true>(dr, di, cin, At, Ht, hi); else lru_scan<false>(dr, di, cin, At, Ht, hi);
            if (!FINAL) { if (hi == 0) { float* sp_ = A.SUM + ((size_t)(b * 128 + j) * 2 + dir) * 1024 + ch;
                __hip_atomic_store(sp_, At, __ATOMIC_RELAXED, __HIP_MEMORY_SCOPE_AGENT); __hip_atomic_store(sp_ + 512, Ht, __ATOMIC_RELAXED, __HIP_MEMORY_SCOPE_AGENT); } }
            else { hs = dir ? hs + di : di; }
        }
        if (FINAL) {
#pragma unroll
            for (int r = 0; r < 16; ++r) Cf[crow16(r, hi) * CFS + ch] = hs[r];
        }
    }
    if (!FINAL && publish) {
        asm volatile("s_waitcnt vmcnt(0)" ::: "memory");
        __syncthreads();
        LAS unsigned* flag = (LAS unsigned*)(lds + 131072 - 16);
        if (tid == 0) { const unsigned old = __hip_atomic_fetch_add(A.CNT + b, 4u, __ATOMIC_RELAXED, __HIP_MEMORY_SCOPE_AGENT); *flag = (old == 124u) ? 1u : 0u; }
        __syncthreads();
        const bool last = (*flag != 0u);
        if (last) {
            __builtin_amdgcn_fence(__ATOMIC_ACQUIRE, "agent");
            const float* sb = A.SUM + (size_t)b * 128 * 2048 + tid;
            float* cb_ = A.CIN + (size_t)b * 128 * 1024 + tid;
            float cf = 0.f, cr = 0.f;
            for (int k0 = 0; k0 < 128; k0 += 32) { float Af[32], Hf[32], Ar[32], Hr[32];
#pragma unroll
                for (int q = 0; q < 32; ++q) { const int jf = k0 + q, jr = 127 - jf;
                    Af[q] = __hip_atomic_load(sb + (size_t)jf * 2048, __ATOMIC_RELAXED, __HIP_MEMORY_SCOPE_AGENT); Hf[q] = __hip_atomic_load(sb + (size_t)jf * 2048 + 512, __ATOMIC_RELAXED, __HIP_MEMORY_SCOPE_AGENT);
                    Ar[q] = __hip_atomic_load(sb + (size_t)jr * 2048 + 1024, __ATOMIC_RELAXED, __HIP_MEMORY_SCOPE_AGENT); Hr[q] = __hip_atomic_load(sb + (size_t)jr * 2048 + 1536, __ATOMIC_RELAXED, __HIP_MEMORY_SCOPE_AGENT); }
#pragma unroll
                for (int q = 0; q < 32; ++q) { const int jf = k0 + q, jr = 127 - jf;
                    cb_[(size_t)jf * 1024] = cf; cf = Af[q] * cf + Hf[q];
                    cb_[(size_t)jr * 1024 + 512] = cr; cr = Ar[q] * cr + Hr[q]; }
            }
        }
    }
    __syncthreads();
    if (FINAL) {
#pragma unroll
        for (int tt = 0; tt < 4; ++tt) { const int tl = 4 * w + tt; const long grow = rowb + j * 32 + tl;
            const f32x4 y0 = *(const f32x4*)(Cf + tl * CFS + 8 * lane), y1 = *(const f32x4*)(Cf + tl * CFS + 8 * lane + 4);
            const bf16x8 g = gpre[tt];
            float y[8]; float ss = 0.f;
#pragma unroll
            for (int e = 0; e < 8; ++e) { const float yv = e < 4 ? y0[e] : y1[e - 4]; y[e] = yv * gelu_tanh(bf2f(g[e])); ss += y[e] * y[e]; }
            ss = wave_sum(ss); const float rs = rsqrtf(ss * (1.f / 512.f) + 1e-6f);
            const f32x4 g0 = *(const f32x4*)(A.norm_g + 8 * lane), g1 = *(const f32x4*)(A.norm_g + 8 * lane + 4);
            v4u pk; pk.x = pk2(y[0] * rs * g0[0], y[1] * rs * g0[1]); pk.y = pk2(y[2] * rs * g0[2], y[3] * rs * g0[3]); pk.z = pk2(y[4] * rs * g1[0], y[5] * rs * g1[1]); pk.w = pk2(y[6] * rs * g1[2], y[7] * rs * g1[3]);
            *(v4u*)(A.MIX + grow * DM + 512 + 8 * lane) = pk;
            const bf16x8 o1 = o1pre[tt], o2 = o2pre[tt];
            float d[8]; float s2 = 0.f;
#pragma unroll
            for (int e = 0; e < 8; ++e) { d[e] = bf2f(o1[e]) - A.lam * bf2f(o2[e]); s2 += d[e] * d[e]; }
            s2 += __shfl_xor(s2, 1); s2 += __shfl_xor(s2, 2); s2 += __shfl_xor(s2, 4); s2 += __shfl_xor(s2, 8);
            const float r2 = rsqrtf(s2 * (1.f / 128.f) + 1e-6f) * A.oml;
            const int gc = (8 * lane) & 127;
            const f32x4 s0 = *(const f32x4*)(A.subln_g + gc), s1 = *(const f32x4*)(A.subln_g + gc + 4);
            v4u pq; pq.x = pk2(d[0] * r2 * s0[0], d[1] * r2 * s0[1]); pq.y = pk2(d[2] * r2 * s0[2], d[3] * r2 * s0[3]); pq.z = pk2(d[4] * r2 * s1[0], d[5] * r2 * s1[1]); pq.w = pk2(d[6] * r2 * s1[2], d[7] * r2 * s1[3]);
            *(v4u*)(A.MIX + grow * DM + 8 * lane) = pq; }
        __syncthreads();
    }
}
#define XB_TMO      128
#define XB_XCNT(j)  (256  + 64 * (j))
#define XB_XSUB(j)  (1280 + 64 * (j))
#define XB_XGEN(j)  (2304 + 64 * (j))
#define XB_TOP      3328
#define XB_TOPGEN   3392
#define XCD_BAR_WORDS 3456
#define XB_SPIN_CAP (1u << 18)

__device__ __forceinline__ unsigned xb_ld(unsigned* p)              { return __hip_atomic_load(p, __ATOMIC_RELAXED, __HIP_MEMORY_SCOPE_AGENT); }
__device__ __forceinline__ unsigned xb_add(unsigned* p, unsigned v) { return __hip_atomic_fetch_add(p, v, __ATOMIC_RELAXED, __HIP_MEMORY_SCOPE_AGENT); }
__device__ __forceinline__ unsigned xb_xcc_id() { return (unsigned)__builtin_amdgcn_s_getreg((3 << 11) | 20) & 0xFu; }
#define XB_SPIN(cond, bar) do { unsigned _sp = 0; while (cond) { __builtin_amdgcn_s_sleep(1); \
    if ((++_sp & 255u) == 0u) { if (xb_ld(&(bar)[XB_TMO])) break; if (_sp > XB_SPIN_CAP) { atomicAdd(&(bar)[XB_TMO], 1u); break; } } } } while (0)

struct XcdBarrier {
    unsigned* bar; unsigned x;
    volatile LAS unsigned* st;
};

__device__ __forceinline__ XcdBarrier xcd_barrier_post(unsigned* bar, volatile LAS unsigned* st) {
    XcdBarrier b; b.bar = bar; b.x = xb_xcc_id(); b.st = st;
    if (threadIdx.x == 0) (void)xb_add(&bar[XB_XCNT(b.x)], 1u);
    return b;
}
__device__ __forceinline__ void xcd_barrier_complete(unsigned* bar, unsigned x, unsigned& nloc, unsigned& nx) {
    const unsigned G = gridDim.x * gridDim.y * gridDim.z;
    unsigned sum, cnt, mine, sp = 0u;
    for (;;) {
        sum = 0u; cnt = 0u; mine = 0u;
#pragma unroll
        for (unsigned j = 0; j < 16; ++j) { const unsigned c = xb_ld(&bar[XB_XCNT(j)]); sum += c; cnt += (c > 0u) ? 1u : 0u; mine = (j == x) ? c : mine; }
        if (sum == G) break;
        __builtin_amdgcn_s_sleep(1);
        if ((++sp & 255u) == 0u) { if (xb_ld(&bar[XB_TMO])) break; if (sp > XB_SPIN_CAP) { atomicAdd(&bar[XB_TMO], 1u); break; } }
    }
    nloc = mine > 0u ? mine : 1u; nx = cnt > 0u ? cnt : 1u;
}

__device__ __forceinline__ void xcd_barrier(const XcdBarrier& b) {
    asm volatile("s_waitcnt vmcnt(0)" ::: "memory");
    __syncthreads();
    if (threadIdx.x == 0) {
        unsigned* bar = b.bar;
        __builtin_amdgcn_s_waitcnt(0);
        unsigned nloc = b.st[0], nx = b.st[1];
        if (nloc == 0u) { xcd_barrier_complete(bar, b.x, nloc, nx); b.st[0] = nloc; b.st[1] = nx; }
        const unsigned old = xb_add(&bar[XB_XSUB(b.x)], 1u);
        const unsigned gen = old / nloc;
        if (old + 1u == (gen + 1u) * nloc) {
            __builtin_amdgcn_fence(__ATOMIC_RELEASE, "agent");
            asm volatile("s_waitcnt vmcnt(0)" ::: "memory");
            const unsigned og = xb_add(&bar[XB_TOP], 1u);
            const unsigned tg = og / nx;
            if (og + 1u == (tg + 1u) * nx) xb_add(&bar[XB_TOPGEN], 1u);
            else XB_SPIN(xb_ld(&bar[XB_TOPGEN]) == tg, bar);
            __builtin_amdgcn_fence(__ATOMIC_ACQUIRE, "agent");
            xb_add(&bar[XB_XGEN(b.x)], 1u);
            asm volatile("s_waitcnt vmcnt(0)" ::: "memory");
        } else {
            XB_SPIN(xb_ld(&bar[XB_XGEN(b.x)]) == gen, bar);
            __builtin_amdgcn_fence(__ATOMIC_ACQUIRE, "agent");
            asm volatile("s_waitcnt vmcnt(0)" ::: "memory");
        }
    }
    __syncthreads();
}

struct Args { const void* in[29]; float* out; unsigned char* ws; };
__device__ __forceinline__ void transpose_item(const float* W, int K, int N, bf16* WT, int row_off, const float* gain, LAS float* scr, int item, int lane) {
    const int nblk = N / 32, kb = item / nblk, nb = item % nblk, k0 = 64 * kb, n0 = 32 * nb;
    float wv_[32];
#pragma unroll
    for (int i = 0; i < 32; ++i) wv_[i] = W[(size_t)(k0 + 2 * i + (lane >> 5)) * N + n0 + (lane & 31)];
#pragma unroll
    for (int i = 0; i < 32; ++i) { const int kk = 2 * i + (lane >> 5); const float gv = gain ? gain[k0 + kk] : 1.f; scr[kk * 33 + (lane & 31)] = wv_[i] * gv; }
    asm volatile("s_waitcnt lgkmcnt(0)" ::: "memory");
    const int c = lane & 7;
#pragma unroll
    for (int j = 0; j < 4; ++j) { const int n = (lane >> 3) + 8 * j; const LAS float* s = scr + (8 * c) * 33 + n;
        v4u o; o.x = pk2(s[0 * 33], s[1 * 33]); o.y = pk2(s[2 * 33], s[3 * 33]); o.z = pk2(s[4 * 33], s[5 * 33]); o.w = pk2(s[6 * 33], s[7 * 33]);
        *(v4u*)(WT + (size_t)(row_off + n0 + n) * K + k0 + 8 * c) = o; }
    asm volatile("s_waitcnt lgkmcnt(0)" ::: "memory");
}
#define IN_F(i) ((const float*)args.in[i])

__global__ void __launch_bounds__(NTHR, 2) mega_fwd(Args args) {
    extern __shared__ __attribute__((aligned(16))) unsigned char lds[];
    cg::grid_group grid = cg::this_grid();
    const int tid = threadIdx.x, lane = tid & 63, wave = __builtin_amdgcn_readfirstlane(tid >> 6);
    const int G = gridDim.x, bx = blockIdx.x;
    const int vcu = (G % 8 == 0) ? (bx % 8) * (G / 8) + bx / 8 : bx;
    unsigned char* ws = args.ws;
    float* XF = args.out;
    bf16* XB = (bf16*)(ws + WS_XB);
    float* RSS = (float*)(ws + WS_RSSP);
    float* ROPE = (float*)(ws + WS_ROPE);
    bf16* Zb = (bf16*)(ws + WS_Z); bf16* OC = (bf16*)(ws + WS_OC); bf16* MIX = (bf16*)(ws + WS_MIX);
    bf16* Hb = (bf16*)(ws + WS_H); bf16* QX = (bf16*)(ws + WS_QX); bf16* OX = (bf16*)(ws + WS_OX);
    LAS unsigned char* ldsl = (LAS unsigned char*)lds;

    volatile LAS unsigned* bst = (volatile LAS unsigned*)(ldsl + 131072 + 64);
    if (tid < 2) bst[tid] = 0u;
    __syncthreads();
    for (int rep_ = 0; rep_ < REP_PRO; ++rep_) {
        const int gw = vcu * NWAVES + wave, NGW = G * NWAVES;
        LAS float* scr = (LAS float*)(ldsl + wave * 16384);
        constexpr int I_IN = 16 * 80, I_SQ = 16 * 32, I_1 = 16 * 128, I_2 = 64 * 32, IPL = I_IN + 5 * I_SQ + I_1 + I_2;
        for (int it = gw; it < DEPTH * IPL; it += NGW) {
            const int l = it / IPL; int r = it % IPL; unsigned char* wl = ws + WS_W + (size_t)l * W_LAYER;
            if (r < I_IN) { transpose_item(IN_F(4) + (size_t)l * DM * INW, DM, INW, (bf16*)(wl + WO_IN), 0, IN_F(3) + l * DM, scr, r, lane); continue; } r -= I_IN;
            if (r < I_SQ) { transpose_item(IN_F(18) + (size_t)l * DM * DM, DM, DM, (bf16*)(wl + WO_OUT), 0, nullptr, scr, r, lane); continue; } r -= I_SQ;
            if (r < I_SQ) { transpose_item(IN_F(21) + (size_t)l * DM * DM, DM, DM, (bf16*)(wl + WO_Q), 0, IN_F(19) + l * DM, scr, r, lane); continue; } r -= I_SQ;
            if (r < I_SQ) { transpose_item(IN_F(22) + (size_t)l * DM * DM, DM, DM, (bf16*)(wl + WO_KV), 0, nullptr, scr, r, lane); continue; } r -= I_SQ;
            if (r < I_SQ) { transpose_item(IN_F(23) + (size_t)l * DM * DM, DM, DM, (bf16*)(wl + WO_KV), DM, nullptr, scr, r, lane); continue; } r -= I_SQ;
            if (r < I_SQ) { transpose_item(IN_F(24) + (size_t)l * DM * DM, DM, DM, (bf16*)(wl + WO_O), 0, nullptr, scr, r, lane); continue; } r -= I_SQ;
            if (r < I_1) { transpose_item(IN_F(26) + (size_t)l * DM * DFF, DM, DFF, (bf16*)(wl + WO_1), 0, IN_F(25) + l * DM, scr, r, lane); continue; } r -= I_1;
            transpose_item(IN_F(27) + (size_t)l * DFF * DM, DFF, DM, (bf16*)(wl + WO_2), 0, nullptr, scr, r, lane);
        }
        const int gt = vcu * NTHR + tid, NGT = G * NTHR;
        { bf16* WG = (bf16*)(ws + WS_GATE);
          for (int o = gt; o < DEPTH * 2 * 2 * 8 * 64 * 64; o += NGT) { const int i = o & 63, jx = (o >> 6) & 63, n = (o >> 12) & 7, gate = (o >> 15) & 1, dir = (o >> 16) & 1, l = o >> 17;
              const float* src = gate ? IN_F(14) : IN_F(12);
              WG[o] = (bf16)f2bf(-LOG2E * src[((((size_t)l * 2 + dir) * 8 + n) * 64 + i) * 64 + jx]); } }
        { float* SPL = (float*)(ws + WS_GATE + 768 * 1024); for (int o = gt; o < DEPTH * 2 * 512; o += NGT) SPL[o] = -8.f * LOG2E * log1pf(expf(-IN_F(16)[o])); }
        { const int* pos = (const int*)args.in[2];
          for (int o = gt; o < T * 8; o += NGT) { const int row = o >> 3, i = o & 7; const float inv = powf(500000.f, -(float)i * 0.125f); const float ang = (float)pos[row] * inv;
              ROPE[row * 16 + i] = cosf(ang); ROPE[row * 16 + 8 + i] = sinf(ang); } }
        if (gt < DEPTH * BATCH) ((unsigned*)(ws + WS_CNT))[gt] = 0u;
        if (gt < XCD_BAR_WORDS) ((unsigned*)(ws + WS_BAR))[gt] = 0u;
        for (int m0 = gw * 4; m0 < T; m0 += NGW * 4) { f32x4 v[4][4];
#pragma unroll
            for (int q = 0; q < 4; ++q) { const f32x4* xr = (const f32x4*)(IN_F(0) + (size_t)(m0 + q) * DM) + lane;
#pragma unroll
                for (int j = 0; j < 4; ++j) v[q][j] = xr[64 * j]; }
#pragma unroll
            for (int q = 0; q < 4; ++q) { float s = 0.f;
#pragma unroll
                for (int j = 0; j < 4; ++j) s += (v[q][j].x * v[q][j].x + v[q][j].y * v[q][j].y) + (v[q][j].z * v[q][j].z + v[q][j].w * v[q][j].w);
                s = wave_sum(s); if (lane < 16) RSS[(size_t)(m0 + q) * 16 + lane] = (lane == 0) ? s : 0.f;
                unsigned long long* o8 = (unsigned long long*)(XB + (size_t)(m0 + q) * DM) + lane;
#pragma unroll
                for (int j = 0; j < 4; ++j) o8[64 * j] = (unsigned long long)pk2(v[q][j].x, v[q][j].y) | ((unsigned long long)pk2(v[q][j].z, v[q][j].w) << 32); } }
        for (int m = gw; m < DEPTH * TM; m += NGW) { const int l = m / TM, row = m % TM; const f32x4* xr = (const f32x4*)(IN_F(1) + (size_t)row * DM) + lane; const f32x4* gr = (const f32x4*)(IN_F(20) + l * DM) + lane; f32x4 v[4]; float s = 0.f;
#pragma unroll
            for (int j = 0; j < 4; ++j) { v[j] = xr[64 * j]; s += (v[j].x * v[j].x + v[j].y * v[j].y) + (v[j].z * v[j].z + v[j].w * v[j].w); }
            const float rs = rsqrtf(wave_sum(s) * (1.f / DM) + 1e-6f);
            unsigned long long* o8 = (unsigned long long*)((bf16*)(ws + WS_MEMN) + (size_t)m * DM) + lane;
#pragma unroll
            for (int j = 0; j < 4; ++j) { const f32x4 g = gr[64 * j]; o8[64 * j] = (unsigned long long)pk2(v[j].x * rs * g.x, v[j].y * rs * g.y) | ((unsigned long long)pk2(v[j].z * rs * g.z, v[j].w * rs * g.w) << 32); } }
    }
    grid.sync();
    const XcdBarrier xbar = xcd_barrier_post((unsigned*)(ws + WS_BAR), bst);
#define GRID_BAR() xcd_barrier(xbar)

    for (int l = 0; l < DEPTH; ++l) {
        pg8::Gemm g{(const bf16*)(ws + WS_MEMN) + (size_t)l * TM * DM, (const bf16*)(ws + WS_W + (size_t)l * W_LAYER + WO_KV), TM, 2048, DM};
        pg8::StaticOrder S; S.init(TM, 2048, G, bx);
        pg8::EpiScale<0> E{(bf16*)(ws + WS_KVX) + (size_t)l * TM * 2048, 2048, nullptr, 1.f, nullptr};
        pg8::gemm_phase<pg8::EpiScale<0>, pg8::StaticOrder, true, true>(ldsl, g, S, E);
    }

#pragma unroll
    for (int l = 0; l < DEPTH; ++l) {
        unsigned char* wl = ws + WS_W + (size_t)l * W_LAYER;
        for (int rep_ = 0; rep_ < REP_IN; ++rep_) {
            pg8::Gemm g{XB, (const bf16*)(wl + WO_IN), T, INW, DM}; pg8::StaticOrder S; S.init(T, INW, G, bx);
            pg8::EpiScale<1> E{Zb, INW, RSS + (size_t)(3 * l) * T * 16, 0.125f * LOG2E, ROPE};
            pg8::gemm_phase<pg8::EpiScale<1>, pg8::StaticOrder, true, true>(ldsl, g, S, E);
        }
        GRID_BAR();
        const float lam_init = 0.8f - 0.6f * expf(-0.3f * (float)l);
        float lam;
        { const float a = wave_sum(IN_F(5)[l * 64 + lane] * IN_F(6)[l * 64 + lane]), b2 = wave_sum(IN_F(7)[l * 64 + lane] * IN_F(8)[l * 64 + lane]); lam = expf(a) - expf(b2) + lam_init; }
        LruArgs LA{(const float*)(ws + WS_GATE + 768 * 1024) + l * 1024, (float*)(ws + WS_CIN), (unsigned*)(ws + WS_CNT) + l * BATCH, Zb, IN_F(10) + (size_t)l * 4 * 512, IN_F(11) + l * 512, IN_F(13) + l * 1024, IN_F(15) + l * 1024, IN_F(16) + l * 1024, IN_F(17) + l * 512,
                   (const bf16*)(ws + WS_GATE) + (size_t)l * 131072, (float*)(ws + WS_SUM), MIX, OC, IN_F(9) + l * 128, lam, 1.f - lam_init};
#ifndef NO_LRUA
        for (int rep_ = 0; rep_ < REP_LRUA; ++rep_)
        for (int base = vcu * 4; base < BATCH * 128; base += G * 4) { bf16x8 xr[7]; lru_xload(xr, LA, base >> 7, base & 127, wave, lane);
#pragma unroll 1
            for (int i = 0; i < 4; ++i) lru_chunk<false>(LA, base >> 7, (base & 127) + i, (char*)lds, xr, base >> 7, i < 3 ? (base & 127) + i + 1 : -1, i == 3); }
#endif
        for (int rep_ = 0; rep_ < REP_FA; ++rep_)
        for (int i = 0; i * G < 1024; ++i) {
            const int L = i * G + vcu; if (L >= 1024) break;
            const int uid = (G == 256) ? (((vcu >> 5) * 4 + i) * 32 + (vcu & 31)) : L;
            const int bh = uid >> 5, wi = uid & 31, c = wi >> 4, qb = wi & 15, b = bh >> 2, h = bh & 3;
            const bf16* Qp = Zb + ((size_t)b * SEQ + qb * 256) * INW + h * 128 + c * 64;
            const bf16* Kp = Zb + ((size_t)b * SEQ) * INW + 512 + h * 128 + c * 64;
            const bf16* Vp = Zb + ((size_t)b * SEQ) * INW + 1024 + h * 128;
            bf16* Op = OC + (size_t)c * T * 512 + ((size_t)b * SEQ + qb * 256) * 512 + h * 128;
#ifndef NO_FA64
            fa::flash_unit64c(Qp, INW, Kp, INW, Vp, INW, Op, 512, SEQ, (char*)lds);
#endif
        }
        GRID_BAR();
#ifndef NO_LRUC
        for (int rep_ = 0; rep_ < REP_LRUC; ++rep_)
        for (int base = vcu * 4; base < BATCH * 128; base += G * 4) { bf16x8 xr[7]; lru_xload(xr, LA, base >> 7, base & 127, wave, lane);
#pragma unroll 1
            for (int i = 0; i < 4; ++i) lru_chunk<true>(LA, base >> 7, (base & 127) + i, (char*)lds, xr, base >> 7, i < 3 ? (base & 127) + i + 1 : -1, false); }
#endif
        GRID_BAR();
        {
            pg8::Gemm g{MIX, (const bf16*)(wl + WO_OUT), T, DM, DM}; pg8::StaticOrder S; S.init(T, DM, G, bx);
            if (l == 0) { pg8::EpiRes<true> E{IN_F(0), XB, RSS + (size_t)(3 * l + 1) * T * 16}; pg8::gemm_phase<pg8::EpiRes<true>, pg8::StaticOrder, true, true>(ldsl, g, S, E); }
            else { pg8::EpiRes<false> E{nullptr, XB, RSS + (size_t)(3 * l + 1) * T * 16}; pg8::gemm_phase<pg8::EpiRes<false>, pg8::StaticOrder, true, true>(ldsl, g, S, E); }
        }
        GRID_BAR();
        for (int rep_ = 0; rep_ < REP_Q; ++rep_) {
            pg8::Gemm g{XB, (const bf16*)(wl + WO_Q), T, DM, DM}; pg8::StaticOrder S; S.init(T, DM, G, bx);
            pg8::EpiScale<2> E{QX, DM, RSS + (size_t)(3 * l + 1) * T * 16, 0.0625f * LOG2E, nullptr};
            pg8::gemm_phase<pg8::EpiScale<2>, pg8::StaticOrder, true, true>(ldsl, g, S, E);
        }
        {
            pg8::StaticOrder S; S.init(T, DM, G, bx); pg8::Unit u;
            for (int rep_ = 0; rep_ < REP_XA; ++rep_)
            for (int i = 0; S.next(i, u); ++i)
            {
                    const int b = u.pm >> 4, qb = u.pm & 15, h = u.pn;
                    const bf16* KV = (const bf16*)(ws + WS_KVX) + (size_t)l * TM * 2048 + (size_t)b * NMEM * 2048;
                    const bf16* Qp = QX + ((size_t)b * SEQ + qb * 256) * DM + h * 256;
                    bf16* Op = OX + ((size_t)b * SEQ + qb * 256) * DM + h * 256;
#ifndef NO_FA256
                    fa::xattn_unit(Qp, KV + h * 256, KV + 1024 + h * 256, Op, (char*)lds);
#endif
            }
        }
        GRID_BAR();
        {
            pg8::Gemm g{OX, (const bf16*)(wl + WO_O), T, DM, DM}; pg8::StaticOrder S; S.init(T, DM, G, bx);
            pg8::EpiRes<false> E{nullptr, XB, RSS + (size_t)(3 * l + 2) * T * 16};
            pg8::gemm_phase<pg8::EpiRes<false>, pg8::StaticOrder, true, true>(ldsl, g, S, E);
        }
        GRID_BAR();
        for (int rep_ = 0; rep_ < REP_UP; ++rep_) {
            pg8::Gemm g{XB, (const bf16*)(wl + WO_1), T, DFF, DM}; pg8::StaticOrder S; S.init(T, DFF, G, bx);
            pg8::EpiScale<3> E{Hb, DFF, RSS + (size_t)(3 * l + 2) * T * 16, 1.f, nullptr};
            pg8::gemm_phase<pg8::EpiScale<3>, pg8::StaticOrder, true, true>(ldsl, g, S, E);
        }
        GRID_BAR();
        {
            pg8::Gemm g{Hb, (const bf16*)(wl + WO_2), T, DM, DFF}; pg8::StaticOrder S; S.init(T, DM, G, bx);
            pg8::EpiRes<false> E{nullptr, XB, RSS + (size_t)(3 * l + 3) * T * 16};
            pg8::gemm_phase<pg8::EpiRes<false>, pg8::StaticOrder, true, true>(ldsl, g, S, E);
        }
        GRID_BAR();
    }
    for (int rep_ = 0; rep_ < REP_SYNC; ++rep_) GRID_BAR();
    {
        const int gw = vcu * NWAVES + wave, NGW = G * NWAVES; const float* rss = RSS + (size_t)6 * T * 16; const f32x4* gr = (const f32x4*)IN_F(28) + lane;
        f32x4 gv[4];
#pragma unroll
        for (int j = 0; j < 4; ++j) gv[j] = gr[64 * j];
        for (int m0 = gw * 4; m0 < T; m0 += NGW * 4) { unsigned long long q[4][4]; float ssv[4];
#pragma unroll
            for (int r = 0; r < 4; ++r) { const unsigned long long* xr = (const unsigned long long*)(XB + (size_t)(m0 + r) * DM) + lane; ssv[r] = lane < 16 ? rss[(size_t)(m0 + r) * 16 + lane] : 0.f;
#pragma unroll
                for (int j = 0; j < 4; ++j) q[r][j] = xr[64 * j]; }
#pragma unroll
            for (int r = 0; r < 4; ++r) { const float rs = rsqrtf(wave_sum(ssv[r]) * (1.f / DM) + 1e-6f); f32x4* orow = (f32x4*)(XF + (size_t)(m0 + r) * DM) + lane;
#pragma unroll
                for (int j = 0; j < 4; ++j) { const unsigned lo = (unsigned)q[r][j], hi2 = (unsigned)(q[r][j] >> 32);
                    const f32x4 v = {__uint_as_float(lo << 16), __uint_as_float(lo & 0xffff0000u), __uint_as_float(hi2 << 16), __uint_as_float(hi2 & 0xffff0000u)};
                    orow[64 * j] = v * rs * gv[j]; } } }
    }
}

extern "C" void kernel_launch(void* const* d_in, const int* in_sizes, int n_in, void* d_out, int out_size, void* d_ws, size_t ws_size, hipStream_t stream) {
    static int grid = 0;
    if (grid == 0) {
        if (n_in != 29 || in_sizes[0] != T * DM || out_size != T * DM || ws_size < WS_END) { fprintf(stderr, "kernel_launch: unexpected shapes (n_in %d, in0 %d, out %d, ws %zu, need %zu)\n", n_in, n_in > 0 ? in_sizes[0] : -1, out_size, ws_size, (size_t)WS_END); grid = -1; return; }
        int dev = 0, cus = 0, per_cu = 0;
        if (hipGetDevice(&dev) != hipSuccess || hipDeviceGetAttribute(&cus, hipDeviceAttributeMultiprocessorCount, dev) != hipSuccess) { fprintf(stderr, "kernel_launch: device query failed\n"); grid = -1; return; }
        if (hipFuncSetAttribute((const void*)mega_fwd, hipFuncAttributeMaxDynamicSharedMemorySize, LDS_BYTES) != hipSuccess) { fprintf(stderr, "kernel_launch: hipFuncSetAttribute failed\n"); grid = -1; return; }
        if (hipOccupancyMaxActiveBlocksPerMultiprocessor(&per_cu, (const void*)mega_fwd, NTHR, LDS_BYTES) != hipSuccess || per_cu < 1) { fprintf(stderr, "kernel_launch: occupancy query says %d blocks per CU\n", per_cu); (void)hipGetLastError(); per_cu = 1; }
        grid = cus;
    }
    if (grid < 0) return;
    Args a{};
    for (int i = 0; i < 29; ++i) a.in[i] = d_in[i];
    a.out = (float*)d_out; a.ws = (unsigned char*)d_ws;
    void* kargs[] = {&a};
    const hipError_t e = hipLaunchCooperativeKernel((const void*)mega_fwd, dim3(grid), dim3(NTHR), kargs, LDS_BYTES, stream);
    if (e != hipSuccess) fprintf(stderr, "kernel_launch: cooperative launch failed: %s (grid %d)\n", hipGetErrorString(e), grid);
}
```

```cpp
#include <hip/hip_runtime.h>
#include <hip/hip_cooperative_groups.h>
#include <cstdio>
#include <cstdint>
namespace cg = cooperative_groups;
#ifndef REP_FA
#define REP_FA 1
#endif
#ifndef REP_LRUA
#define REP_LRUA 1
#endif
#ifndef REP_LRUC
#define REP_LRUC 1
#endif
#ifndef REP_PRO
#define REP_PRO 1
#endif
#ifndef REP_Q
#define REP_Q 1
#endif
#ifndef REP_SYNC
#define REP_SYNC 0
#endif
#ifndef REP_XA
#define REP_XA 1
#endif
#ifndef REP_UP
#define REP_UP 1
#endif
#ifndef REP_IN
#define REP_IN 1
#endif
__device__ __forceinline__ int opaque_tid() { int t = threadIdx.x; asm volatile("" : "+v"(t)); return t; }
namespace pg8 {
#define PG8_LAS __attribute__((address_space(3)))
typedef unsigned short bf16_t;
typedef short bf16x8 __attribute__((ext_vector_type(8)));
typedef float f32x4 __attribute__((ext_vector_type(4)));
typedef unsigned u32x4 __attribute__((ext_vector_type(4)));
constexpr int BM = 256, BK = 64, HALF = 128, HTB = HALF * BK * 2  , STAGE_BYTES = 8 * HTB, NXCD = 8, WGM = 8;

__host__ __device__ __forceinline__ int lds_byte(int r, int c) { const int st = (r >> 4) * 2 + (c >> 5), rr = r & 15, cc = c & 31, ob = rr * 64 + cc * 2; return st * 1024 + (ob ^ (((ob >> 9) & 1) << 5)); }
__host__ __device__ __forceinline__ void stage_rc(int b, int& R, int& C) { const int st = b / 1024, sb = b % 1024, swz = sb ^ (((sb >> 9) & 1) << 5); R = (st >> 1) * 16 + swz / 64; C = (st & 1) * 32 + (swz % 64) / 2; }
__host__ __device__ __forceinline__ int perm32(int rho) { const int n = rho >> 4, i = rho & 15; return 8 * (i >> 2) + 4 * n + (i & 3); }

struct Unit { int pm, pn; };
struct Gemm { const bf16_t* A; const bf16_t* Bt; int M, N, K; };

struct StaticOrder {
    int nM, nN, nwg, G, c;
    __host__ __device__ void init(int M, int N, int G_, int c_) { nM = M / BM; nN = N / BM; nwg = nM * nN; G = G_; c = c_; }
    __host__ __device__ bool next(int i, Unit& u) const {
        const long L = (long)i * G + c; if (L >= nwg) return false;
        int wgid = (int)L; { const int q = nwg / NXCD, r = nwg % NXCD, xcd = wgid % NXCD, off = wgid / NXCD; wgid = (xcd < r ? xcd * (q + 1) : r * (q + 1) + (xcd - r) * q) + off; }
        const int nig = WGM * nN, gid = wgid / nig, fm = gid * WGM, gsz = (nM - fm) < WGM ? (nM - fm) : WGM;
        u.pm = fm + ((wgid % nig) % gsz); u.pn = (wgid % nig) / gsz; return true;
    }
    __device__ __forceinline__ void a_ready(const Unit&) const {}
    __device__ __forceinline__ void done(const Unit&) const {}
};

__device__ __forceinline__ unsigned cvt_pk_bf16(float lo, float hi) { unsigned r; asm volatile("v_cvt_pk_bf16_f32 %0, %1, %2" : "=v"(r) : "v"(lo), "v"(hi)); return r; }
template <class Epi, class Sched, bool ALIGN_EPI = false, bool SP2 = false>
__device__ __forceinline__ void gemm_phase(PG8_LAS unsigned char* lds, const Gemm g, const Sched& S, const Epi& E) {
    const int tid = opaque_tid(), wid = __builtin_amdgcn_readfirstlane(tid >> 6), lane = tid & 63, wr = wid >> 2, wc = wid & 3, fr = lane & 15, fq = lane >> 4;
    const int K = g.K, nt = K / BK;
    unsigned voffA[2], voffB[2];
#pragma unroll
    for (int i = 0; i < 2; ++i) { int R, C; stage_rc(tid * 16 + i * 8192, R, C); const int Rb = Epi::PERM ? ((R & ~31) + perm32(R & 31)) : R;
        voffA[i] = (unsigned)(R * K + C) * 2u; voffB[i] = (unsigned)(Rb * K + C) * 2u; }
    const size_t kstep = (size_t)(BK * 2);
    const size_t hstep = (size_t)HALF * K * 2;
    const size_t tstep = 2 * hstep;
    const unsigned ldsw = (unsigned)wid * 1024u;
    const int aoff = lds_byte(wr * 64 + fr, fq * 8), boff = lds_byte(wc * 32 + fr, fq * 8);
#define PG8_SA(b, h) (((b) * 2 + (h)) * HTB)
#define PG8_SB(b, h) ((4 + (b) * 2 + (h)) * HTB)
#define PG8_STAGE(bufoff, gbase, voff) do { _Pragma("unroll") for (int _i = 0; _i < 2; ++_i) \
        __builtin_amdgcn_global_load_lds((const unsigned*)((const char*)(gbase) + (voff)[_i]), (PG8_LAS unsigned*)(lds + (bufoff) + ldsw + _i * 8192), 16, 0, 0); } while (0)
#define PG8_LDA(dst, b, h) do { _Pragma("unroll") for (int m = 0; m < 4; ++m) _Pragma("unroll") for (int k = 0; k < 2; ++k) dst[m][k] = *(const PG8_LAS bf16x8*)(lds + PG8_SA(b, h) + aoff + m * 2048 + k * 1024); } while (0)
#define PG8_LDB(dst, b, h) do { _Pragma("unroll") for (int n = 0; n < 2; ++n) _Pragma("unroll") for (int k = 0; k < 2; ++k) dst[n][k] = *(const PG8_LAS bf16x8*)(lds + PG8_SB(b, h) + boff + n * 2048 + k * 1024); } while (0)
#define PG8_MMA(ai, bj, At, Bt) do { __builtin_amdgcn_s_setprio(1); _Pragma("unroll") for (int m = 0; m < 4; ++m) _Pragma("unroll") for (int n = 0; n < 2; ++n) _Pragma("unroll") for (int k = 0; k < 2; ++k) \
        acc[ai][bj][m][n] = __builtin_amdgcn_mfma_f32_16x16x32_bf16(Bt[n][k], At[m][k], acc[ai][bj][m][n], 0, 0, 0); __builtin_amdgcn_s_setprio(0); } while (0)
#define PG8_WAIT_V(n) asm volatile("s_waitcnt vmcnt(" #n ")" ::: "memory")
#define PG8_WAIT_L(n) asm volatile("s_waitcnt lgkmcnt(" #n ")" ::: "memory")
#define PG8_BAR __builtin_amdgcn_s_barrier()
#define PG8_SCHED __builtin_amdgcn_sched_barrier(0)
    Unit cur, nxt; int ui = 0;
    if (!S.next(0, cur)) return;
    f32x4 acc[2][2][4][2];
#pragma unroll
    for (int a = 0; a < 2; ++a)
#pragma unroll
        for (int b = 0; b < 2; ++b)
#pragma unroll
            for (int m = 0; m < 4; ++m)
#pragma unroll
                for (int n = 0; n < 2; ++n) acc[a][b][m][n] = (f32x4){0.f, 0.f, 0.f, 0.f};
    bf16x8 At[4][2], B0[2][2], B1[2][2];
    const char* cA = (const char*)g.A + (size_t)cur.pm * tstep; const char* cB = (const char*)g.Bt + (size_t)cur.pn * tstep;
    S.a_ready(cur);
    if constexpr (SP2) {
        PG8_STAGE(PG8_SB(0, 0), cB, voffB); PG8_STAGE(PG8_SB(0, 1), cB + hstep, voffB); PG8_STAGE(PG8_SA(0, 0), cA, voffA); PG8_STAGE(PG8_SA(0, 1), cA + hstep, voffA);
        if (wr == 1) PG8_BAR;
        PG8_WAIT_V(2); PG8_BAR;
        PG8_STAGE(PG8_SB(1, 0), cB + kstep, voffB); PG8_STAGE(PG8_SA(1, 0), cA + kstep, voffA); PG8_STAGE(PG8_SB(1, 1), cB + hstep + kstep, voffB);
        PG8_WAIT_V(6); PG8_BAR;
    } else {
        PG8_STAGE(PG8_SB(0, 0), cB, voffB); PG8_STAGE(PG8_SA(0, 0), cA, voffA); PG8_STAGE(PG8_SB(0, 1), cB + hstep, voffB); PG8_STAGE(PG8_SA(0, 1), cA + hstep, voffA);
        if (wr == 1) PG8_BAR;
        PG8_WAIT_V(4); PG8_BAR;
        PG8_STAGE(PG8_SB(1, 0), cB + kstep, voffB); PG8_STAGE(PG8_SA(1, 0), cA + kstep, voffA); PG8_STAGE(PG8_SB(1, 1), cB + hstep + kstep, voffB);
        PG8_WAIT_V(6); PG8_BAR;
    }
    for (;;) {
        const bool has_next = S.next(ui + 1, nxt);
        const char* nA = has_next ? (const char*)g.A + (size_t)nxt.pm * tstep : cA; const char* nB = has_next ? (const char*)g.Bt + (size_t)nxt.pn * tstep : cB;
        for (int t = 0; t < nt; t += 2) {
            const bool last = (t == nt - 2);
            const char* a1 = cA + (size_t)(t + 1) * kstep;
            const char* a2 = last ? nA : cA + (size_t)(t + 2) * kstep; const char* b2 = last ? nB : cB + (size_t)(t + 2) * kstep;
            const char* a3 = a2 + kstep; const char* b3 = b2 + kstep;
            if (last && has_next) S.a_ready(nxt);
            if constexpr (SP2) {
            PG8_LDB(B0, 0, 0); PG8_LDB(B1, 0, 1); PG8_SCHED; PG8_LDA(At, 0, 0); PG8_STAGE(PG8_SA(1, 1), a1 + hstep, voffA);
            PG8_WAIT_V(8); PG8_WAIT_L(0); PG8_BAR; PG8_MMA(0, 0, At, B0); PG8_MMA(0, 1, At, B1); PG8_BAR; PG8_SCHED;
            PG8_LDA(At, 0, 1); PG8_STAGE(PG8_SB(0, 0), b2, voffB); PG8_STAGE(PG8_SB(0, 1), b2 + hstep, voffB); PG8_STAGE(PG8_SA(0, 0), a2, voffA);
            PG8_WAIT_V(8); PG8_WAIT_L(0); PG8_BAR; PG8_MMA(1, 0, At, B0); PG8_MMA(1, 1, At, B1); PG8_BAR; PG8_SCHED;
            PG8_LDB(B0, 1, 0); PG8_LDB(B1, 1, 1); PG8_SCHED; PG8_LDA(At, 1, 0); PG8_STAGE(PG8_SA(0, 1), a2 + hstep, voffA);
            PG8_WAIT_V(8); PG8_WAIT_L(0); PG8_BAR; PG8_MMA(0, 0, At, B0); PG8_MMA(0, 1, At, B1); PG8_BAR; PG8_SCHED;
            PG8_LDA(At, 1, 1); PG8_STAGE(PG8_SB(1, 0), b3, voffB); PG8_STAGE(PG8_SB(1, 1), b3 + hstep, voffB); PG8_STAGE(PG8_SA(1, 0), a3, voffA);
            PG8_WAIT_V(8); PG8_WAIT_L(0); PG8_BAR; PG8_MMA(1, 0, At, B0); PG8_MMA(1, 1, At, B1); PG8_BAR; PG8_SCHED;
            } else {
            PG8_LDB(B0, 0, 0); PG8_SCHED; PG8_LDA(At, 0, 0); PG8_STAGE(PG8_SA(1, 1), a1 + hstep, voffA);
            PG8_WAIT_L(8); PG8_BAR; PG8_WAIT_L(0); PG8_MMA(0, 0, At, B0); PG8_BAR; PG8_SCHED;
            PG8_LDB(B1, 0, 1); PG8_STAGE(PG8_SB(0, 0), b2, voffB);
            PG8_BAR; PG8_WAIT_L(0); PG8_MMA(0, 1, At, B1); PG8_BAR;
            PG8_LDA(At, 0, 1); PG8_STAGE(PG8_SA(0, 0), a2, voffA);
            PG8_BAR; PG8_WAIT_L(0); PG8_MMA(1, 0, At, B0); PG8_BAR; PG8_SCHED;
            PG8_STAGE(PG8_SB(0, 1), b2 + hstep, voffB);
            PG8_WAIT_V(6); PG8_BAR; PG8_MMA(1, 1, At, B1); PG8_BAR;
            PG8_LDB(B0, 1, 0); PG8_SCHED; PG8_LDA(At, 1, 0); PG8_STAGE(PG8_SA(0, 1), a2 + hstep, voffA);
            PG8_WAIT_L(8); PG8_BAR; PG8_WAIT_L(0); PG8_MMA(0, 0, At, B0); PG8_BAR; PG8_SCHED;
            PG8_LDB(B1, 1, 1); PG8_STAGE(PG8_SB(1, 0), b3, voffB);
            PG8_BAR; PG8_WAIT_L(0); PG8_MMA(0, 1, At, B1); PG8_BAR;
            PG8_LDA(At, 1, 1); PG8_STAGE(PG8_SA(1, 0), a3, voffA);
            PG8_BAR; PG8_WAIT_L(0); PG8_MMA(1, 0, At, B0); PG8_BAR; PG8_SCHED;
            PG8_STAGE(PG8_SB(1, 1), b3 + hstep, voffB);
            PG8_WAIT_V(6); PG8_BAR; PG8_MMA(1, 1, At, B1); PG8_BAR;
            }
        }
        if constexpr (ALIGN_EPI) { if (wr == 0) PG8_BAR; }
        if constexpr (!Epi::AFTER_DRAIN) { E(acc, cur, wr, wc, fr, fq); S.done(cur); }
        if (!has_next) break;
#pragma unroll
        for (int a = 0; a < 2; ++a)
#pragma unroll
            for (int b = 0; b < 2; ++b)
#pragma unroll
                for (int m = 0; m < 4; ++m)
#pragma unroll
                    for (int n = 0; n < 2; ++n) acc[a][b][m][n] = (f32x4){0.f, 0.f, 0.f, 0.f};
        cur = nxt; cA = nA; cB = nB; ++ui;
        if constexpr (ALIGN_EPI) { if (wr == 1) PG8_BAR; }
    }
    PG8_WAIT_V(0);
    if constexpr (!ALIGN_EPI) { if (wr == 0) PG8_BAR; }
    PG8_BAR;
    if constexpr (Epi::AFTER_DRAIN) { E.fused(acc, cur, wr, wc, fr, fq, lds, wid, lane); S.done(cur); }
#undef PG8_SA
#undef PG8_SB
#undef PG8_STAGE
#undef PG8_LDA
#undef PG8_LDB
#undef PG8_MMA
#undef PG8_WAIT_V
#undef PG8_WAIT_L
#undef PG8_BAR
#undef PG8_SCHED
}
}
namespace pg8 {
typedef unsigned u32x4e __attribute__((ext_vector_type(4)));
template <int MODE> struct EpiScale {
    static constexpr bool PERM = true, AFTER_DRAIN = false;
    bf16_t* O; int ldc; const float* rss; float cs; const float* rope;
    __device__ __forceinline__ void operator()(const f32x4 (&acc)[2][2][4][2], const Unit& u, int wr, int wc, int fr, int fq) const {
        const int row0 = u.pm * BM + wr * 64 + fr, col0 = u.pn * BM + wc * 32 + 8 * fq;
        const bool ropew = (MODE == 1) && (u.pn < 4) && ((wc & 1) == 0);
#pragma unroll
        for (int ai = 0; ai < 2; ++ai)
#pragma unroll
            for (int m = 0; m < 4; ++m) {
                const int row = row0 + ai * HALF + m * 16;
                float rs = 1.f;
                if (MODE != 0) { const f32x4 q0 = *((const f32x4*)(rss + (size_t)row * 16) + fq);
                    float sq = (q0[0] + q0[1]) + (q0[2] + q0[3]); sq += __shfl_xor(sq, 16); sq += __shfl_xor(sq, 32);
                    rs = rsqrtf(sq * (1.f / 1024.f) + 1e-6f); }
                if (MODE == 2) rs *= cs;
                f32x4 cv0 = {1.f, 1.f, 1.f, 1.f}, cv1 = cv0, sv0 = {0.f, 0.f, 0.f, 0.f}, sv1 = sv0;
                if (ropew) { const float* rp = rope + (size_t)row * 16; cv0 = *(const f32x4*)rp; cv1 = *(const f32x4*)(rp + 4); sv0 = *(const f32x4*)(rp + 8); sv1 = *(const f32x4*)(rp + 12); }
#pragma unroll
                for (int bj = 0; bj < 2; ++bj) {
                    f32x4 v0 = acc[ai][bj][m][0] * rs, v1 = acc[ai][bj][m][1] * rs;
                    if (MODE == 1) {
                        if (ropew) {
                            f32x4 o0, o1;
#pragma unroll
                            for (int j = 0; j < 4; ++j) { o0[j] = __shfl_xor(v0[j], 16); o1[j] = __shfl_xor(v1[j], 16); }
                            if (fq == 0) { v0 = v0 * cv0 - o0 * sv0; v1 = v1 * cv1 - o1 * sv1; }
                            else if (fq == 1) { v0 = v0 * cv0 + o0 * sv0; v1 = v1 * cv1 + o1 * sv1; }
                        }
                        if (u.pn < 2) { v0 = v0 * cs; v1 = v1 * cs; }
                    }
                    if (MODE == 3) {
#pragma unroll
                        for (int j = 0; j < 4; ++j) { const float a = fmaxf(v0[j], 0.f), b = fmaxf(v1[j], 0.f); v0[j] = a * a; v1[j] = b * b; }
                    }
                    u32x4e w; w.x = cvt_pk_bf16(v0[0], v0[1]); w.y = cvt_pk_bf16(v0[2], v0[3]); w.z = cvt_pk_bf16(v1[0], v1[1]); w.w = cvt_pk_bf16(v1[2], v1[3]);
                    *(u32x4e*)(O + (size_t)row * ldc + col0 + bj * HALF) = w;
                }
            }
    }
};
template <bool F32BASE> struct EpiRes {
    static constexpr bool PERM = true, AFTER_DRAIN = false;
    const float* basef; bf16_t* xb; float* rss;
    __device__ __forceinline__ void operator()(const f32x4 (&acc)[2][2][4][2], const Unit& u, int wr, int wc, int fr, int fq) const {
        const int row0 = u.pm * BM + wr * 64 + fr, col0 = u.pn * BM + wc * 32 + 8 * fq;
#pragma unroll
        for (int ai = 0; ai < 2; ++ai)
#pragma unroll
            for (int m = 0; m < 4; ++m) {
                const int row = row0 + ai * HALF + m * 16; float ss = 0.f;
#pragma unroll
                for (int bj = 0; bj < 2; ++bj) {
                    const size_t off = (size_t)row * 1024 + col0 + bj * HALF;
                    f32x4 b0, b1;
                    if (F32BASE) { b0 = *(const f32x4*)(basef + off); b1 = *(const f32x4*)(basef + off + 4); }
                    else { const u32x4e q = *(const u32x4e*)(xb + off);
                        b0 = (f32x4){__uint_as_float(q.x << 16), __uint_as_float(q.x & 0xffff0000u), __uint_as_float(q.y << 16), __uint_as_float(q.y & 0xffff0000u)};
                        b1 = (f32x4){__uint_as_float(q.z << 16), __uint_as_float(q.z & 0xffff0000u), __uint_as_float(q.w << 16), __uint_as_float(q.w & 0xffff0000u)}; }
                    const f32x4 v0 = acc[ai][bj][m][0] + b0, v1 = acc[ai][bj][m][1] + b1;
                    u32x4e w; w.x = cvt_pk_bf16(v0[0], v0[1]); w.y = cvt_pk_bf16(v0[2], v0[3]); w.z = cvt_pk_bf16(v1[0], v1[1]); w.w = cvt_pk_bf16(v1[2], v1[3]);
                    *(u32x4e*)(xb + off) = w;
                    ss += (v0[0] * v0[0] + v0[1] * v0[1]) + (v0[2] * v0[2] + v0[3] * v0[3]) + (v1[0] * v1[0] + v1[1] * v1[1]) + (v1[2] * v1[2] + v1[3] * v1[3]);
                }
                ss += __shfl_xor(ss, 16); ss += __shfl_xor(ss, 32);
                if (fq == 0) rss[(size_t)row * 16 + u.pn * 4 + wc] = ss;
            }
    }
};
}
namespace fa {
typedef unsigned short bf16_t;
using bf16x8 = __attribute__((ext_vector_type(8))) short;
using s16x4  = __attribute__((ext_vector_type(4))) short;
using f32x16 = __attribute__((ext_vector_type(16))) float;
using u32x4  = __attribute__((ext_vector_type(4))) unsigned;
#define FA_SBAR() __builtin_amdgcn_sched_barrier(0)
__device__ __forceinline__ int crow(int r, int hi) { return (r & 3) + 8 * (r >> 2) + 4 * hi; }
__device__ __forceinline__ unsigned cvtpk(float lo, float hi) { unsigned r; asm volatile("v_cvt_pk_bf16_f32 %0, %1, %2" : "=v"(r) : "v"(lo), "v"(hi)); return r; }
__device__ __forceinline__ int v_st(int k, int c) { const int kk = (k & ~0xC) | ((k & 4) << 1) | ((k & 8) >> 1); return ((kk >> 3) * 4 + (c >> 5)) * 512 + ((kk & 7) * 32 + (c & 31)) * 2; }
__device__ __forceinline__ int v_rd_base(int lane) { return ((lane & 3) << 3) | (((lane >> 2) & 3) << 6) | (((lane >> 4) & 1) << 5) | (((lane >> 5) & 1) << 8); }
constexpr int v_rd_off(int d0, int ks, int half) { return d0 * 512 + ks * 4096 + half * 2048; }
template <int OFF> __device__ __forceinline__ s16x4 tr_read(int vb) { s16x4 r; asm volatile("ds_read_b64_tr_b16 %0, %1 offset:%2" : "=&v"(r) : "v"(vb), "i"(OFF) : "memory"); return r; }
template <int D0> __device__ __forceinline__ void pv_one(f32x16& od, int vb, bf16x8 pa0, bf16x8 pa1, bf16x8 pa2, bf16x8 pa3) {
  const s16x4 l0 = tr_read<v_rd_off(D0, 0, 0)>(vb), h0 = tr_read<v_rd_off(D0, 0, 1)>(vb), l1 = tr_read<v_rd_off(D0, 1, 0)>(vb), h1 = tr_read<v_rd_off(D0, 1, 1)>(vb);
  const s16x4 l2 = tr_read<v_rd_off(D0, 2, 0)>(vb), h2 = tr_read<v_rd_off(D0, 2, 1)>(vb), l3 = tr_read<v_rd_off(D0, 3, 0)>(vb), h3 = tr_read<v_rd_off(D0, 3, 1)>(vb);
  asm volatile("s_waitcnt lgkmcnt(0)" ::: "memory"); FA_SBAR();
#define FA_PK(L, H) (bf16x8){L[0], L[1], L[2], L[3], H[0], H[1], H[2], H[3]}
  od = __builtin_amdgcn_mfma_f32_32x32x16_bf16(pa0, FA_PK(l0, h0), od, 0, 0, 0);
  od = __builtin_amdgcn_mfma_f32_32x32x16_bf16(pa1, FA_PK(l1, h1), od, 0, 0, 0);
  od = __builtin_amdgcn_mfma_f32_32x32x16_bf16(pa2, FA_PK(l2, h2), od, 0, 0, 0);
  od = __builtin_amdgcn_mfma_f32_32x32x16_bf16(pa3, FA_PK(l3, h3), od, 0, 0, 0);
#undef FA_PK
}
__device__ __forceinline__ void pv_d0(f32x16* o, int vb, bf16x8 pa0, bf16x8 pa1, bf16x8 pa2, bf16x8 pa3) {
  pv_one<0>(o[0], vb, pa0, pa1, pa2, pa3); pv_one<1>(o[1], vb, pa0, pa1, pa2, pa3); pv_one<2>(o[2], vb, pa0, pa1, pa2, pa3); pv_one<3>(o[3], vb, pa0, pa1, pa2, pa3);
}
template <int DQK, bool QREG> __device__ __forceinline__ void qkt(f32x16& p0, f32x16& p1, const char* Ks, const bf16x8* qr, const bf16_t* qsrc, int r32, int hi) {
  constexpr int KROWB = DQK * 2;
  p0 = f32x16{}; p1 = f32x16{};
  if constexpr (QREG) {
#pragma unroll
    for (int d0 = 0; d0 < DQK / 16; ++d0) { const int cb = (d0 * 16 + hi * 8) * 2;
      const int sw = (DQK == 64) ? (((r32 >> 1) & 7) << 4) : ((r32 & 7) << 4);
      const bf16x8 b0 = *reinterpret_cast<const bf16x8*>(Ks + r32 * KROWB + (cb ^ sw));
      const bf16x8 b1 = *reinterpret_cast<const bf16x8*>(Ks + (32 + r32) * KROWB + (cb ^ sw));
      p0 = __builtin_amdgcn_mfma_f32_32x32x16_bf16(b0, qr[d0], p0, 0, 0, 0);
      p1 = __builtin_amdgcn_mfma_f32_32x32x16_bf16(b1, qr[d0], p1, 0, 0, 0); }
  } else {
    typedef __attribute__((address_space(1))) const bf16x8 gq_t;
#pragma unroll
    for (int g = 0; g < DQK / 128; ++g) { bf16x8 qv[8];
#pragma unroll
      for (int i = 0; i < 8; ++i) qv[i] = *(gq_t*)(qsrc + (g * 8 + i) * 16);
#pragma unroll
      for (int i = 0; i < 8; ++i) { const int d0 = g * 8 + i, cb = (d0 * 16 + hi * 8) * 2;
        const bf16x8 b0 = *reinterpret_cast<const bf16x8*>(Ks + r32 * KROWB + (cb ^ ((r32 & 7) << 4)));
        const bf16x8 b1 = *reinterpret_cast<const bf16x8*>(Ks + (32 + r32) * KROWB + (cb ^ ((r32 & 7) << 4)));
        p0 = __builtin_amdgcn_mfma_f32_32x32x16_bf16(b0, qv[i], p0, 0, 0, 0);
        p1 = __builtin_amdgcn_mfma_f32_32x32x16_bf16(b1, qv[i], p1, 0, 0, 0); } }
  }
}
__device__ __forceinline__ void softmax_tile(f32x16& p0, f32x16& p1, float& m_reg, float& l_reg, float& alpha, bf16x8& pa0, bf16x8& pa1, bf16x8& pa2, bf16x8& pa3) {
  float pmax = p0[0];
#pragma unroll
  for (int r = 1; r < 16; ++r) pmax = fmaxf(pmax, p0[r]);
#pragma unroll
  for (int r = 0; r < 16; ++r) pmax = fmaxf(pmax, p1[r]);
  { auto rr = __builtin_amdgcn_permlane32_swap(__float_as_uint(pmax), __float_as_uint(pmax), false, false); pmax = fmaxf(__uint_as_float(rr[0]), __uint_as_float(rr[1])); }
  if (__builtin_expect(__all(pmax - m_reg <= 8.f), 1)) { alpha = 1.f; }
  else { const float mn = fmaxf(m_reg, pmax); alpha = __builtin_amdgcn_exp2f(m_reg - mn); m_reg = mn; }
  const float mneg = -m_reg;
#pragma unroll
  for (int r = 0; r < 16; ++r) { p0[r] = __builtin_amdgcn_exp2f(p0[r] + mneg); p1[r] = __builtin_amdgcn_exp2f(p1[r] + mneg); }
  float ps = 0.f;
#pragma unroll
  for (int r = 0; r < 16; ++r) ps += p0[r];
#pragma unroll
  for (int r = 0; r < 16; ++r) ps += p1[r];
  { auto rr = __builtin_amdgcn_permlane32_swap(__float_as_uint(ps), __float_as_uint(ps), false, false); ps = __uint_as_float(rr[0]) + __uint_as_float(rr[1]); }
  l_reg = l_reg * alpha + ps;
#define FA_PK4(P, BASE, OUT) do { unsigned a0 = cvtpk(P[BASE + 0], P[BASE + 1]), a1 = cvtpk(P[BASE + 2], P[BASE + 3]);   \
    unsigned b0 = cvtpk(P[BASE + 4], P[BASE + 5]), b1 = cvtpk(P[BASE + 6], P[BASE + 7]);                              \
    auto r0 = __builtin_amdgcn_permlane32_swap(a0, b0, false, false); auto r1 = __builtin_amdgcn_permlane32_swap(a1, b1, false, false); \
    u32x4 w = {r0[0], r1[0], r0[1], r1[1]}; OUT = *reinterpret_cast<bf16x8*>(&w); } while (0)
  FA_PK4(p0, 0, pa0); FA_PK4(p0, 8, pa1); FA_PK4(p1, 0, pa2); FA_PK4(p1, 8, pa3);
#undef FA_PK4
}
template <int DQK>
__device__ __forceinline__ void flash_unit(const bf16_t* __restrict__ Qb, int ldq, const bf16_t* __restrict__ Kh, int ldk,
                                           const bf16_t* __restrict__ Vh, int ldv, bf16_t* __restrict__ Ob, int ldo, int nkeys, char* lds) {
  constexpr int KROWB = DQK * 2, SHM_K = 64 * KROWB, SHM_V = 16384, ND = DQK / 16, NKL = DQK / 64, CPR = DQK / 8;
  const int tid = opaque_tid(), wid = tid >> 6, lane = tid & 63, r32 = lane & 31, hi = lane >> 5;
  char* V_lds = lds; char* K_lds = lds + 2 * SHM_V;
  float* ws = (float*)(lds + 2 * SHM_V + 2 * SHM_K) + wid * 64; float* li_l = ws; float* al_l = ws + 32;
  constexpr bool QREG = (DQK <= 64);
  float m_reg = -1e30f, l_reg = 0.f; f32x16 o[4] = {}; bf16x8 qr[QREG ? ND : 1];
  const bf16_t* Qw = Qb + (long)(wid * 32 + r32) * ldq + hi * 8;
#pragma unroll
  for (int d0 = 0; d0 < (QREG ? ND : 1); ++d0) qr[d0] = *reinterpret_cast<const bf16x8*>(Qw + d0 * 16);
  const int vr = tid >> 4, vc = (tid & 15) * 8, vst0 = v_st(vr, vc), vst1 = v_st(32 + vr, vc);
  const int vb0 = (int)(uintptr_t)V_lds + v_rd_base(lane);
  bf16x8 vs0, vs1, ksg[NKL];
#define FA_SLOAD(k0) do { vs0 = *reinterpret_cast<const bf16x8*>(Vh + (long)((k0) + vr) * ldv + vc); vs1 = *reinterpret_cast<const bf16x8*>(Vh + (long)((k0) + 32 + vr) * ldv + vc); \
    _Pragma("unroll") for (int i_ = 0; i_ < NKL; ++i_) { const int q_ = tid + 512 * i_, row_ = q_ / CPR, ch_ = q_ % CPR; ksg[i_] = *reinterpret_cast<const bf16x8*>(Kh + (long)((k0) + row_) * ldk + ch_ * 8); } } while (0)
#define FA_SWRITE(b) do { *(bf16x8*)(V_lds + (b) * SHM_V + vst0) = vs0; *(bf16x8*)(V_lds + (b) * SHM_V + vst1) = vs1; \
    _Pragma("unroll") for (int i_ = 0; i_ < NKL; ++i_) { const int q_ = tid + 512 * i_, row_ = q_ / CPR, ch_ = q_ % CPR; \
      *(bf16x8*)(K_lds + (b) * SHM_K + row_ * KROWB + ((ch_ * 16) ^ ((DQK == 64 ? ((row_ >> 1) & 7) : (row_ & 7)) << 4))) = ksg[i_]; } } while (0)
#define FA_RESC(a) do { if (__any((a) < 1.f)) { if (hi == 0) al_l[r32] = (a); asm volatile("s_waitcnt lgkmcnt(0)" ::: "memory"); \
    _Pragma("unroll") for (int d_ = 0; d_ < 4; ++d_) _Pragma("unroll") for (int r_ = 0; r_ < 16; ++r_) o[d_][r_] *= al_l[crow(r_, hi)]; } } while (0)
#define FA_TILE(b) do { f32x16 p0, p1; float alpha; bf16x8 pa0, pa1, pa2, pa3; \
    const bf16_t* qs_ = Qw; asm volatile("" : "+v"(qs_)); qkt<DQK, QREG>(p0, p1, K_lds + (b) * SHM_K, qr, qs_, r32, hi); softmax_tile(p0, p1, m_reg, l_reg, alpha, pa0, pa1, pa2, pa3); FA_RESC(alpha); \
    pv_d0(o, vb0 + (b) * SHM_V, pa0, pa1, pa2, pa3); } while (0)
  const int NT = nkeys / 64;
  FA_SLOAD(0); FA_SWRITE(0); __syncthreads();
  for (int j = 0; j < NT; j += 2) {
    FA_SLOAD((j + 1) * 64);
    FA_TILE(0);
    FA_SWRITE(1); __syncthreads();
    if (j + 2 < NT) FA_SLOAD((j + 2) * 64);
    FA_TILE(1);
    if (j + 2 < NT) FA_SWRITE(0);
    __syncthreads();
  }
  if (hi == 0) li_l[r32] = l_reg; asm volatile("s_waitcnt lgkmcnt(0)" ::: "memory");
  float rli[16];
#pragma unroll
  for (int r = 0; r < 16; ++r) rli[r] = __builtin_amdgcn_rcpf(li_l[crow(r, hi)]);
  bf16_t* Ow = Ob + (long)(wid * 32) * ldo;
#pragma unroll
  for (int r = 0; r < 16; ++r) { const int orow = crow(r, hi);
#pragma unroll
    for (int d0 = 0; d0 < 4; ++d0) { const float v = o[d0][r] * rli[r]; Ow[(long)orow * ldo + d0 * 32 + r32] = (bf16_t)(cvtpk(v, v) & 0xffffu); } }
  __syncthreads();
#undef FA_SLOAD
#undef FA_SWRITE
#undef FA_RESC
#undef FA_TILE
}

__device__ __forceinline__ void partialSM(f32x16& p0, f32x16& p1, float& m_reg, float& alpha) {
  float pmax = p0[0];
#pragma unroll
  for (int r = 1; r < 16; ++r) pmax = fmaxf(pmax, p0[r]);
#pragma unroll
  for (int r = 0; r < 16; ++r) pmax = fmaxf(pmax, p1[r]);
  { auto rr = __builtin_amdgcn_permlane32_swap(__float_as_uint(pmax), __float_as_uint(pmax), false, false); pmax = fmaxf(__uint_as_float(rr[0]), __uint_as_float(rr[1])); }
  if (__builtin_expect(__all(pmax - m_reg <= 8.f), 1)) { alpha = 1.f; }
  else { const float mn = fmaxf(m_reg, pmax); alpha = __builtin_amdgcn_exp2f(m_reg - mn); m_reg = mn; }
  const float mneg = -m_reg;
#pragma unroll
  for (int r = 0; r < 16; ++r) { p0[r] += mneg; p1[r] += mneg; }
#pragma unroll
  for (int r = 0; r < 16; ++r) p0[r] = __builtin_amdgcn_exp2f(p0[r]);
}
__device__ __forceinline__ void finishSM(f32x16& p0, f32x16& p1, float alpha, float& l_reg, bf16x8& pa0, bf16x8& pa1, bf16x8& pa2, bf16x8& pa3) {
#pragma unroll
  for (int r = 0; r < 16; ++r) p1[r] = __builtin_amdgcn_exp2f(p1[r]);
  float ps = 0.f;
#pragma unroll
  for (int r = 0; r < 16; ++r) ps += p0[r];
#pragma unroll
  for (int r = 0; r < 16; ++r) ps += p1[r];
  { auto rr = __builtin_amdgcn_permlane32_swap(__float_as_uint(ps), __float_as_uint(ps), false, false); ps = __uint_as_float(rr[0]) + __uint_as_float(rr[1]); }
  l_reg = l_reg * alpha + ps;
#define FA_PK4(P, BASE, OUT) do { unsigned a0 = cvtpk(P[BASE + 0], P[BASE + 1]), a1 = cvtpk(P[BASE + 2], P[BASE + 3]);   \
    unsigned b0 = cvtpk(P[BASE + 4], P[BASE + 5]), b1 = cvtpk(P[BASE + 6], P[BASE + 7]);                              \
    auto r0 = __builtin_amdgcn_permlane32_swap(a0, b0, false, false); auto r1 = __builtin_amdgcn_permlane32_swap(a1, b1, false, false); \
    u32x4 w = {r0[0], r1[0], r0[1], r1[1]}; OUT = *reinterpret_cast<bf16x8*>(&w); } while (0)
  FA_PK4(p0, 0, pa0); FA_PK4(p0, 8, pa1); FA_PK4(p1, 0, pa2); FA_PK4(p1, 8, pa3);
#undef FA_PK4
}
__device__ __forceinline__ void flash_unit64(const bf16_t* __restrict__ Qb, int ldq, const bf16_t* __restrict__ Kh, int ldk,
                                             const bf16_t* __restrict__ Vh, int ldv, bf16_t* __restrict__ Ob, int ldo, int nkeys, char* lds) {
  constexpr int DQK = 64, KROWB = 128, SHM_K = 8192, SHM_V = 16384;
  const int tid = opaque_tid(), wid = tid >> 6, lane = tid & 63, r32 = lane & 31, hi = lane >> 5;
  char* V_lds = lds; char* K_lds = lds + 2 * SHM_V;
  float* ws = (float*)(lds + 2 * SHM_V + 2 * SHM_K) + wid * 64; float* li_l = ws; float* al_l = ws + 32;
  float m_reg = -1e30f, l_reg = 0.f; f32x16 o[4] = {}; bf16x8 qr[4];
  const bf16_t* Qw = Qb + (long)(wid * 32 + r32) * ldq + hi * 8;
#pragma unroll
  for (int d0 = 0; d0 < 4; ++d0) qr[d0] = *reinterpret_cast<const bf16x8*>(Qw + d0 * 16);
  const int vr = tid >> 4, vc = (tid & 15) * 8, vst0 = v_st(vr, vc), vst1 = v_st(32 + vr, vc);
  const int kr = tid >> 3, kc = tid & 7, kst = kr * KROWB + ((kc * 16) ^ (((kr >> 1) & 7) << 4));
  const int vb0 = (int)(uintptr_t)V_lds + v_rd_base(lane);
  bf16x8 vsA0, vsA1, ksA, vsB0, vsB1, ksB;
#define F2_SLOAD(S, k0) do { vs##S##0 = *reinterpret_cast<const bf16x8*>(Vh + (long)((k0) + vr) * ldv + vc); vs##S##1 = *reinterpret_cast<const bf16x8*>(Vh + (long)((k0) + 32 + vr) * ldv + vc); \
    ks##S = *reinterpret_cast<const bf16x8*>(Kh + (long)((k0) + kr) * ldk + kc * 8); } while (0)
#define F2_SWRITE(b, S) do { *(bf16x8*)(V_lds + (b) * SHM_V + vst0) = vs##S##0; *(bf16x8*)(V_lds + (b) * SHM_V + vst1) = vs##S##1; *(bf16x8*)(K_lds + (b) * SHM_K + kst) = ks##S; } while (0)
#define F2_RESC(a) do { if (__any((a) < 1.f)) { if (hi == 0) al_l[r32] = (a); asm volatile("s_waitcnt lgkmcnt(0)" ::: "memory"); \
    _Pragma("unroll") for (int d_ = 0; d_ < 4; ++d_) _Pragma("unroll") for (int r_ = 0; r_ < 16; ++r_) o[d_][r_] *= al_l[crow(r_, hi)]; } } while (0)
  f32x16 pA0, pA1, pB0, pB1; float alA, alB; bf16x8 pa0, pa1, pa2, pa3; const int NT = nkeys / 64;
  F2_SLOAD(A, 0); F2_SWRITE(0, A); __syncthreads();
  qkt<DQK, true>(pA0, pA1, K_lds, qr, nullptr, r32, hi); partialSM(pA0, pA1, m_reg, alA);
  F2_SLOAD(B, 64); if (2 < NT) F2_SLOAD(A, 128);
  F2_SWRITE(1, B); __syncthreads();
  for (int j = 1; j + 1 < NT; j += 2) {
    FA_SBAR(); qkt<DQK, true>(pB0, pB1, K_lds + SHM_K, qr, nullptr, r32, hi);
    finishSM(pA0, pA1, alA, l_reg, pa0, pa1, pa2, pa3); FA_SBAR();
    F2_SLOAD(B, (j + 2) * 64); FA_SBAR();
    pv_d0(o, vb0, pa0, pa1, pa2, pa3); partialSM(pB0, pB1, m_reg, alB);
    __syncthreads(); F2_SWRITE(0, A);
    F2_RESC(alB); __syncthreads();
    FA_SBAR(); qkt<DQK, true>(pA0, pA1, K_lds, qr, nullptr, r32, hi);
    finishSM(pB0, pB1, alB, l_reg, pa0, pa1, pa2, pa3); FA_SBAR();
    if (j + 3 < NT) F2_SLOAD(A, (j + 3) * 64);
    FA_SBAR();
    pv_d0(o, vb0 + SHM_V, pa0, pa1, pa2, pa3); partialSM(pA0, pA1, m_reg, alA);
    __syncthreads(); F2_SWRITE(1, B);
    F2_RESC(alA); __syncthreads();
  }
  FA_SBAR(); qkt<DQK, true>(pB0, pB1, K_lds + SHM_K, qr, nullptr, r32, hi);
  finishSM(pA0, pA1, alA, l_reg, pa0, pa1, pa2, pa3); FA_SBAR();
  pv_d0(o, vb0, pa0, pa1, pa2, pa3); partialSM(pB0, pB1, m_reg, alB);
  __syncthreads(); F2_RESC(alB);
  finishSM(pB0, pB1, alB, l_reg, pa0, pa1, pa2, pa3); FA_SBAR();
  pv_d0(o, vb0 + SHM_V, pa0, pa1, pa2, pa3);
  if (hi == 0) li_l[r32] = l_reg; asm volatile("s_waitcnt lgkmcnt(0)" ::: "memory");
  float rli[16];
#pragma unroll
  for (int r = 0; r < 16; ++r) rli[r] = __builtin_amdgcn_rcpf(li_l[crow(r, hi)]);
  bf16_t* Ow = Ob + (long)(wid * 32) * ldo;
#pragma unroll
  for (int r = 0; r < 16; ++r) { const int orow = crow(r, hi);
#pragma unroll
    for (int d0 = 0; d0 < 4; ++d0) { const float v = o[d0][r] * rli[r]; Ow[(long)orow * ldo + d0 * 32 + r32] = (bf16_t)(cvtpk(v, v) & 0xffffu); } }
  __syncthreads();
#undef F2_SLOAD
#undef F2_SWRITE
#undef F2_RESC
}

__device__ __forceinline__ void xattn_unit(const bf16_t* __restrict__ Qb, const bf16_t* __restrict__ Kh, const bf16_t* __restrict__ Vh, bf16_t* __restrict__ Ob, char* lds) {
  const int tid = opaque_tid(), wid = __builtin_amdgcn_readfirstlane(tid >> 6), lane = tid & 63, r32 = lane & 31, hi = lane >> 5;
  float* li_l = (float*)(lds + 131072 + 256) + wid * 32;
  { bf16x8 st[16];
#pragma unroll
    for (int i = 0; i < 16; ++i) { const int q = tid + 512 * i, row = q >> 5, ch = q & 31; st[i] = *reinterpret_cast<const bf16x8*>(Kh + (long)row * 2048 + ch * 8); }
#pragma unroll
    for (int i = 0; i < 16; ++i) { const int q = tid + 512 * i, row = q >> 5, ch = q & 31; *(bf16x8*)(lds + row * 512 + ((ch * 16) ^ ((row & 15) << 4))) = st[i]; } }
  __syncthreads();
  f32x16 S[8];
#pragma unroll
  for (int kb = 0; kb < 8; ++kb) S[kb] = f32x16{};
  const bf16_t* Qw = Qb + (long)(wid * 32 + r32) * 1024 + hi * 8;
#pragma unroll
  for (int g = 0; g < 2; ++g) { bf16x8 qv[8];
#pragma unroll
    for (int i = 0; i < 8; ++i) qv[i] = *reinterpret_cast<const bf16x8*>(Qw + (g * 8 + i) * 16);
#pragma unroll
    for (int i = 0; i < 8; ++i) { const int cb = ((g * 8 + i) * 16 + hi * 8) * 2;
#pragma unroll
      for (int kb = 0; kb < 8; ++kb) { const bf16x8 kf = *reinterpret_cast<const bf16x8*>(lds + (kb * 32 + r32) * 512 + (cb ^ ((r32 & 15) << 4)));
        S[kb] = __builtin_amdgcn_mfma_f32_32x32x16_bf16(kf, qv[i], S[kb], 0, 0, 0); } } }
  float m = S[0][0];
#pragma unroll
  for (int kb = 0; kb < 8; ++kb)
#pragma unroll
    for (int r = 0; r < 16; ++r) m = fmaxf(m, S[kb][r]);
  { auto rr = __builtin_amdgcn_permlane32_swap(__float_as_uint(m), __float_as_uint(m), false, false); m = fmaxf(__uint_as_float(rr[0]), __uint_as_float(rr[1])); }
  float l = 0.f;
#pragma unroll
  for (int kb = 0; kb < 8; ++kb)
#pragma unroll
    for (int r = 0; r < 16; ++r) { S[kb][r] = __builtin_amdgcn_exp2f(S[kb][r] - m); l += S[kb][r]; }
  { auto rr = __builtin_amdgcn_permlane32_swap(__float_as_uint(l), __float_as_uint(l), false, false); l = __uint_as_float(rr[0]) + __uint_as_float(rr[1]); }
  bf16x8 pa[16];
#define XA_PK4(P, BASE, OUT) do { unsigned a0 = cvtpk(P[BASE + 0], P[BASE + 1]), a1 = cvtpk(P[BASE + 2], P[BASE + 3]);   \
    unsigned b0 = cvtpk(P[BASE + 4], P[BASE + 5]), b1 = cvtpk(P[BASE + 6], P[BASE + 7]);                              \
    auto r0 = __builtin_amdgcn_permlane32_swap(a0, b0, false, false); auto r1 = __builtin_amdgcn_permlane32_swap(a1, b1, false, false); \
    u32x4 w = {r0[0], r1[0], r0[1], r1[1]}; OUT = *reinterpret_cast<bf16x8*>(&w); } while (0)
#pragma unroll
  for (int kt = 0; kt < 4; ++kt) { XA_PK4(S[2 * kt], 0, pa[4 * kt]); XA_PK4(S[2 * kt], 8, pa[4 * kt + 1]); XA_PK4(S[2 * kt + 1], 0, pa[4 * kt + 2]); XA_PK4(S[2 * kt + 1], 8, pa[4 * kt + 3]); }
#undef XA_PK4
  { bf16x8 st[16];
#pragma unroll
    for (int i = 0; i < 16; ++i) { const int q = tid + 512 * i, row = q >> 5, c = (q & 31) * 8; st[i] = *reinterpret_cast<const bf16x8*>(Vh + (long)row * 2048 + c); }
    __syncthreads();
#pragma unroll
    for (int i = 0; i < 16; ++i) { const int q = tid + 512 * i, row = q >> 5, c = (q & 31) * 8; *(bf16x8*)(lds + ((row >> 6) * 2 + (c >> 7)) * 16384 + v_st(row & 63, c & 127)) = st[i]; } }
  if (hi == 0) li_l[r32] = l;
  __syncthreads();
  float rli[16];
#pragma unroll
  for (int r = 0; r < 16; ++r) rli[r] = __builtin_amdgcn_rcpf(li_l[crow(r, hi)]);
  const int vb0 = (int)(uintptr_t)lds + v_rd_base(lane);
  bf16_t* Ow = Ob + (long)(wid * 32) * 1024;
#pragma unroll
  for (int dvh = 0; dvh < 2; ++dvh) { f32x16 o[4] = {};
#pragma unroll
    for (int kt = 0; kt < 4; ++kt) pv_d0(o, vb0 + (kt * 2 + dvh) * 16384, pa[4 * kt], pa[4 * kt + 1], pa[4 * kt + 2], pa[4 * kt + 3]);
#pragma unroll
    for (int r = 0; r < 16; ++r) { const int orow = crow(r, hi);
#pragma unroll
      for (int d0 = 0; d0 < 4; ++d0) { const float v = o[d0][r] * rli[r]; Ow[(long)orow * 1024 + dvh * 128 + d0 * 32 + r32] = (bf16_t)(cvtpk(v, v) & 0xffffu); } } }
  __syncthreads();
}

__device__ __forceinline__ void flash_unit64c(const bf16_t* __restrict__ Qb, int ldq, const bf16_t* __restrict__ Kh, int ldk,
                                              const bf16_t* __restrict__ Vh, int ldv, bf16_t* __restrict__ Ob, int ldo, int nkeys, char* lds) {
  constexpr int KROWB = 128, SHM_K = 8192, SHM_V = 16384;
  const int tid = opaque_tid(), wid = tid >> 6, lane = tid & 63, r32 = lane & 31, hi = lane >> 5;
  char* V_lds = lds; char* K_lds = lds + 2 * SHM_V;
  float* ws = (float*)(lds + 2 * SHM_V + 2 * SHM_K) + wid * 64; float* li_l = ws; float* al_l = ws + 32;
  float m_run = 0.f, l_reg = 0.f; f32x16 o[4] = {}; bf16x8 qr[4]; f32x16 negm = {};
  const bf16_t* Qw = Qb + (long)(wid * 32 + r32) * ldq + hi * 8;
#pragma unroll
  for (int d0 = 0; d0 < 4; ++d0) qr[d0] = *reinterpret_cast<const bf16x8*>(Qw + d0 * 16);
  const int vr = 2 * (tid >> 5) + ((tid >> 2) & 1), vc = (((tid >> 3) & 3) * 4 + (tid & 3)) * 8, vst0 = v_st(vr, vc), vst1 = v_st(32 + vr, vc);
  const int kr = tid >> 3, kc = tid & 7, kst = kr * KROWB + ((kc * 16) ^ (((kr >> 1) & 7) << 4));
  const int vb0 = (int)(uintptr_t)V_lds + v_rd_base(lane);
  const int ksw = ((r32 >> 1) & 7) << 4;
  bf16x8 vs0, vs1, ks;
#define F4_SLOAD(k0) do { vs0 = *reinterpret_cast<const bf16x8*>(Vh + (long)((k0) + vr) * ldv + vc); vs1 = *reinterpret_cast<const bf16x8*>(Vh + (long)((k0) + 32 + vr) * ldv + vc); \
    ks = *reinterpret_cast<const bf16x8*>(Kh + (long)((k0) + kr) * ldk + kc * 8); } while (0)
#define F4_SWRITE(b) do { *(bf16x8*)(V_lds + (b) * SHM_V + vst0) = vs0; *(bf16x8*)(V_lds + (b) * SHM_V + vst1) = vs1; *(bf16x8*)(K_lds + (b) * SHM_K + kst) = ks; } while (0)
#define F4_PK4(P, BASE, OUT) do { unsigned a0 = cvtpk(P[BASE + 0], P[BASE + 1]), a1 = cvtpk(P[BASE + 2], P[BASE + 3]);   \
    unsigned b0 = cvtpk(P[BASE + 4], P[BASE + 5]), b1 = cvtpk(P[BASE + 6], P[BASE + 7]);                              \
    auto r0 = __builtin_amdgcn_permlane32_swap(a0, b0, false, false); auto r1 = __builtin_amdgcn_permlane32_swap(a1, b1, false, false); \
    u32x4 w = {r0[0], r1[0], r0[1], r1[1]}; OUT = *reinterpret_cast<bf16x8*>(&w); } while (0)
#define F4_TILE(b, FIRST) do { f32x16 p0, p1; bf16x8 pa0, pa1, pa2, pa3; const char* Ks_ = K_lds + (b) * SHM_K; \
    _Pragma("unroll") for (int d0 = 0; d0 < 4; ++d0) { const int cb = (d0 * 16 + hi * 8) * 2; \
      const bf16x8 b0 = *reinterpret_cast<const bf16x8*>(Ks_ + r32 * KROWB + (cb ^ ksw)); const bf16x8 b1 = *reinterpret_cast<const bf16x8*>(Ks_ + (32 + r32) * KROWB + (cb ^ ksw)); \
      if (d0 == 0) { p0 = __builtin_amdgcn_mfma_f32_32x32x16_bf16(b0, qr[0], negm, 0, 0, 0); p1 = __builtin_amdgcn_mfma_f32_32x32x16_bf16(b1, qr[0], negm, 0, 0, 0); } \
      else { p0 = __builtin_amdgcn_mfma_f32_32x32x16_bf16(b0, qr[d0], p0, 0, 0, 0); p1 = __builtin_amdgcn_mfma_f32_32x32x16_bf16(b1, qr[d0], p1, 0, 0, 0); } } \
    float pmax = p0[0]; \
    _Pragma("unroll") for (int r = 1; r < 16; ++r) pmax = fmaxf(pmax, p0[r]); \
    _Pragma("unroll") for (int r = 0; r < 16; ++r) pmax = fmaxf(pmax, p1[r]); \
    { auto rr = __builtin_amdgcn_permlane32_swap(__float_as_uint(pmax), __float_as_uint(pmax), false, false); pmax = fmaxf(__uint_as_float(rr[0]), __uint_as_float(rr[1])); } \
    if ((FIRST) || !__builtin_expect(__all(pmax <= 8.f), 1)) { const float dl = (FIRST) ? pmax : fmaxf(pmax, 0.f); const float alpha = __builtin_amdgcn_exp2f(-dl); m_run += dl; l_reg *= alpha; \
      _Pragma("unroll") for (int r = 0; r < 16; ++r) { p0[r] -= dl; p1[r] -= dl; negm[r] = -m_run; } \
      if (!(FIRST)) { if (hi == 0) al_l[r32] = alpha; asm volatile("s_waitcnt lgkmcnt(0)" ::: "memory"); \
        _Pragma("unroll") for (int d_ = 0; d_ < 4; ++d_) _Pragma("unroll") for (int r_ = 0; r_ < 16; ++r_) o[d_][r_] *= al_l[crow(r_, hi)]; } } \
    _Pragma("unroll") for (int r = 0; r < 16; ++r) { p0[r] = __builtin_amdgcn_exp2f(p0[r]); p1[r] = __builtin_amdgcn_exp2f(p1[r]); } \
    float ps = 0.f; \
    _Pragma("unroll") for (int r = 0; r < 16; ++r) ps += p0[r]; \
    _Pragma("unroll") for (int r = 0; r < 16; ++r) ps += p1[r]; \
    { auto rr = __builtin_amdgcn_permlane32_swap(__float_as_uint(ps), __float_as_uint(ps), false, false); ps = __uint_as_float(rr[0]) + __uint_as_float(rr[1]); } \
    l_reg += ps; \
    F4_PK4(p0, 0, pa0); F4_PK4(p0, 8, pa1); F4_PK4(p1, 0, pa2); F4_PK4(p1, 8, pa3); \
    pv_d0(o, vb0 + (b) * SHM_V, pa0, pa1, pa2, pa3); } while (0)
  const int NT = nkeys / 64;
  F4_SLOAD(0); F4_SWRITE(0); F4_SLOAD(64); F4_SWRITE(1); F4_SLOAD(128); __syncthreads();
  F4_TILE(0, true);
  __syncthreads();
  F4_SWRITE(0); F4_SLOAD(192);
  for (int j = 1; j + 1 < NT; j += 2) {
    F4_TILE(1, false);
    __syncthreads();
    if (j + 2 < NT) { F4_SWRITE(1); if (j + 3 < NT) F4_SLOAD((j + 3) * 64); }
    F4_TILE(0, false);
    __syncthreads();
    if (j + 3 < NT) { F4_SWRITE(0); if (j + 4 < NT) F4_SLOAD((j + 4) * 64); }
  }
  F4_TILE(1, false);
  __syncthreads();
  if (hi == 0) li_l[r32] = l_reg; asm volatile("s_waitcnt lgkmcnt(0)" ::: "memory");
  float rli[16];
#pragma unroll
  for (int r = 0; r < 16; ++r) rli[r] = __builtin_amdgcn_rcpf(li_l[crow(r, hi)]);
  bf16_t* Ow = Ob + (long)(wid * 32) * ldo;
  { bf16_t* stg = (bf16_t*)(lds + 65536) + wid * 4096;
#pragma unroll
    for (int r = 0; r < 16; ++r) { const int orow = crow(r, hi);
#pragma unroll
      for (int d0 = 0; d0 < 4; ++d0) { const float v = o[d0][r] * rli[r]; stg[orow * 128 + d0 * 32 + r32] = (bf16_t)(cvtpk(v, v) & 0xffffu); } }
    asm volatile("s_waitcnt lgkmcnt(0)" ::: "memory");
#pragma unroll
    for (int i = 0; i < 8; ++i) { const int row = i * 4 + (lane >> 4), ch = lane & 15; const u32x4 v = *(const u32x4*)(stg + row * 128 + ch * 8); *(u32x4*)(Ow + (long)row * ldo + ch * 8) = v; } }
  __syncthreads();
#undef F4_SLOAD
#undef F4_SWRITE
#undef F4_PK4
#undef F4_TILE
}
}
typedef unsigned short bf16;
typedef float f32x4 __attribute__((ext_vector_type(4)));
typedef unsigned v4u __attribute__((ext_vector_type(4)));
typedef short bf16x8 __attribute__((ext_vector_type(8)));
typedef float f32x16 __attribute__((ext_vector_type(16)));
#define LAS __attribute__((address_space(3)))
constexpr int BATCH = 8, SEQ = 4096, DM = 1024, T = BATCH * SEQ, DEPTH = 2, NMEM = 256, TM = BATCH * NMEM, INW = 2560, DFF = 4096;
constexpr int NWAVES = 8, NTHR = 512;
constexpr size_t MiB = 1u << 20;
constexpr size_t WS_W = 0, W_LAYER = 32 * MiB;
constexpr size_t WO_IN = 0, WO_OUT = 5 * MiB, WO_Q = 7 * MiB, WO_KV = 9 * MiB, WO_O = 13 * MiB, WO_1 = 15 * MiB, WO_2 = 23 * MiB;
constexpr size_t WS_GATE = 64 * MiB;
constexpr size_t WS_ROPE = 65 * MiB;
constexpr size_t WS_RSS = 67 * MiB;
constexpr size_t WS_MEMN = 68 * MiB;
constexpr size_t WS_KVX = 76 * MiB;
constexpr size_t WS_SUM = 92 * MiB;
constexpr size_t WS_XB = 108 * MiB;
constexpr size_t WS_Z = 172 * MiB, WS_OC = 332 * MiB, WS_MIX = 396 * MiB, WS_CIN = 460 * MiB, WS_RSSP = 464 * MiB, WS_END = 480 * MiB;
constexpr size_t WS_BAR = WS_RSS + 964 * 1024;
constexpr size_t WS_CNT = WS_RSS + 960 * 1024;
constexpr size_t WS_H = WS_Z, WS_QX = WS_Z, WS_OX = WS_Z + 64 * MiB;
constexpr int LDS_BYTES = 147456;
constexpr float LOG2E = 1.4426950408889634f;

__device__ __forceinline__ float bf2f(short v) { return __uint_as_float(((unsigned)(unsigned short)v) << 16); }
__device__ __forceinline__ unsigned f2bf(float f) { unsigned u = __builtin_bit_cast(unsigned, f); return (u + 0x7fffu + ((u >> 16) & 1u)) >> 16; }
__device__ __forceinline__ unsigned pk2(float lo, float hi) { return f2bf(lo) | (f2bf(hi) << 16); }
__device__ __forceinline__ float wave_sum(float v) {
#pragma unroll
    for (int o = 1; o < 64; o <<= 1) v += __shfl_xor(v, o);
    return v;
}
__device__ __forceinline__ float sigm(float x) { return __builtin_amdgcn_rcpf(1.f + __expf(-x)); }
__device__ __forceinline__ float gelu_tanh(float x) { const float y = 0.7978845608028654f * (x + 0.044715f * x * x * x); const float e = __expf(2.f * y); const float th = 1.f - 2.f * __builtin_amdgcn_rcpf(e + 1.f); return 0.5f * x * (1.f + th); }

struct LruArgs { const float* spl; float* CIN; unsigned* CNT; const bf16* Z; const float *conv_w, *conv_b, *b_r, *b_i, *a_param, *norm_g; const bf16* WG; float* SUM; bf16* MIX; const bf16* OC; const float* subln_g; float lam, oml; };
constexpr int CSB = 1040, CFS = 516, CF_OFF = 34816;
__device__ __forceinline__ int crow16(int r, int hi) { return (r & 3) + 8 * (r >> 2) + 4 * hi; }

template <bool REV> __device__ __forceinline__ void lru_scan(f32x16& a, f32x16& u, float cin, float& Atot, float& Htot, int hi) {
    float P[16], As[4], Hs[4];
#pragma unroll
    for (int s = 0; s < 4; ++s) { float h = 0.f, p = 1.f;
#pragma unroll
        for (int q = 0; q < 4; ++q) { const int r = REV ? 4 * s + 3 - q : 4 * s + q; h = a[r] * h + u[r]; p *= a[r]; u[r] = h; P[r] = p; }
        As[s] = p; Hs[s] = h; }
    float pA[4], pH[4];
#pragma unroll
    for (int s = 0; s < 4; ++s) { pA[s] = __shfl_xor(As[s], 32); pH[s] = __shfl_xor(Hs[s], 32); }
    float c = cin, at = 1.f, cm[4] = {0.f, 0.f, 0.f, 0.f};
#pragma unroll
    for (int gg = 0; gg < 8; ++gg) { const int g = REV ? 7 - gg : gg; const int s = g >> 1; const bool own = ((g & 1) == hi);
        const float Ag = own ? As[s] : pA[s], Hg = own ? Hs[s] : pH[s];
        cm[s] = own ? c : cm[s];
        c = Ag * c + Hg; at *= Ag; }
    Atot = at; Htot = c;
#pragma unroll
    for (int r = 0; r < 16; ++r) u[r] = u[r] + P[r] * cm[r >> 2];
}
template <bool REV> __device__ __forceinline__ float lru_carry(const float* sb  , int j) {
    const int n = REV ? 127 - j : j; float c = 0.f;
    for (int k0 = 0; k0 < n; k0 += 8) { float Av[8], Hv[8];
#pragma unroll
        for (int q = 0; q < 8; ++q) { const int k = k0 + q; const bool ok = k < n; const int i = ok ? (REV ? 127 - k : k) : (REV ? 127 : 0);
            const float av = sb[(size_t)i * 2048], hv = sb[(size_t)i * 2048 + 512]; Av[q] = ok ? av : 1.f; Hv[q] = ok ? hv : 0.f; }
#pragma unroll
        for (int q = 0; q < 8; ++q) c = Av[q] * c + Hv[q];
    }
    return c;
}
__device__ __forceinline__ void lru_xload(bf16x8 (&xr)[7], const LruArgs& A, int b, int j, int w, int lane) {
    const int t0 = j * 32 + 4 * w; const long rowb = (long)b * SEQ;
#pragma unroll
    for (int rr = 0; rr < 7; ++rr) { const int t = t0 + rr - 2; const int tc = t < 0 ? 0 : (t >= SEQ ? SEQ - 1 : t);
        const bf16x8 raw = *(const bf16x8*)(A.Z + (rowb + tc) * INW + 1536 + 8 * lane); xr[rr] = (t >= 0 && t < SEQ) ? raw : (bf16x8){0, 0, 0, 0, 0, 0, 0, 0}; }
}
template <bool FINAL> __device__ __forceinline__ void lru_chunk(const LruArgs& A, int b, int j, char* lds, bf16x8 (&xr)[7], int nb_, int nj_, bool publish) {
    const int tid = opaque_tid(), w = __builtin_amdgcn_readfirstlane(tid >> 6), lane = tid & 63, n32 = lane & 31, hi = lane >> 5;
    char* Cs = lds; float* Cf = (float*)(lds + CF_OFF);
    const long rowb = (long)b * SEQ;
    {
        const int tl = 4 * w;
        float xv[7][8];
#pragma unroll
        for (int rr = 0; rr < 7; ++rr) {
#pragma unroll
            for (int e = 0; e < 8; ++e) xv[rr][e] = bf2f(xr[rr][e]); }
        float cw[4][8], cb[8];
#pragma unroll
        for (int jj = 0; jj < 4; ++jj) { const f32x4 a0 = *(const f32x4*)(A.conv_w + jj * 512 + 8 * lane), a1 = *(const f32x4*)(A.conv_w + jj * 512 + 8 * lane + 4);
#pragma unroll
            for (int e = 0; e < 4; ++e) { cw[jj][e] = a0[e]; cw[jj][4 + e] = a1[e]; } }
        { const f32x4 a0 = *(const f32x4*)(A.conv_b + 8 * lane), a1 = *(const f32x4*)(A.conv_b + 8 * lane + 4);
#pragma unroll
            for (int e = 0; e < 4; ++e) { cb[e] = a0[e]; cb[4 + e] = a1[e]; } }
#pragma unroll
        for (int tt = 0; tt < 4; ++tt) { float c[8];
#pragma unroll
            for (int e = 0; e < 8; ++e) c[e] = cb[e] + cw[0][e] * xv[tt][e] + cw[1][e] * xv[tt + 1][e] + cw[2][e] * xv[tt + 2][e] + cw[3][e] * xv[tt + 3][e];
            v4u pk; pk.x = pk2(c[0], c[1]); pk.y = pk2(c[2], c[3]); pk.z = pk2(c[4], c[5]); pk.w = pk2(c[6], c[7]);
            *(v4u*)(Cs + (tl + tt) * CSB + lane * 16) = pk;
            *(f32x4*)(Cf + (tl + tt) * CFS + 8 * lane) = (f32x4){c[0], c[1], c[2], c[3]};
            *(f32x4*)(Cf + (tl + tt) * CFS + 8 * lane + 4) = (f32x4){c[4], c[5], c[6], c[7]}; }
    }
    __syncthreads();
    if (nj_ >= 0) lru_xload(xr, A, nb_, nj_, w, lane);
    bf16x8 gpre[4], o1pre[4], o2pre[4];
    if (FINAL) {
#pragma unroll
        for (int tt = 0; tt < 4; ++tt) { const long grow = rowb + j * 32 + 4 * w + tt;
            gpre[tt] = *(const bf16x8*)(A.Z + grow * INW + 2048 + 8 * lane); o1pre[tt] = *(const bf16x8*)(A.OC + grow * 512 + 8 * lane); o2pre[tt] = *(const bf16x8*)(A.OC + (size_t)T * 512 + grow * 512 + 8 * lane); } }
    bf16x8 af[4];
#pragma unroll
    for (int ks = 0; ks < 4; ++ks) af[ks] = *(const bf16x8*)(Cs + n32 * CSB + (64 * w + 16 * ks + 8 * hi) * 2);
#pragma unroll
    for (int nb = 0; nb < 2; ++nb) {
        const int cl = 32 * nb + n32, ch = 64 * w + cl;
        f32x16 hs = {};
#pragma unroll
        for (int dir = 0; dir < 2; ++dir) {
            const bf16* wg_r = A.WG + ((size_t)((dir * 2 + 0) * 8 + w) * 64 + cl) * 64 + 8 * hi;
            const bf16* wg_i = A.WG + ((size_t)((dir * 2 + 1) * 8 + w) * 64 + cl) * 64 + 8 * hi;
            f32x16 dr = {}, di = {};
#pragma unroll
            for (int ks = 0; ks < 4; ++ks) {
                dr = __builtin_amdgcn_mfma_f32_32x32x16_bf16(af[ks], *(const bf16x8*)(wg_r + 16 * ks), dr, 0, 0, 0);
                di = __builtin_amdgcn_mfma_f32_32x32x16_bf16(af[ks], *(const bf16x8*)(wg_i + 16 * ks), di, 0, 0, 0); }
            const float spl = A.spl[dir * 512 + ch], br = -LOG2E * A.b_r[dir * 512 + ch], bi = -LOG2E * A.b_i[dir * 512 + ch];
#pragma unroll
            for (int r = 0; r < 16; ++r) { const int tok = crow16(r, hi);
                const float rg = __builtin_amdgcn_rcpf(1.f + __builtin_amdgcn_exp2f(dr[r] + br)), ig = __builtin_amdgcn_rcpf(1.f + __builtin_amdgcn_exp2f(di[r] + bi));
                const float a = __builtin_amdgcn_exp2f(rg * spl), mult = __builtin_amdgcn_sqrtf(fmaf(-a, a, 1.f));
                dr[r] = a; di[r] = Cf[tok * CFS + ch] * ig * mult; }
            float cin = 0.f;
            if (FINAL) cin = A.CIN[((size_t)(b * 128 + j) * 2 + dir) * 512 + ch];
            float At, Ht;
            if (dir) lru_scan<true>(dr, di, cin, At, Ht, hi); else lru_scan<false>(dr, di, cin, At, Ht, hi);
            if (!FINAL) { if (hi == 0) { float* sp_ = A.SUM + ((size_t)(b * 128 + j) * 2 + dir) * 1024 + ch;
                __hip_atomic_store(sp_, At, __ATOMIC_RELAXED, __HIP_MEMORY_SCOPE_AGENT); __hip_atomic_store(sp_ + 512, Ht, __ATOMIC_RELAXED, __HIP_MEMORY_SCOPE_AGENT); } }
            else { hs = dir ? hs + di : di; }
        }
        if (FINAL) {
#pragma unroll
            for (int r = 0; r < 16; ++r) Cf[crow16(r, hi) * CFS + ch] = hs[r];
        }
    }
    if (!FINAL && publish) {
        asm volatile("s_waitcnt vmcnt(0)" ::: "memory");
        __syncthreads();
        LAS unsigned* flag = (LAS unsigned*)(lds + 131072 - 16);
        if (tid == 0) { const unsigned old = __hip_atomic_fetch_add(A.CNT + b, 4u, __ATOMIC_RELAXED, __HIP_MEMORY_SCOPE_AGENT); *flag = (old == 124u) ? 1u : 0u; }
        __syncthreads();
        const bool last = (*flag != 0u);
        if (last) {
            __builtin_amdgcn_fence(__ATOMIC_ACQUIRE, "agent");
            const float* sb = A.SUM + (size_t)b * 128 * 2048 + tid;
            float* cb_ = A.CIN + (size_t)b * 128 * 1024 + tid;
            float cf = 0.f, cr = 0.f;
            for (int k0 = 0; k0 < 128; k0 += 32) { float Af[32], Hf[32], Ar[32], Hr[32];
#pragma unroll
                for (int q = 0; q < 32; ++q) { const int jf = k0 + q, jr = 127 - jf;
                    Af[q] = __hip_atomic_load(sb + (size_t)jf * 2048, __ATOMIC_RELAXED, __HIP_MEMORY_SCOPE_AGENT); Hf[q] = __hip_atomic_load(sb + (size_t)jf * 2048 + 512, __ATOMIC_RELAXED, __HIP_MEMORY_SCOPE_AGENT);
                    Ar[q] = __hip_atomic_load(sb + (size_t)jr * 2048 + 1024, __ATOMIC_RELAXED, __HIP_MEMORY_SCOPE_AGENT); Hr[q] = __hip_atomic_load(sb + (size_t)jr * 2048 + 1536, __ATOMIC_RELAXED, __HIP_MEMORY_SCOPE_AGENT); }
#pragma unroll
                for (int q = 0; q < 32; ++q) { const int jf = k0 + q, jr = 127 - jf;
                    cb_[(size_t)jf * 1024] = cf; cf = Af[q] * cf + Hf[q];
                    cb_[(size_t)jr * 1024 + 512] = cr; cr = Ar[q] * cr + Hr[q]; }
            }
        }
    }
    __syncthreads();
    if (FINAL) {
#pragma unroll
        for (int tt = 0; tt < 4; ++tt) { const int tl = 4 * w + tt; const long grow = rowb + j * 32 + tl;
            const f32x4 y0 = *(const f32x4*)(Cf + tl * CFS + 8 * lane), y1 = *(const f32x4*)(Cf + tl * CFS + 8 * lane + 4);
            const bf16x8 g = gpre[tt];
            float y[8]; float ss = 0.f;
#pragma unroll
            for (int e = 0; e < 8; ++e) { const float yv = e < 4 ? y0[e] : y1[e - 4]; y[e] = yv * gelu_tanh(bf2f(g[e])); ss += y[e] * y[e]; }
            ss = wave_sum(ss); const float rs = rsqrtf(ss * (1.f / 512.f) + 1e-6f);
            const f32x4 g0 = *(const f32x4*)(A.norm_g + 8 * lane), g1 = *(const f32x4*)(A.norm_g + 8 * lane + 4);
            v4u pk; pk.x = pk2(y[0] * rs * g0[0], y[1] * rs * g0[1]); pk.y = pk2(y[2] * rs * g0[2], y[3] * rs * g0[3]); pk.z = pk2(y[4] * rs * g1[0], y[5] * rs * g1[1]); pk.w = pk2(y[6] * rs * g1[2], y[7] * rs * g1[3]);
            *(v4u*)(A.MIX + grow * DM + 512 + 8 * lane) = pk;
            const bf16x8 o1 = o1pre[tt], o2 = o2pre[tt];
            float d[8]; float s2 = 0.f;
#pragma unroll
            for (int e = 0; e < 8; ++e) { d[e] = bf2f(o1[e]) - A.lam * bf2f(o2[e]); s2 += d[e] * d[e]; }
            s2 += __shfl_xor(s2, 1); s2 += __shfl_xor(s2, 2); s2 += __shfl_xor(s2, 4); s2 += __shfl_xor(s2, 8);
            const float r2 = rsqrtf(s2 * (1.f / 128.f) + 1e-6f) * A.oml;
            const int gc = (8 * lane) & 127;
            const f32x4 s0 = *(const f32x4*)(A.subln_g + gc), s1 = *(const f32x4*)(A.subln_g + gc + 4);
            v4u pq; pq.x = pk2(d[0] * r2 * s0[0], d[1] * r2 * s0[1]); pq.y = pk2(d[2] * r2 * s0[2], d[3] * r2 * s0[3]); pq.z = pk2(d[4] * r2 * s1[0], d[5] * r2 * s1[1]); pq.w = pk2(d[6] * r2 * s1[2], d[7] * r2 * s1[3]);
            *(v4u*)(A.MIX + grow * DM + 8 * lane) = pq; }
        __syncthreads();
    }
}
#define XB_TMO      128
#define XB_XCNT(j)  (256  + 64 * (j))
#define XB_XSUB(j)  (1280 + 64 * (j))
#define XB_XGEN(j)  (2304 + 64 * (j))
#define XB_TOP      3328
#define XB_TOPGEN   3392
#define XCD_BAR_WORDS 3456
#define XB_SPIN_CAP (1u << 18)

__device__ __forceinline__ unsigned xb_ld(unsigned* p)              { return __hip_atomic_load(p, __ATOMIC_RELAXED, __HIP_MEMORY_SCOPE_AGENT); }
__device__ __forceinline__ unsigned xb_add(unsigned* p, unsigned v) { return __hip_atomic_fetch_add(p, v, __ATOMIC_RELAXED, __HIP_MEMORY_SCOPE_AGENT); }
__device__ __forceinline__ unsigned xb_xcc_id() { return (unsigned)__builtin_amdgcn_s_getreg((3 << 11) | 20) & 0xFu; }
#define XB_SPIN(cond, bar) do { unsigned _sp = 0; while (cond) { __builtin_amdgcn_s_sleep(1); \
    if ((++_sp & 255u) == 0u) { if (xb_ld(&(bar)[XB_TMO])) break; if (_sp > XB_SPIN_CAP) { atomicAdd(&(bar)[XB_TMO], 1u); break; } } } } while (0)

struct XcdBarrier {
    unsigned* bar; unsigned x;
    volatile LAS unsigned* st;
};

__device__ __forceinline__ XcdBarrier xcd_barrier_post(unsigned* bar, volatile LAS unsigned* st) {
    XcdBarrier b; b.bar = bar; b.x = xb_xcc_id(); b.st = st;
    if (threadIdx.x == 0) (void)xb_add(&bar[XB_XCNT(b.x)], 1u);
    return b;
}
__device__ __forceinline__ void xcd_barrier_complete(unsigned* bar, unsigned x, unsigned& nloc, unsigned& nx) {
    const unsigned G = gridDim.x * gridDim.y * gridDim.z;
    unsigned sum, cnt, mine, sp = 0u;
    for (;;) {
        sum = 0u; cnt = 0u; mine = 0u;
#pragma unroll
        for (unsigned j = 0; j < 16; ++j) { const unsigned c = xb_ld(&bar[XB_XCNT(j)]); sum += c; cnt += (c > 0u) ? 1u : 0u; mine = (j == x) ? c : mine; }
        if (sum == G) break;
        __builtin_amdgcn_s_sleep(1);
        if ((++sp & 255u) == 0u) { if (xb_ld(&bar[XB_TMO])) break; if (sp > XB_SPIN_CAP) { atomicAdd(&bar[XB_TMO], 1u); break; } }
    }
    nloc = mine > 0u ? mine : 1u; nx = cnt > 0u ? cnt : 1u;
}

__device__ __forceinline__ void xcd_barrier(const XcdBarrier& b) {
    asm volatile("s_waitcnt vmcnt(0)" ::: "memory");
    __syncthreads();
    if (threadIdx.x == 0) {
        unsigned* bar = b.bar;
        __builtin_amdgcn_s_waitcnt(0);
        unsigned nloc = b.st[0], nx = b.st[1];
        if (nloc == 0u) { xcd_barrier_complete(bar, b.x, nloc, nx); b.st[0] = nloc; b.st[1] = nx; }
        const unsigned old = xb_add(&bar[XB_XSUB(b.x)], 1u);
        const unsigned gen = old / nloc;
        if (old + 1u == (gen + 1u) * nloc) {
            __builtin_amdgcn_fence(__ATOMIC_RELEASE, "agent");
            asm volatile("s_waitcnt vmcnt(0)" ::: "memory");
            const unsigned og = xb_add(&bar[XB_TOP], 1u);
            const unsigned tg = og / nx;
            if (og + 1u == (tg + 1u) * nx) xb_add(&bar[XB_TOPGEN], 1u);
            else XB_SPIN(xb_ld(&bar[XB_TOPGEN]) == tg, bar);
            __builtin_amdgcn_fence(__ATOMIC_ACQUIRE, "agent");
            xb_add(&bar[XB_XGEN(b.x)], 1u);
            asm volatile("s_waitcnt vmcnt(0)" ::: "memory");
        } else {
            XB_SPIN(xb_ld(&bar[XB_XGEN(b.x)]) == gen, bar);
            __builtin_amdgcn_fence(__ATOMIC_ACQUIRE, "agent");
            asm volatile("s_waitcnt vmcnt(0)" ::: "memory");
        }
    }
    __syncthreads();
}

struct Args { const void* in[29]; float* out; unsigned char* ws; };
__device__ __forceinline__ void transpose_item(const float* W, int K, int N, bf16* WT, int row_off, const float* gain, LAS float* scr, int item, int lane) {
    const int nblk = N / 32, kb = item / nblk, nb = item % nblk, k0 = 64 * kb, n0 = 32 * nb;
    float wv_[32];
#pragma unroll
    for (int i = 0; i < 32; ++i) wv_[i] = W[(size_t)(k0 + 2 * i + (lane >> 5)) * N + n0 + (lane & 31)];
#pragma unroll
    for (int i = 0; i < 32; ++i) { const int kk = 2 * i + (lane >> 5); const float gv = gain ? gain[k0 + kk] : 1.f; scr[kk * 33 + (lane & 31)] = wv_[i] * gv; }
    asm volatile("s_waitcnt lgkmcnt(0)" ::: "memory");
    const int c = lane & 7;
#pragma unroll
    for (int j = 0; j < 4; ++j) { const int n = (lane >> 3) + 8 * j; const LAS float* s = scr + (8 * c) * 33 + n;
        v4u o; o.x = pk2(s[0 * 33], s[1 * 33]); o.y = pk2(s[2 * 33], s[3 * 33]); o.z = pk2(s[4 * 33], s[5 * 33]); o.w = pk2(s[6 * 33], s[7 * 33]);
        *(v4u*)(WT + (size_t)(row_off + n0 + n) * K + k0 + 8 * c) = o; }
    asm volatile("s_waitcnt lgkmcnt(0)" ::: "memory");
}
#define IN_F(i) ((const float*)args.in[i])

__global__ void __launch_bounds__(NTHR, 2) mega_fwd(Args args) {
    extern __shared__ __attribute__((aligned(16))) unsigned char lds[];
    cg::grid_group grid = cg::this_grid();
    const int tid = threadIdx.x, lane = tid & 63, wave = __builtin_amdgcn_readfirstlane(tid >> 6);
    const int G = gridDim.x, bx = blockIdx.x;
    const int vcu = (G % 8 == 0) ? (bx % 8) * (G / 8) + bx / 8 : bx;
    unsigned char* ws = args.ws;
    float* XF = args.out;
    bf16* XB = (bf16*)(ws + WS_XB);
    float* RSS = (float*)(ws + WS_RSSP);
    float* ROPE = (float*)(ws + WS_ROPE);
    bf16* Zb = (bf16*)(ws + WS_Z); bf16* OC = (bf16*)(ws + WS_OC); bf16* MIX = (bf16*)(ws + WS_MIX);
    bf16* Hb = (bf16*)(ws + WS_H); bf16* QX = (bf16*)(ws + WS_QX); bf16* OX = (bf16*)(ws + WS_OX);
    LAS unsigned char* ldsl = (LAS unsigned char*)lds;

    volatile LAS unsigned* bst = (volatile LAS unsigned*)(ldsl + 131072 + 64);
    if (tid < 2) bst[tid] = 0u;
    __syncthreads();
    for (int rep_ = 0; rep_ < REP_PRO; ++rep_) {
        const int gw = vcu * NWAVES + wave, NGW = G * NWAVES;
        LAS float* scr = (LAS float*)(ldsl + wave * 16384);
        constexpr int I_IN = 16 * 80, I_SQ = 16 * 32, I_1 = 16 * 128, I_2 = 64 * 32, IPL = I_IN + 5 * I_SQ + I_1 + I_2;
        for (int it = gw; it < DEPTH * IPL; it += NGW) {
            const int l = it / IPL; int r = it % IPL; unsigned char* wl = ws + WS_W + (size_t)l * W_LAYER;
            if (r < I_IN) { transpose_item(IN_F(4) + (size_t)l * DM * INW, DM, INW, (bf16*)(wl + WO_IN), 0, IN_F(3) + l * DM, scr, r, lane); continue; } r -= I_IN;
            if (r < I_SQ) { transpose_item(IN_F(18) + (size_t)l * DM * DM, DM, DM, (bf16*)(wl + WO_OUT), 0, nullptr, scr, r, lane); continue; } r -= I_SQ;
            if (r < I_SQ) { transpose_item(IN_F(21) + (size_t)l * DM * DM, DM, DM, (bf16*)(wl + WO_Q), 0, IN_F(19) + l * DM, scr, r, lane); continue; } r -= I_SQ;
            if (r < I_SQ) { transpose_item(IN_F(22) + (size_t)l * DM * DM, DM, DM, (bf16*)(wl + WO_KV), 0, nullptr, scr, r, lane); continue; } r -= I_SQ;
            if (r < I_SQ) { transpose_item(IN_F(23) + (size_t)l * DM * DM, DM, DM, (bf16*)(wl + WO_KV), DM, nullptr, scr, r, lane); continue; } r -= I_SQ;
            if (r < I_SQ) { transpose_item(IN_F(24) + (size_t)l * DM * DM, DM, DM, (bf16*)(wl + WO_O), 0, nullptr, scr, r, lane); continue; } r -= I_SQ;
            if (r < I_1) { transpose_item(IN_F(26) + (size_t)l * DM * DFF, DM, DFF, (bf16*)(wl + WO_1), 0, IN_F(25) + l * DM, scr, r, lane); continue; } r -= I_1;
            transpose_item(IN_F(27) + (size_t)l * DFF * DM, DFF, DM, (bf16*)(wl + WO_2), 0, nullptr, scr, r, lane);
        }
        const int gt = vcu * NTHR + tid, NGT = G * NTHR;
        { bf16* WG = (bf16*)(ws + WS_GATE);
          for (int o = gt; o < DEPTH * 2 * 2 * 8 * 64 * 64; o += NGT) { const int i = o & 63, jx = (o >> 6) & 63, n = (o >> 12) & 7, gate = (o >> 15) & 1, dir = (o >> 16) & 1, l = o >> 17;
              const float* src = gate ? IN_F(14) : IN_F(12);
              WG[o] = (bf16)f2bf(-LOG2E * src[((((size_t)l * 2 + dir) * 8 + n) * 64 + i) * 64 + jx]); } }
        { float* SPL = (float*)(ws + WS_GATE + 768 * 1024); for (int o = gt; o < DEPTH * 2 * 512; o += NGT) SPL[o] = -8.f * LOG2E * log1pf(expf(-IN_F(16)[o])); }
        { const int* pos = (const int*)args.in[2];
          for (int o = gt; o < T * 8; o += NGT) { const int row = o >> 3, i = o & 7; const float inv = powf(500000.f, -(float)i * 0.125f); const float ang = (float)pos[row] * inv;
              ROPE[row * 16 + i] = cosf(ang); ROPE[row * 16 + 8 + i] = sinf(ang); } }
        if (gt < DEPTH * BATCH) ((unsigned*)(ws + WS_CNT))[gt] = 0u;
        if (gt < XCD_BAR_WORDS) ((unsigned*)(ws + WS_BAR))[gt] = 0u;
        for (int m0 = gw * 4; m0 < T; m0 += NGW * 4) { f32x4 v[4][4];
#pragma unroll
            for (int q = 0; q < 4; ++q) { const f32x4* xr = (const f32x4*)(IN_F(0) + (size_t)(m0 + q) * DM) + lane;
#pragma unroll
                for (int j = 0; j < 4; ++j) v[q][j] = xr[64 * j]; }
#pragma unroll
            for (int q = 0; q < 4; ++q) { float s = 0.f;
#pragma unroll
                for (int j = 0; j < 4; ++j) s += (v[q][j].x * v[q][j].x + v[q][j].y * v[q][j].y) + (v[q][j].z * v[q][j].z + v[q][j].w * v[q][j].w);
                s = wave_sum(s); if (lane < 16) RSS[(size_t)(m0 + q) * 16 + lane] = (lane == 0) ? s : 0.f;
                unsigned long long* o8 = (unsigned long long*)(XB + (size_t)(m0 + q) * DM) + lane;
#pragma unroll
                for (int j = 0; j < 4; ++j) o8[64 * j] = (unsigned long long)pk2(v[q][j].x, v[q][j].y) | ((unsigned long long)pk2(v[q][j].z, v[q][j].w) << 32); } }
        for (int m = gw; m < DEPTH * TM; m += NGW) { const int l = m / TM, row = m % TM; const f32x4* xr = (const f32x4*)(IN_F(1) + (size_t)row * DM) + lane; const f32x4* gr = (const f32x4*)(IN_F(20) + l * DM) + lane; f32x4 v[4]; float s = 0.f;
#pragma unroll
            for (int j = 0; j < 4; ++j) { v[j] = xr[64 * j]; s += (v[j].x * v[j].x + v[j].y * v[j].y) + (v[j].z * v[j].z + v[j].w * v[j].w); }
            const float rs = rsqrtf(wave_sum(s) * (1.f / DM) + 1e-6f);
            unsigned long long* o8 = (unsigned long long*)((bf16*)(ws + WS_MEMN) + (size_t)m * DM) + lane;
#pragma unroll
            for (int j = 0; j < 4; ++j) { const f32x4 g = gr[64 * j]; o8[64 * j] = (unsigned long long)pk2(v[j].x * rs * g.x, v[j].y * rs * g.y) | ((unsigned long long)pk2(v[j].z * rs * g.z, v[j].w * rs * g.w) << 32); } }
    }
    grid.sync();
    const XcdBarrier xbar = xcd_barrier_post((unsigned*)(ws + WS_BAR), bst);
#define GRID_BAR() xcd_barrier(xbar)

    for (int l = 0; l < DEPTH; ++l) {
        pg8::Gemm g{(const bf16*)(ws + WS_MEMN) + (size_t)l * TM * DM, (const bf16*)(ws + WS_W + (size_t)l * W_LAYER + WO_KV), TM, 2048, DM};
        pg8::StaticOrder S; S.init(TM, 2048, G, bx);
        pg8::EpiScale<0> E{(bf16*)(ws + WS_KVX) + (size_t)l * TM * 2048, 2048, nullptr, 1.f, nullptr};
        pg8::gemm_phase<pg8::EpiScale<0>, pg8::StaticOrder, true, true>(ldsl, g, S, E);
    }

#pragma unroll
    for (int l = 0; l < DEPTH; ++l) {
        unsigned char* wl = ws + WS_W + (size_t)l * W_LAYER;
        for (int rep_ = 0; rep_ < REP_IN; ++rep_) {
            pg8::Gemm g{XB, (const bf16*)(wl + WO_IN), T, INW, DM}; pg8::StaticOrder S; S.init(T, INW, G, bx);
            pg8::EpiScale<1> E{Zb, INW, RSS + (size_t)(3 * l) * T * 16, 0.125f * LOG2E, ROPE};
            pg8::gemm_phase<pg8::EpiScale<1>, pg8::StaticOrder, true, true>(ldsl, g, S, E);
        }
        GRID_BAR();
        const float lam_init = 0.8f - 0.6f * expf(-0.3f * (float)l);
        float lam;
        { const float a = wave_sum(IN_F(5)[l * 64 + lane] * IN_F(6)[l * 64 + lane]), b2 = wave_sum(IN_F(7)[l * 64 + lane] * IN_F(8)[l * 64 + lane]); lam = expf(a) - expf(b2) + lam_init; }
        LruArgs LA{(const float*)(ws + WS_GATE + 768 * 1024) + l * 1024, (float*)(ws + WS_CIN), (unsigned*)(ws + WS_CNT) + l * BATCH, Zb, IN_F(10) + (size_t)l * 4 * 512, IN_F(11) + l * 512, IN_F(13) + l * 1024, IN_F(15) + l * 1024, IN_F(16) + l * 1024, IN_F(17) + l * 512,
                   (const bf16*)(ws + WS_GATE) + (size_t)l * 131072, (float*)(ws + WS_SUM), MIX, OC, IN_F(9) + l * 128, lam, 1.f - lam_init};
#ifndef NO_LRUA
        for (int rep_ = 0; rep_ < REP_LRUA; ++rep_)
        for (int base = vcu * 4; base < BATCH * 128; base += G * 4) { bf16x8 xr[7]; lru_xload(xr, LA, base >> 7, base & 127, wave, lane);
#pragma unroll 1
            for (int i = 0; i < 4; ++i) lru_chunk<false>(LA, base >> 7, (base & 127) + i, (char*)lds, xr, base >> 7, i < 3 ? (base & 127) + i + 1 : -1, i == 3); }
#endif
        for (int rep_ = 0; rep_ < REP_FA; ++rep_)
        for (int i = 0; i * G < 1024; ++i) {
            const int L = i * G + vcu; if (L >= 1024) break;
            const int uid = (G == 256) ? (((vcu >> 5) * 4 + i) * 32 + (vcu & 31)) : L;
            const int bh = uid >> 5, wi = uid & 31, c = wi >> 4, qb = wi & 15, b = bh >> 2, h = bh & 3;
            const bf16* Qp = Zb + ((size_t)b * SEQ + qb * 256) * INW + h * 128 + c * 64;
            const bf16* Kp = Zb + ((size_t)b * SEQ) * INW + 512 + h * 128 + c * 64;
            const bf16* Vp = Zb + ((size_t)b * SEQ) * INW + 1024 + h * 128;
            bf16* Op = OC + (size_t)c * T * 512 + ((size_t)b * SEQ + qb * 256) * 512 + h * 128;
#ifndef NO_FA64
            fa::flash_unit64c(Qp, INW, Kp, INW, Vp, INW, Op, 512, SEQ, (char*)lds);
#endif
        }
        GRID_BAR();
#ifndef NO_LRUC
        for (int rep_ = 0; rep_ < REP_LRUC; ++rep_)
        for (int base = vcu * 4; base < BATCH * 128; base += G * 4) { bf16x8 xr[7]; lru_xload(xr, LA, base >> 7, base & 127, wave, lane);
#pragma unroll 1
            for (int i = 0; i < 4; ++i) lru_chunk<true>(LA, base >> 7, (base & 127) + i, (char*)lds, xr, base >> 7, i < 3 ? (base & 127) + i + 1 : -1, false); }
#endif
        GRID_BAR();
        {
            pg8::Gemm g{MIX, (const bf16*)(wl + WO_OUT), T, DM, DM}; pg8::StaticOrder S; S.init(T, DM, G, bx);
            if (l == 0) { pg8::EpiRes<true> E{IN_F(0), XB, RSS + (size_t)(3 * l + 1) * T * 16}; pg8::gemm_phase<pg8::EpiRes<true>, pg8::StaticOrder, true, true>(ldsl, g, S, E); }
            else { pg8::EpiRes<false> E{nullptr, XB, RSS + (size_t)(3 * l + 1) * T * 16}; pg8::gemm_phase<pg8::EpiRes<false>, pg8::StaticOrder, true, true>(ldsl, g, S, E); }
        }
        GRID_BAR();
        for (int rep_ = 0; rep_ < REP_Q; ++rep_) {
            pg8::Gemm g{XB, (const bf16*)(wl + WO_Q), T, DM, DM}; pg8::StaticOrder S; S.init(T, DM, G, bx);
            pg8::EpiScale<2> E{QX, DM, RSS + (size_t)(3 * l + 1) * T * 16, 0.0625f * LOG2E, nullptr};
            pg8::gemm_phase<pg8::EpiScale<2>, pg8::StaticOrder, true, true>(ldsl, g, S, E);
        }
        {
            pg8::StaticOrder S; S.init(T, DM, G, bx); pg8::Unit u;
            for (int rep_ = 0; rep_ < REP_XA; ++rep_)
            for (int i = 0; S.next(i, u); ++i)
            {
                    const int b = u.pm >> 4, qb = u.pm & 15, h = u.pn;
                    const bf16* KV = (const bf16*)(ws + WS_KVX) + (size_t)l * TM * 2048 + (size_t)b * NMEM * 2048;
                    const bf16* Qp = QX + ((size_t)b * SEQ + qb * 256) * DM + h * 256;
                    bf16* Op = OX + ((size_t)b * SEQ + qb * 256) * DM + h * 256;
#ifndef NO_FA256
                    fa::xattn_unit(Qp, KV + h * 256, KV + 1024 + h * 256, Op, (char*)lds);
#endif
            }
        }
        GRID_BAR();
        {
            pg8::Gemm g{OX, (const bf16*)(wl + WO_O), T, DM, DM}; pg8::StaticOrder S; S.init(T, DM, G, bx);
            pg8::EpiRes<false> E{nullptr, XB, RSS + (size_t)(3 * l + 2) * T * 16};
            pg8::gemm_phase<pg8::EpiRes<false>, pg8::StaticOrder, true, true>(ldsl, g, S, E);
        }
        GRID_BAR();
        for (int rep_ = 0; rep_ < REP_UP; ++rep_) {
            pg8::Gemm g{XB, (const bf16*)(wl + WO_1), T, DFF, DM}; pg8::StaticOrder S; S.init(T, DFF, G, bx);
            pg8::EpiScale<3> E{Hb, DFF, RSS + (size_t)(3 * l + 2) * T * 16, 1.f, nullptr};
            pg8::gemm_phase<pg8::EpiScale<3>, pg8::StaticOrder, true, true>(ldsl, g, S, E);
        }
        GRID_BAR();
        {
            pg8::Gemm g{Hb, (const bf16*)(wl + WO_2), T, DM, DFF}; pg8::StaticOrder S; S.init(T, DM, G, bx);
            pg8::EpiRes<false> E{nullptr, XB, RSS + (size_t)(3 * l + 3) * T * 16};
            pg8::gemm_phase<pg8::EpiRes<false>, pg8::StaticOrder, true, true>(ldsl, g, S, E);
        }
        GRID_BAR();
    }
    for (int rep_ = 0; rep_ < REP_SYNC; ++rep_) GRID_BAR();
    {
        const int gw = vcu * NWAVES + wave, NGW = G * NWAVES; const float* rss = RSS + (size_t)6 * T * 16; const f32x4* gr = (const f32x4*)IN_F(28) + lane;
        f32x4 gv[4];
#pragma unroll
        for (int j = 0; j < 4; ++j) gv[j] = gr[64 * j];
        for (int m0 = gw * 4; m0 < T; m0 += NGW * 4) { unsigned long long q[4][4]; float ssv[4];
#pragma unroll
            for (int r = 0; r < 4; ++r) { const unsigned long long* xr = (const unsigned long long*)(XB + (size_t)(m0 + r) * DM) + lane; ssv[r] = lane < 16 ? rss[(size_t)(m0 + r) * 16 + lane] : 0.f;
#pragma unroll
                for (int j = 0; j < 4; ++j) q[r][j] = xr[64 * j]; }
#pragma unroll
            for (int r = 0; r < 4; ++r) { const float rs = rsqrtf(wave_sum(ssv[r]) * (1.f / DM) + 1e-6f); f32x4* orow = (f32x4*)(XF + (size_t)(m0 + r) * DM) + lane;
#pragma unroll
                for (int j = 0; j < 4; ++j) { const unsigned lo = (unsigned)q[r][j], hi2 = (unsigned)(q[r][j] >> 32);
                    const f32x4 v = {__uint_as_float(lo << 16), __uint_as_float(lo & 0xffff0000u), __uint_as_float(hi2 << 16), __uint_as_float(hi2 & 0xffff0000u)};
                    __builtin_nontemporal_store(v * rs * gv[j], orow + 64 * j); } } }
    }
}

extern "C" void kernel_launch(void* const* d_in, const int* in_sizes, int n_in, void* d_out, int out_size, void* d_ws, size_t ws_size, hipStream_t stream) {
    static int grid = 0;
    if (grid == 0) {
        if (n_in != 29 || in_sizes[0] != T * DM || out_size != T * DM || ws_size < WS_END) { fprintf(stderr, "kernel_launch: unexpected shapes (n_in %d, in0 %d, out %d, ws %zu, need %zu)\n", n_in, n_in > 0 ? in_sizes[0] : -1, out_size, ws_size, (size_t)WS_END); grid = -1; return; }
        int dev = 0, cus = 0, per_cu = 0;
        if (hipGetDevice(&dev) != hipSuccess || hipDeviceGetAttribute(&cus, hipDeviceAttributeMultiprocessorCount, dev) != hipSuccess) { fprintf(stderr, "kernel_launch: device query failed\n"); grid = -1; return; }
        if (hipFuncSetAttribute((const void*)mega_fwd, hipFuncAttributeMaxDynamicSharedMemorySize, LDS_BYTES) != hipSuccess) { fprintf(stderr, "kernel_launch: hipFuncSetAttribute failed\n"); grid = -1; return; }
        if (hipOccupancyMaxActiveBlocksPerMultiprocessor(&per_cu, (const void*)mega_fwd, NTHR, LDS_BYTES) != hipSuccess || per_cu < 1) { fprintf(stderr, "kernel_launch: occupancy query says %d blocks per CU\n", per_cu); (void)hipGetLastError(); per_cu = 1; }
        grid = cus;
    }
    if (grid < 0) return;
    Args a{};
    for (int i = 0; i < 29; ++i) a.in[i] = d_in[i];
    a.out = (float*)d_out; a.ws = (unsigned char*)d_ws;
    void* kargs[] = {&a};
    const hipError_t e = hipLaunchCooperativeKernel((const void*)mega_fwd, dim3(grid), dim3(NTHR), kargs, LDS_BYTES, stream);
    if (e != hipSuccess) fprintf(stderr, "kernel_launch: cooperative launch failed: %s (grid %d)\n", hipGetErrorString(e), grid);
}
```

```cpp
#include <hip/hip_runtime.h>
#include <hip/hip_cooperative_groups.h>
#include <cstdio>
#include <cstdint>
namespace cg = cooperative_groups;
#ifndef REP_FA
#define REP_FA 1
#endif
#ifndef REP_LRUA
#define REP_LRUA 1
#endif
#ifndef REP_LRUC
#define REP_LRUC 1
#endif
#ifndef REP_PRO
#define REP_PRO 1
#endif
#ifndef REP_Q
#define REP_Q 1
#endif
#ifndef REP_SYNC
#define REP_SYNC 0
#endif
#ifndef REP_XA
#define REP_XA 1
#endif
#ifndef REP_UP
#define REP_UP 1
#endif
#ifndef REP_IN
#define REP_IN 1
#endif
__device__ __forceinline__ int opaque_tid() { int t = threadIdx.x; asm volatile("" : "+v"(t)); return t; }
namespace pg8 {
#define PG8_LAS __attribute__((address_space(3)))
typedef unsigned short bf16_t;
typedef short bf16x8 __attribute__((ext_vector_type(8)));
typedef float f32x4 __attribute__((ext_vector_type(4)));
typedef unsigned u32x4 __attribute__((ext_vector_type(4)));
constexpr int BM = 256, BK = 64, HALF = 128, HTB = HALF * BK * 2  , STAGE_BYTES = 8 * HTB, NXCD = 8, WGM = 8;

__host__ __device__ __forceinline__ int lds_byte(int r, int c) { const int st = (r >> 4) * 2 + (c >> 5), rr = r & 15, cc = c & 31, ob = rr * 64 + cc * 2; return st * 1024 + (ob ^ (((ob >> 9) & 1) << 5)); }
__host__ __device__ __forceinline__ void stage_rc(int b, int& R, int& C) { const int st = b / 1024, sb = b % 1024, swz = sb ^ (((sb >> 9) & 1) << 5); R = (st >> 1) * 16 + swz / 64; C = (st & 1) * 32 + (swz % 64) / 2; }
__host__ __device__ __forceinline__ int perm32(int rho) { const int n = rho >> 4, i = rho & 15; return 8 * (i >> 2) + 4 * n + (i & 3); }

struct Unit { int pm, pn; };
struct Gemm { const bf16_t* A; const bf16_t* Bt; int M, N, K; };

struct StaticOrder {
    int nM, nN, nwg, G, c;
    __host__ __device__ void init(int M, int N, int G_, int c_) { nM = M / BM; nN = N / BM; nwg = nM * nN; G = G_; c = c_; }
    __host__ __device__ bool next(int i, Unit& u) const {
        const long L = (long)i * G + c; if (L >= nwg) return false;
        int wgid = (int)L; { const int q = nwg / NXCD, r = nwg % NXCD, xcd = wgid % NXCD, off = wgid / NXCD; wgid = (xcd < r ? xcd * (q + 1) : r * (q + 1) + (xcd - r) * q) + off; }
        const int nig = WGM * nN, gid = wgid / nig, fm = gid * WGM, gsz = (nM - fm) < WGM ? (nM - fm) : WGM;
        u.pm = fm + ((wgid % nig) % gsz); u.pn = (wgid % nig) / gsz; return true;
    }
    __device__ __forceinline__ void a_ready(const Unit&) const {}
    __device__ __forceinline__ void done(const Unit&) const {}
};

__device__ __forceinline__ unsigned cvt_pk_bf16(float lo, float hi) { unsigned r; asm volatile("v_cvt_pk_bf16_f32 %0, %1, %2" : "=v"(r) : "v"(lo), "v"(hi)); return r; }
template <class Epi, class Sched, bool ALIGN_EPI = false, bool SP2 = false>
__device__ __forceinline__ void gemm_phase(PG8_LAS unsigned char* lds, const Gemm g, const Sched& S, const Epi& E) {
    const int tid = opaque_tid(), wid = __builtin_amdgcn_readfirstlane(tid >> 6), lane = tid & 63, wr = wid >> 2, wc = wid & 3, fr = lane & 15, fq = lane >> 4;
    const int K = g.K, nt = K / BK;
    unsigned voffA[2], voffB[2];
#pragma unroll
    for (int i = 0; i < 2; ++i) { int R, C; stage_rc(tid * 16 + i * 8192, R, C); const int Rb = Epi::PERM ? ((R & ~31) + perm32(R & 31)) : R;
        voffA[i] = (unsigned)(R * K + C) * 2u; voffB[i] = (unsigned)(Rb * K + C) * 2u; }
    const size_t kstep = (size_t)(BK * 2);
    const size_t hstep = (size_t)HALF * K * 2;
    const size_t tstep = 2 * hstep;
    const unsigned ldsw = (unsigned)wid * 1024u;
    const int aoff = lds_byte(wr * 64 + fr, fq * 8), boff = lds_byte(wc * 32 + fr, fq * 8);
#define PG8_SA(b, h) (((b) * 2 + (h)) * HTB)
#define PG8_SB(b, h) ((4 + (b) * 2 + (h)) * HTB)
#define PG8_STAGE(bufoff, gbase, voff) do { _Pragma("unroll") for (int _i = 0; _i < 2; ++_i) \
        __builtin_amdgcn_global_load_lds((const unsigned*)((const char*)(gbase) + (voff)[_i]), (PG8_LAS unsigned*)(lds + (bufoff) + ldsw + _i * 8192), 16, 0, 0); } while (0)
#define PG8_LDA(dst, b, h) do { _Pragma("unroll") for (int m = 0; m < 4; ++m) _Pragma("unroll") for (int k = 0; k < 2; ++k) dst[m][k] = *(const PG8_LAS bf16x8*)(lds + PG8_SA(b, h) + aoff + m * 2048 + k * 1024); } while (0)
#define PG8_LDB(dst, b, h) do { _Pragma("unroll") for (int n = 0; n < 2; ++n) _Pragma("unroll") for (int k = 0; k < 2; ++k) dst[n][k] = *(const PG8_LAS bf16x8*)(lds + PG8_SB(b, h) + boff + n * 2048 + k * 1024); } while (0)
#define PG8_MMA(ai, bj, At, Bt) do { __builtin_amdgcn_s_setprio(1); _Pragma("unroll") for (int m = 0; m < 4; ++m) _Pragma("unroll") for (int n = 0; n < 2; ++n) _Pragma("unroll") for (int k = 0; k < 2; ++k) \
        acc[ai][bj][m][n] = __builtin_amdgcn_mfma_f32_16x16x32_bf16(Bt[n][k], At[m][k], acc[ai][bj][m][n], 0, 0, 0); __builtin_amdgcn_s_setprio(0); } while (0)
#define PG8_WAIT_V(n) asm volatile("s_waitcnt vmcnt(" #n ")" ::: "memory")
#define PG8_WAIT_L(n) asm volatile("s_waitcnt lgkmcnt(" #n ")" ::: "memory")
#define PG8_BAR __builtin_amdgcn_s_barrier()
#define PG8_SCHED __builtin_amdgcn_sched_barrier(0)
    Unit cur, nxt; int ui = 0;
    if (!S.next(0, cur)) return;
    f32x4 acc[2][2][4][2];
#pragma unroll
    for (int a = 0; a < 2; ++a)
#pragma unroll
        for (int b = 0; b < 2; ++b)
#pragma unroll
            for (int m = 0; m < 4; ++m)
#pragma unroll
                for (int n = 0; n < 2; ++n) acc[a][b][m][n] = (f32x4){0.f, 0.f, 0.f, 0.f};
    bf16x8 At[4][2], B0[2][2], B1[2][2];
    const char* cA = (const char*)g.A + (size_t)cur.pm * tstep; const char* cB = (const char*)g.Bt + (size_t)cur.pn * tstep;
    S.a_ready(cur);
    if constexpr (SP2) {
        PG8_STAGE(PG8_SB(0, 0), cB, voffB); PG8_STAGE(PG8_SB(0, 1), cB + hstep, voffB); PG8_STAGE(PG8_SA(0, 0), cA, voffA); PG8_STAGE(PG8_SA(0, 1), cA + hstep, voffA);
        if (wr == 1) PG8_BAR;
        PG8_WAIT_V(2); PG8_BAR;
        PG8_STAGE(PG8_SB(1, 0), cB + kstep, voffB); PG8_STAGE(PG8_SA(1, 0), cA + kstep, voffA); PG8_STAGE(PG8_SB(1, 1), cB + hstep + kstep, voffB);
        PG8_WAIT_V(6); PG8_BAR;
    } else {
        PG8_STAGE(PG8_SB(0, 0), cB, voffB); PG8_STAGE(PG8_SA(0, 0), cA, voffA); PG8_STAGE(PG8_SB(0, 1), cB + hstep, voffB); PG8_STAGE(PG8_SA(0, 1), cA + hstep, voffA);
        if (wr == 1) PG8_BAR;
        PG8_WAIT_V(4); PG8_BAR;
        PG8_STAGE(PG8_SB(1, 0), cB + kstep, voffB); PG8_STAGE(PG8_SA(1, 0), cA + kstep, voffA); PG8_STAGE(PG8_SB(1, 1), cB + hstep + kstep, voffB);
        PG8_WAIT_V(6); PG8_BAR;
    }
    for (;;) {
        const bool has_next = S.next(ui + 1, nxt);
        const char* nA = has_next ? (const char*)g.A + (size_t)nxt.pm * tstep : cA; const char* nB = has_next ? (const char*)g.Bt + (size_t)nxt.pn * tstep : cB;
        for (int t = 0; t < nt; t += 2) {
            const bool last = (t == nt - 2);
            const char* a1 = cA + (size_t)(t + 1) * kstep;
            const char* a2 = last ? nA : cA + (size_t)(t + 2) * kstep; const char* b2 = last ? nB : cB + (size_t)(t + 2) * kstep;
            const char* a3 = a2 + kstep; const char* b3 = b2 + kstep;
            if (last && has_next) S.a_ready(nxt);
            if constexpr (SP2) {
            PG8_LDB(B0, 0, 0); PG8_LDB(B1, 0, 1); PG8_SCHED; PG8_LDA(At, 0, 0); PG8_STAGE(PG8_SA(1, 1), a1 + hstep, voffA);
            PG8_WAIT_V(8); PG8_WAIT_L(0); PG8_BAR; PG8_MMA(0, 0, At, B0); PG8_MMA(0, 1, At, B1); PG8_BAR; PG8_SCHED;
            PG8_LDA(At, 0, 1); PG8_STAGE(PG8_SB(0, 0), b2, voffB); PG8_STAGE(PG8_SB(0, 1), b2 + hstep, voffB); PG8_STAGE(PG8_SA(0, 0), a2, voffA);
            PG8_WAIT_V(8); PG8_WAIT_L(0); PG8_BAR; PG8_MMA(1, 0, At, B0); PG8_MMA(1, 1, At, B1); PG8_BAR; PG8_SCHED;
            PG8_LDB(B0, 1, 0); PG8_LDB(B1, 1, 1); PG8_SCHED; PG8_LDA(At, 1, 0); PG8_STAGE(PG8_SA(0, 1), a2 + hstep, voffA);
            PG8_WAIT_V(8); PG8_WAIT_L(0); PG8_BAR; PG8_MMA(0, 0, At, B0); PG8_MMA(0, 1, At, B1); PG8_BAR; PG8_SCHED;
            PG8_LDA(At, 1, 1); PG8_STAGE(PG8_SB(1, 0), b3, voffB); PG8_STAGE(PG8_SB(1, 1), b3 + hstep, voffB); PG8_STAGE(PG8_SA(1, 0), a3, voffA);
            PG8_WAIT_V(8); PG8_WAIT_L(0); PG8_BAR; PG8_MMA(1, 0, At, B0); PG8_MMA(1, 1, At, B1); PG8_BAR; PG8_SCHED;
            } else {
            PG8_LDB(B0, 0, 0); PG8_SCHED; PG8_LDA(At, 0, 0); PG8_STAGE(PG8_SA(1, 1), a1 + hstep, voffA);
            PG8_WAIT_L(8); PG8_BAR; PG8_WAIT_L(0); PG8_MMA(0, 0, At, B0); PG8_BAR; PG8_SCHED;
            PG8_LDB(B1, 0, 1); PG8_STAGE(PG8_SB(0, 0), b2, voffB);
            PG8_BAR; PG8_WAIT_L(0); PG8_MMA(0, 1, At, B1); PG8_BAR;
            PG8_LDA(At, 0, 1); PG8_STAGE(PG8_SA(0, 0), a2, voffA);
            PG8_BAR; PG8_WAIT_L(0); PG8_MMA(1, 0, At, B0); PG8_BAR; PG8_SCHED;
            PG8_STAGE(PG8_SB(0, 1), b2 + hstep, voffB);
            PG8_WAIT_V(6); PG8_BAR; PG8_MMA(1, 1, At, B1); PG8_BAR;
            PG8_LDB(B0, 1, 0); PG8_SCHED; PG8_LDA(At, 1, 0); PG8_STAGE(PG8_SA(0, 1), a2 + hstep, voffA);
            PG8_WAIT_L(8); PG8_BAR; PG8_WAIT_L(0); PG8_MMA(0, 0, At, B0); PG8_BAR; PG8_SCHED;
            PG8_LDB(B1, 1, 1); PG8_STAGE(PG8_SB(1, 0), b3, voffB);
            PG8_BAR; PG8_WAIT_L(0); PG8_MMA(0, 1, At, B1); PG8_BAR;
            PG8_LDA(At, 1, 1); PG8_STAGE(PG8_SA(1, 0), a3, voffA);
            PG8_BAR; PG8_WAIT_L(0); PG8_MMA(1, 0, At, B0); PG8_BAR; PG8_SCHED;
            PG8_STAGE(PG8_SB(1, 1), b3 + hstep, voffB);
            PG8_WAIT_V(6); PG8_BAR; PG8_MMA(1, 1, At, B1); PG8_BAR;
            }
        }
        if constexpr (ALIGN_EPI) { if (wr == 0) PG8_BAR; }
        if constexpr (!Epi::AFTER_DRAIN) { E(acc, cur, wr, wc, fr, fq); S.done(cur); }
        if (!has_next) break;
#pragma unroll
        for (int a = 0; a < 2; ++a)
#pragma unroll
            for (int b = 0; b < 2; ++b)
#pragma unroll
                for (int m = 0; m < 4; ++m)
#pragma unroll
                    for (int n = 0; n < 2; ++n) acc[a][b][m][n] = (f32x4){0.f, 0.f, 0.f, 0.f};
        cur = nxt; cA = nA; cB = nB; ++ui;
        if constexpr (ALIGN_EPI) { if (wr == 1) PG8_BAR; }
    }
    PG8_WAIT_V(0);
    if constexpr (!ALIGN_EPI) { if (wr == 0) PG8_BAR; }
    PG8_BAR;
    if constexpr (Epi::AFTER_DRAIN) { E.fused(acc, cur, wr, wc, fr, fq, lds, wid, lane); S.done(cur); }
#undef PG8_SA
#undef PG8_SB
#undef PG8_STAGE
#undef PG8_LDA
#undef PG8_LDB
#undef PG8_MMA
#undef PG8_WAIT_V
#undef PG8_WAIT_L
#undef PG8_BAR
#undef PG8_SCHED
}
}
namespace pg8 {
typedef unsigned u32x4e __attribute__((ext_vector_type(4)));
template <int MODE> struct EpiScale {
    static constexpr bool PERM = true, AFTER_DRAIN = false;
    bf16_t* O; int ldc; const float* rss; float cs; const float* rope;
    __device__ __forceinline__ void operator()(const f32x4 (&acc)[2][2][4][2], const Unit& u, int wr, int wc, int fr, int fq) const {
        const int row0 = u.pm * BM + wr * 64 + fr, col0 = u.pn * BM + wc * 32 + 8 * fq;
        const bool ropew = (MODE == 1) && (u.pn < 4) && ((wc & 1) == 0);
#pragma unroll
        for (int ai = 0; ai < 2; ++ai)
#pragma unroll
            for (int m = 0; m < 4; ++m) {
                const int row = row0 + ai * HALF + m * 16;
                float rs = 1.f;
                if (MODE != 0) { const f32x4 q0 = *((const f32x4*)(rss + (size_t)row * 16) + fq);
                    float sq = (q0[0] + q0[1]) + (q0[2] + q0[3]); sq += __shfl_xor(sq, 16); sq += __shfl_xor(sq, 32);
                    rs = rsqrtf(sq * (1.f / 1024.f) + 1e-6f); }
                if (MODE == 2) rs *= cs;
                f32x4 cv0 = {1.f, 1.f, 1.f, 1.f}, cv1 = cv0, sv0 = {0.f, 0.f, 0.f, 0.f}, sv1 = sv0;
                if (ropew) { const float* rp = rope + (size_t)row * 16; cv0 = *(const f32x4*)rp; cv1 = *(const f32x4*)(rp + 4); sv0 = *(const f32x4*)(rp + 8); sv1 = *(const f32x4*)(rp + 12); }
#pragma unroll
                for (int bj = 0; bj < 2; ++bj) {
                    f32x4 v0 = acc[ai][bj][m][0] * rs, v1 = acc[ai][bj][m][1] * rs;
                    if (MODE == 1) {
                        if (ropew) {
                            f32x4 o0, o1;
#pragma unroll
                            for (int j = 0; j < 4; ++j) { o0[j] = __shfl_xor(v0[j], 16); o1[j] = __shfl_xor(v1[j], 16); }
                            if (fq == 0) { v0 = v0 * cv0 - o0 * sv0; v1 = v1 * cv1 - o1 * sv1; }
                            else if (fq == 1) { v0 = v0 * cv0 + o0 * sv0; v1 = v1 * cv1 + o1 * sv1; }
                        }
                        if (u.pn < 2) { v0 = v0 * cs; v1 = v1 * cs; }
                    }
                    if (MODE == 3) {
#pragma unroll
                        for (int j = 0; j < 4; ++j) { const float a = fmaxf(v0[j], 0.f), b = fmaxf(v1[j], 0.f); v0[j] = a * a; v1[j] = b * b; }
                    }
                    u32x4e w; w.x = cvt_pk_bf16(v0[0], v0[1]); w.y = cvt_pk_bf16(v0[2], v0[3]); w.z = cvt_pk_bf16(v1[0], v1[1]); w.w = cvt_pk_bf16(v1[2], v1[3]);
                    *(u32x4e*)(O + (size_t)row * ldc + col0 + bj * HALF) = w;
                }
            }
    }
};
template <bool F32BASE> struct EpiRes {
    static constexpr bool PERM = true, AFTER_DRAIN = false;
    const float* basef; bf16_t* xb; float* rss;
    __device__ __forceinline__ void operator()(const f32x4 (&acc)[2][2][4][2], const Unit& u, int wr, int wc, int fr, int fq) const {
        const int row0 = u.pm * BM + wr * 64 + fr, col0 = u.pn * BM + wc * 32 + 8 * fq;
#pragma unroll
        for (int ai = 0; ai < 2; ++ai)
#pragma unroll
            for (int m = 0; m < 4; ++m) {
                const int row = row0 + ai * HALF + m * 16; float ss = 0.f;
#pragma unroll
                for (int bj = 0; bj < 2; ++bj) {
                    const size_t off = (size_t)row * 1024 + col0 + bj * HALF;
                    f32x4 b0, b1;
                    if (F32BASE) { b0 = *(const f32x4*)(basef + off); b1 = *(const f32x4*)(basef + off + 4); }
                    else { const u32x4e q = *(const u32x4e*)(xb + off);
                        b0 = (f32x4){__uint_as_float(q.x << 16), __uint_as_float(q.x & 0xffff0000u), __uint_as_float(q.y << 16), __uint_as_float(q.y & 0xffff0000u)};
                        b1 = (f32x4){__uint_as_float(q.z << 16), __uint_as_float(q.z & 0xffff0000u), __uint_as_float(q.w << 16), __uint_as_float(q.w & 0xffff0000u)}; }
                    const f32x4 v0 = acc[ai][bj][m][0] + b0, v1 = acc[ai][bj][m][1] + b1;
                    u32x4e w; w.x = cvt_pk_bf16(v0[0], v0[1]); w.y = cvt_pk_bf16(v0[2], v0[3]); w.z = cvt_pk_bf16(v1[0], v1[1]); w.w = cvt_pk_bf16(v1[2], v1[3]);
                    *(u32x4e*)(xb + off) = w;
                    ss += (v0[0] * v0[0] + v0[1] * v0[1]) + (v0[2] * v0[2] + v0[3] * v0[3]) + (v1[0] * v1[0] + v1[1] * v1[1]) + (v1[2] * v1[2] + v1[3] * v1[3]);
                }
                ss += __shfl_xor(ss, 16); ss += __shfl_xor(ss, 32);
                if (fq == 0) rss[(size_t)row * 16 + u.pn * 4 + wc] = ss;
            }
    }
};
}
namespace fa {
typedef unsigned short bf16_t;
using bf16x8 = __attribute__((ext_vector_type(8))) short;
using s16x4  = __attribute__((ext_vector_type(4))) short;
using f32x16 = __attribute__((ext_vector_type(16))) float;
using u32x4  = __attribute__((ext_vector_type(4))) unsigned;
#define FA_SBAR() __builtin_amdgcn_sched_barrier(0)
__device__ __forceinline__ int crow(int r, int hi) { return (r & 3) + 8 * (r >> 2) + 4 * hi; }
__device__ __forceinline__ unsigned cvtpk(float lo, float hi) { unsigned r; asm volatile("v_cvt_pk_bf16_f32 %0, %1, %2" : "=v"(r) : "v"(lo), "v"(hi)); return r; }
__device__ __forceinline__ int v_st(int k, int c) { const int kk = (k & ~0xC) | ((k & 4) << 1) | ((k & 8) >> 1); return ((kk >> 3) * 4 + (c >> 5)) * 512 + ((kk & 7) * 32 + (c & 31)) * 2; }
__device__ __forceinline__ int v_rd_base(int lane) { return ((lane & 3) << 3) | (((lane >> 2) & 3) << 6) | (((lane >> 4) & 1) << 5) | (((lane >> 5) & 1) << 8); }
constexpr int v_rd_off(int d0, int ks, int half) { return d0 * 512 + ks * 4096 + half * 2048; }
template <int OFF> __device__ __forceinline__ s16x4 tr_read(int vb) { s16x4 r; asm volatile("ds_read_b64_tr_b16 %0, %1 offset:%2" : "=&v"(r) : "v"(vb), "i"(OFF) : "memory"); return r; }
template <int D0> __device__ __forceinline__ void pv_one(f32x16& od, int vb, bf16x8 pa0, bf16x8 pa1, bf16x8 pa2, bf16x8 pa3) {
  const s16x4 l0 = tr_read<v_rd_off(D0, 0, 0)>(vb), h0 = tr_read<v_rd_off(D0, 0, 1)>(vb), l1 = tr_read<v_rd_off(D0, 1, 0)>(vb), h1 = tr_read<v_rd_off(D0, 1, 1)>(vb);
  const s16x4 l2 = tr_read<v_rd_off(D0, 2, 0)>(vb), h2 = tr_read<v_rd_off(D0, 2, 1)>(vb), l3 = tr_read<v_rd_off(D0, 3, 0)>(vb), h3 = tr_read<v_rd_off(D0, 3, 1)>(vb);
  asm volatile("s_waitcnt lgkmcnt(0)" ::: "memory"); FA_SBAR();
#define FA_PK(L, H) (bf16x8){L[0], L[1], L[2], L[3], H[0], H[1], H[2], H[3]}
  od = __builtin_amdgcn_mfma_f32_32x32x16_bf16(pa0, FA_PK(l0, h0), od, 0, 0, 0);
  od = __builtin_amdgcn_mfma_f32_32x32x16_bf16(pa1, FA_PK(l1, h1), od, 0, 0, 0);
  od = __builtin_amdgcn_mfma_f32_32x32x16_bf16(pa2, FA_PK(l2, h2), od, 0, 0, 0);
  od = __builtin_amdgcn_mfma_f32_32x32x16_bf16(pa3, FA_PK(l3, h3), od, 0, 0, 0);
#undef FA_PK
}
__device__ __forceinline__ void pv_d0(f32x16* o, int vb, bf16x8 pa0, bf16x8 pa1, bf16x8 pa2, bf16x8 pa3) {
  pv_one<0>(o[0], vb, pa0, pa1, pa2, pa3); pv_one<1>(o[1], vb, pa0, pa1, pa2, pa3); pv_one<2>(o[2], vb, pa0, pa1, pa2, pa3); pv_one<3>(o[3], vb, pa0, pa1, pa2, pa3);
}
template <int DQK, bool QREG> __device__ __forceinline__ void qkt(f32x16& p0, f32x16& p1, const char* Ks, const bf16x8* qr, const bf16_t* qsrc, int r32, int hi) {
  constexpr int KROWB = DQK * 2;
  p0 = f32x16{}; p1 = f32x16{};
  if constexpr (QREG) {
#pragma unroll
    for (int d0 = 0; d0 < DQK / 16; ++d0) { const int cb = (d0 * 16 + hi * 8) * 2;
      const int sw = (DQK == 64) ? (((r32 >> 1) & 7) << 4) : ((r32 & 7) << 4);
      const bf16x8 b0 = *reinterpret_cast<const bf16x8*>(Ks + r32 * KROWB + (cb ^ sw));
      const bf16x8 b1 = *reinterpret_cast<const bf16x8*>(Ks + (32 + r32) * KROWB + (cb ^ sw));
      p0 = __builtin_amdgcn_mfma_f32_32x32x16_bf16(b0, qr[d0], p0, 0, 0, 0);
      p1 = __builtin_amdgcn_mfma_f32_32x32x16_bf16(b1, qr[d0], p1, 0, 0, 0); }
  } else {
    typedef __attribute__((address_space(1))) const bf16x8 gq_t;
#pragma unroll
    for (int g = 0; g < DQK / 128; ++g) { bf16x8 qv[8];
#pragma unroll
      for (int i = 0; i < 8; ++i) qv[i] = *(gq_t*)(qsrc + (g * 8 + i) * 16);
#pragma unroll
      for (int i = 0; i < 8; ++i) { const int d0 = g * 8 + i, cb = (d0 * 16 + hi * 8) * 2;
        const bf16x8 b0 = *reinterpret_cast<const bf16x8*>(Ks + r32 * KROWB + (cb ^ ((r32 & 7) << 4)));
        const bf16x8 b1 = *reinterpret_cast<const bf16x8*>(Ks + (32 + r32) * KROWB + (cb ^ ((r32 & 7) << 4)));
        p0 = __builtin_amdgcn_mfma_f32_32x32x16_bf16(b0, qv[i], p0, 0, 0, 0);
        p1 = __builtin_amdgcn_mfma_f32_32x32x16_bf16(b1, qv[i], p1, 0, 0, 0); } }
  }
}
__device__ __forceinline__ void softmax_tile(f32x16& p0, f32x16& p1, float& m_reg, float& l_reg, float& alpha, bf16x8& pa0, bf16x8& pa1, bf16x8& pa2, bf16x8& pa3) {
  float pmax = p0[0];
#pragma unroll
  for (int r = 1; r < 16; ++r) pmax = fmaxf(pmax, p0[r]);
#pragma unroll
  for (int r = 0; r < 16; ++r) pmax = fmaxf(pmax, p1[r]);
  { auto rr = __builtin_amdgcn_permlane32_swap(__float_as_uint(pmax), __float_as_uint(pmax), false, false); pmax = fmaxf(__uint_as_float(rr[0]), __uint_as_float(rr[1])); }
  if (__builtin_expect(__all(pmax - m_reg <= 8.f), 1)) { alpha = 1.f; }
  else { const float mn = fmaxf(m_reg, pmax); alpha = __builtin_amdgcn_exp2f(m_reg - mn); m_reg = mn; }
  const float mneg = -m_reg;
#pragma unroll
  for (int r = 0; r < 16; ++r) { p0[r] = __builtin_amdgcn_exp2f(p0[r] + mneg); p1[r] = __builtin_amdgcn_exp2f(p1[r] + mneg); }
  float ps = 0.f;
#pragma unroll
  for (int r = 0; r < 16; ++r) ps += p0[r];
#pragma unroll
  for (int r = 0; r < 16; ++r) ps += p1[r];
  { auto rr = __builtin_amdgcn_permlane32_swap(__float_as_uint(ps), __float_as_uint(ps), false, false); ps = __uint_as_float(rr[0]) + __uint_as_float(rr[1]); }
  l_reg = l_reg * alpha + ps;
#define FA_PK4(P, BASE, OUT) do { unsigned a0 = cvtpk(P[BASE + 0], P[BASE + 1]), a1 = cvtpk(P[BASE + 2], P[BASE + 3]);   \
    unsigned b0 = cvtpk(P[BASE + 4], P[BASE + 5]), b1 = cvtpk(P[BASE + 6], P[BASE + 7]);                              \
    auto r0 = __builtin_amdgcn_permlane32_swap(a0, b0, false, false); auto r1 = __builtin_amdgcn_permlane32_swap(a1, b1, false, false); \
    u32x4 w = {r0[0], r1[0], r0[1], r1[1]}; OUT = *reinterpret_cast<bf16x8*>(&w); } while (0)
  FA_PK4(p0, 0, pa0); FA_PK4(p0, 8, pa1); FA_PK4(p1, 0, pa2); FA_PK4(p1, 8, pa3);
#undef FA_PK4
}
template <int DQK>
__device__ __forceinline__ void flash_unit(const bf16_t* __restrict__ Qb, int ldq, const bf16_t* __restrict__ Kh, int ldk,
                                           const bf16_t* __restrict__ Vh, int ldv, bf16_t* __restrict__ Ob, int ldo, int nkeys, char* lds) {
  constexpr int KROWB = DQK * 2, SHM_K = 64 * KROWB, SHM_V = 16384, ND = DQK / 16, NKL = DQK / 64, CPR = DQK / 8;
  const int tid = opaque_tid(), wid = tid >> 6, lane = tid & 63, r32 = lane & 31, hi = lane >> 5;
  char* V_lds = lds; char* K_lds = lds + 2 * SHM_V;
  float* ws = (float*)(lds + 2 * SHM_V + 2 * SHM_K) + wid * 64; float* li_l = ws; float* al_l = ws + 32;
  constexpr bool QREG = (DQK <= 64);
  float m_reg = -1e30f, l_reg = 0.f; f32x16 o[4] = {}; bf16x8 qr[QREG ? ND : 1];
  const bf16_t* Qw = Qb + (long)(wid * 32 + r32) * ldq + hi * 8;
#pragma unroll
  for (int d0 = 0; d0 < (QREG ? ND : 1); ++d0) qr[d0] = *reinterpret_cast<const bf16x8*>(Qw + d0 * 16);
  const int vr = tid >> 4, vc = (tid & 15) * 8, vst0 = v_st(vr, vc), vst1 = v_st(32 + vr, vc);
  const int vb0 = (int)(uintptr_t)V_lds + v_rd_base(lane);
  bf16x8 vs0, vs1, ksg[NKL];
#define FA_SLOAD(k0) do { vs0 = *reinterpret_cast<const bf16x8*>(Vh + (long)((k0) + vr) * ldv + vc); vs1 = *reinterpret_cast<const bf16x8*>(Vh + (long)((k0) + 32 + vr) * ldv + vc); \
    _Pragma("unroll") for (int i_ = 0; i_ < NKL; ++i_) { const int q_ = tid + 512 * i_, row_ = q_ / CPR, ch_ = q_ % CPR; ksg[i_] = *reinterpret_cast<const bf16x8*>(Kh + (long)((k0) + row_) * ldk + ch_ * 8); } } while (0)
#define FA_SWRITE(b) do { *(bf16x8*)(V_lds + (b) * SHM_V + vst0) = vs0; *(bf16x8*)(V_lds + (b) * SHM_V + vst1) = vs1; \
    _Pragma("unroll") for (int i_ = 0; i_ < NKL; ++i_) { const int q_ = tid + 512 * i_, row_ = q_ / CPR, ch_ = q_ % CPR; \
      *(bf16x8*)(K_lds + (b) * SHM_K + row_ * KROWB + ((ch_ * 16) ^ ((DQK == 64 ? ((row_ >> 1) & 7) : (row_ & 7)) << 4))) = ksg[i_]; } } while (0)
#define FA_RESC(a) do { if (__any((a) < 1.f)) { if (hi == 0) al_l[r32] = (a); asm volatile("s_waitcnt lgkmcnt(0)" ::: "memory"); \
    _Pragma("unroll") for (int d_ = 0; d_ < 4; ++d_) _Pragma("unroll") for (int r_ = 0; r_ < 16; ++r_) o[d_][r_] *= al_l[crow(r_, hi)]; } } while (0)
#define FA_TILE(b) do { f32x16 p0, p1; float alpha; bf16x8 pa0, pa1, pa2, pa3; \
    const bf16_t* qs_ = Qw; asm volatile("" : "+v"(qs_)); qkt<DQK, QREG>(p0, p1, K_lds + (b) * SHM_K, qr, qs_, r32, hi); softmax_tile(p0, p1, m_reg, l_reg, alpha, pa0, pa1, pa2, pa3); FA_RESC(alpha); \
    pv_d0(o, vb0 + (b) * SHM_V, pa0, pa1, pa2, pa3); } while (0)
  const int NT = nkeys / 64;
  FA_SLOAD(0); FA_SWRITE(0); __syncthreads();
  for (int j = 0; j < NT; j += 2) {
    FA_SLOAD((j + 1) * 64);
    FA_TILE(0);
    FA_SWRITE(1); __syncthreads();
    if (j + 2 < NT) FA_SLOAD((j + 2) * 64);
    FA_TILE(1);
    if (j + 2 < NT) FA_SWRITE(0);
    __syncthreads();
  }
  if (hi == 0) li_l[r32] = l_reg; asm volatile("s_waitcnt lgkmcnt(0)" ::: "memory");
  float rli[16];
#pragma unroll
  for (int r = 0; r < 16; ++r) rli[r] = __builtin_amdgcn_rcpf(li_l[crow(r, hi)]);
  bf16_t* Ow = Ob + (long)(wid * 32) * ldo;
#pragma unroll
  for (int r = 0; r < 16; ++r) { const int orow = crow(r, hi);
#pragma unroll
    for (int d0 = 0; d0 < 4; ++d0) { const float v = o[d0][r] * rli[r]; Ow[(long)orow * ldo + d0 * 32 + r32] = (bf16_t)(cvtpk(v, v) & 0xffffu); } }
  __syncthreads();
#undef FA_SLOAD
#undef FA_SWRITE
#undef FA_RESC
#undef FA_TILE
}

__device__ __forceinline__ void partialSM(f32x16& p0, f32x16& p1, float& m_reg, float& alpha) {
  float pmax = p0[0];
#pragma unroll
  for (int r = 1; r < 16; ++r) pmax = fmaxf(pmax, p0[r]);
#pragma unroll
  for (int r = 0; r < 16; ++r) pmax = fmaxf(pmax, p1[r]);
  { auto rr = __builtin_amdgcn_permlane32_swap(__float_as_uint(pmax), __float_as_uint(pmax), false, false); pmax = fmaxf(__uint_as_float(rr[0]), __uint_as_float(rr[1])); }
  if (__builtin_expect(__all(pmax - m_reg <= 8.f), 1)) { alpha = 1.f; }
  else { const float mn = fmaxf(m_reg, pmax); alpha = __builtin_amdgcn_exp2f(m_reg - mn); m_reg = mn; }
  const float mneg = -m_reg;
#pragma unroll
  for (int r = 0; r < 16; ++r) { p0[r] += mneg; p1[r] += mneg; }
#pragma unroll
  for (int r = 0; r < 16; ++r) p0[r] = __builtin_amdgcn_exp2f(p0[r]);
}
__device__ __forceinline__ void finishSM(f32x16& p0, f32x16& p1, float alpha, float& l_reg, bf16x8& pa0, bf16x8& pa1, bf16x8& pa2, bf16x8& pa3) {
#pragma unroll
  for (int r = 0; r < 16; ++r) p1[r] = __builtin_amdgcn_exp2f(p1[r]);
  float ps = 0.f;
#pragma unroll
  for (int r = 0; r < 16; ++r) ps += p0[r];
#pragma unroll
  for (int r = 0; r < 16; ++r) ps += p1[r];
  { auto rr = __builtin_amdgcn_permlane32_swap(__float_as_uint(ps), __float_as_uint(ps), false, false); ps = __uint_as_float(rr[0]) + __uint_as_float(rr[1]); }
  l_reg = l_reg * alpha + ps;
#define FA_PK4(P, BASE, OUT) do { unsigned a0 = cvtpk(P[BASE + 0], P[BASE + 1]), a1 = cvtpk(P[BASE + 2], P[BASE + 3]);   \
    unsigned b0 = cvtpk(P[BASE + 4], P[BASE + 5]), b1 = cvtpk(P[BASE + 6], P[BASE + 7]);                              \
    auto r0 = __builtin_amdgcn_permlane32_swap(a0, b0, false, false); auto r1 = __builtin_amdgcn_permlane32_swap(a1, b1, false, false); \
    u32x4 w = {r0[0], r1[0], r0[1], r1[1]}; OUT = *reinterpret_cast<bf16x8*>(&w); } while (0)
  FA_PK4(p0, 0, pa0); FA_PK4(p0, 8, pa1); FA_PK4(p1, 0, pa2); FA_PK4(p1, 8, pa3);
#undef FA_PK4
}
__device__ __forceinline__ void flash_unit64(const bf16_t* __restrict__ Qb, int ldq, const bf16_t* __restrict__ Kh, int ldk,
                                             const bf16_t* __restrict__ Vh, int ldv, bf16_t* __restrict__ Ob, int ldo, int nkeys, char* lds) {
  constexpr int DQK = 64, KROWB = 128, SHM_K = 8192, SHM_V = 16384;
  const int tid = opaque_tid(), wid = tid >> 6, lane = tid & 63, r32 = lane & 31, hi = lane >> 5;
  char* V_lds = lds; char* K_lds = lds + 2 * SHM_V;
  float* ws = (float*)(lds + 2 * SHM_V + 2 * SHM_K) + wid * 64; float* li_l = ws; float* al_l = ws + 32;
  float m_reg = -1e30f, l_reg = 0.f; f32x16 o[4] = {}; bf16x8 qr[4];
  const bf16_t* Qw = Qb + (long)(wid * 32 + r32) * ldq + hi * 8;
#pragma unroll
  for (int d0 = 0; d0 < 4; ++d0) qr[d0] = *reinterpret_cast<const bf16x8*>(Qw + d0 * 16);
  const int vr = tid >> 4, vc = (tid & 15) * 8, vst0 = v_st(vr, vc), vst1 = v_st(32 + vr, vc);
  const int kr = tid >> 3, kc = tid & 7, kst = kr * KROWB + ((kc * 16) ^ (((kr >> 1) & 7) << 4));
  const int vb0 = (int)(uintptr_t)V_lds + v_rd_base(lane);
  bf16x8 vsA0, vsA1, ksA, vsB0, vsB1, ksB;
#define F2_SLOAD(S, k0) do { vs##S##0 = *reinterpret_cast<const bf16x8*>(Vh + (long)((k0) + vr) * ldv + vc); vs##S##1 = *reinterpret_cast<const bf16x8*>(Vh + (long)((k0) + 32 + vr) * ldv + vc); \
    ks##S = *reinterpret_cast<const bf16x8*>(Kh + (long)((k0) + kr) * ldk + kc * 8); } while (0)
#define F2_SWRITE(b, S) do { *(bf16x8*)(V_lds + (b) * SHM_V + vst0) = vs##S##0; *(bf16x8*)(V_lds + (b) * SHM_V + vst1) = vs##S##1; *(bf16x8*)(K_lds + (b) * SHM_K + kst) = ks##S; } while (0)
#define F2_RESC(a) do { if (__any((a) < 1.f)) { if (hi == 0) al_l[r32] = (a); asm volatile("s_waitcnt lgkmcnt(0)" ::: "memory"); \
    _Pragma("unroll") for (int d_ = 0; d_ < 4; ++d_) _Pragma("unroll") for (int r_ = 0; r_ < 16; ++r_) o[d_][r_] *= al_l[crow(r_, hi)]; } } while (0)
  f32x16 pA0, pA1, pB0, pB1; float alA, alB; bf16x8 pa0, pa1, pa2, pa3; const int NT = nkeys / 64;
  F2_SLOAD(A, 0); F2_SWRITE(0, A); __syncthreads();
  qkt<DQK, true>(pA0, pA1, K_lds, qr, nullptr, r32, hi); partialSM(pA0, pA1, m_reg, alA);
  F2_SLOAD(B, 64); if (2 < NT) F2_SLOAD(A, 128);
  F2_SWRITE(1, B); __syncthreads();
  for (int j = 1; j + 1 < NT; j += 2) {
    FA_SBAR(); qkt<DQK, true>(pB0, pB1, K_lds + SHM_K, qr, nullptr, r32, hi);
    finishSM(pA0, pA1, alA, l_reg, pa0, pa1, pa2, pa3); FA_SBAR();
    F2_SLOAD(B, (j + 2) * 64); FA_SBAR();
    pv_d0(o, vb0, pa0, pa1, pa2, pa3); partialSM(pB0, pB1, m_reg, alB);
    __syncthreads(); F2_SWRITE(0, A);
    F2_RESC(alB); __syncthreads();
    FA_SBAR(); qkt<DQK, true>(pA0, pA1, K_lds, qr, nullptr, r32, hi);
    finishSM(pB0, pB1, alB, l_reg, pa0, pa1, pa2, pa3); FA_SBAR();
    if (j + 3 < NT) F2_SLOAD(A, (j + 3) * 64);
    FA_SBAR();
    pv_d0(o, vb0 + SHM_V, pa0, pa1, pa2, pa3); partialSM(pA0, pA1, m_reg, alA);
    __syncthreads(); F2_SWRITE(1, B);
    F2_RESC(alA); __syncthreads();
  }
  FA_SBAR(); qkt<DQK, true>(pB0, pB1, K_lds + SHM_K, qr, nullptr, r32, hi);
  finishSM(pA0, pA1, alA, l_reg, pa0, pa1, pa2, pa3); FA_SBAR();
  pv_d0(o, vb0, pa0, pa1, pa2, pa3); partialSM(pB0, pB1, m_reg, alB);
  __syncthreads(); F2_RESC(alB);
  finishSM(pB0, pB1, alB, l_reg, pa0, pa1, pa2, pa3); FA_SBAR();
  pv_d0(o, vb0 + SHM_V, pa0, pa1, pa2, pa3);
  if (hi == 0) li_l[r32] = l_reg; asm volatile("s_waitcnt lgkmcnt(0)" ::: "memory");
  float rli[16];
#pragma unroll
  for (int r = 0; r < 16; ++r) rli[r] = __builtin_amdgcn_rcpf(li_l[crow(r, hi)]);
  bf16_t* Ow = Ob + (long)(wid * 32) * ldo;
#pragma unroll
  for (int r = 0; r < 16; ++r) { const int orow = crow(r, hi);
#pragma unroll
    for (int d0 = 0; d0 < 4; ++d0) { const float v = o[d0][r] * rli[r]; Ow[(long)orow * ldo + d0 * 32 + r32] = (bf16_t)(cvtpk(v, v) & 0xffffu); } }
  __syncthreads();
#undef F2_SLOAD
#undef F2_SWRITE
#undef F2_RESC
}

__device__ __forceinline__ void xattn_unit(const bf16_t* __restrict__ Qb, const bf16_t* __restrict__ Kh, const bf16_t* __restrict__ Vh, bf16_t* __restrict__ Ob, char* lds) {
  const int tid = opaque_tid(), wid = __builtin_amdgcn_readfirstlane(tid >> 6), lane = tid & 63, r32 = lane & 31, hi = lane >> 5;
  float* li_l = (float*)(lds + 131072 + 256) + wid * 32;
  { bf16x8 st[16];
#pragma unroll
    for (int i = 0; i < 16; ++i) { const int q = tid + 512 * i, row = q >> 5, ch = q & 31; st[i] = *reinterpret_cast<const bf16x8*>(Kh + (long)row * 2048 + ch * 8); }
#pragma unroll
    for (int i = 0; i < 16; ++i) { const int q = tid + 512 * i, row = q >> 5, ch = q & 31; *(bf16x8*)(lds + row * 512 + ((ch * 16) ^ ((row & 15) << 4))) = st[i]; } }
  __syncthreads();
  f32x16 S[8];
#pragma unroll
  for (int kb = 0; kb < 8; ++kb) S[kb] = f32x16{};
  const bf16_t* Qw = Qb + (long)(wid * 32 + r32) * 1024 + hi * 8;
#pragma unroll
  for (int g = 0; g < 2; ++g) { bf16x8 qv[8];
#pragma unroll
    for (int i = 0; i < 8; ++i) qv[i] = *reinterpret_cast<const bf16x8*>(Qw + (g * 8 + i) * 16);
#pragma unroll
    for (int i = 0; i < 8; ++i) { const int cb = ((g * 8 + i) * 16 + hi * 8) * 2;
#pragma unroll
      for (int kb = 0; kb < 8; ++kb) { const bf16x8 kf = *reinterpret_cast<const bf16x8*>(lds + (kb * 32 + r32) * 512 + (cb ^ ((r32 & 15) << 4)));
        S[kb] = __builtin_amdgcn_mfma_f32_32x32x16_bf16(kf, qv[i], S[kb], 0, 0, 0); } } }
  float m = S[0][0];
#pragma unroll
  for (int kb = 0; kb < 8; ++kb)
#pragma unroll
    for (int r = 0; r < 16; ++r) m = fmaxf(m, S[kb][r]);
  { auto rr = __builtin_amdgcn_permlane32_swap(__float_as_uint(m), __float_as_uint(m), false, false); m = fmaxf(__uint_as_float(rr[0]), __uint_as_float(rr[1])); }
  float l = 0.f;
#pragma unroll
  for (int kb = 0; kb < 8; ++kb)
#pragma unroll
    for (int r = 0; r < 16; ++r) { S[kb][r] = __builtin_amdgcn_exp2f(S[kb][r] - m); l += S[kb][r]; }
  { auto rr = __builtin_amdgcn_permlane32_swap(__float_as_uint(l), __float_as_uint(l), false, false); l = __uint_as_float(rr[0]) + __uint_as_float(rr[1]); }
  bf16x8 pa[16];
#define XA_PK4(P, BASE, OUT) do { unsigned a0 = cvtpk(P[BASE + 0], P[BASE + 1]), a1 = cvtpk(P[BASE + 2], P[BASE + 3]);   \
    unsigned b0 = cvtpk(P[BASE + 4], P[BASE + 5]), b1 = cvtpk(P[BASE + 6], P[BASE + 7]);                              \
    auto r0 = __builtin_amdgcn_permlane32_swap(a0, b0, false, false); auto r1 = __builtin_amdgcn_permlane32_swap(a1, b1, false, false); \
    u32x4 w = {r0[0], r1[0], r0[1], r1[1]}; OUT = *reinterpret_cast<bf16x8*>(&w); } while (0)
#pragma unroll
  for (int kt = 0; kt < 4; ++kt) { XA_PK4(S[2 * kt], 0, pa[4 * kt]); XA_PK4(S[2 * kt], 8, pa[4 * kt + 1]); XA_PK4(S[2 * kt + 1], 0, pa[4 * kt + 2]); XA_PK4(S[2 * kt + 1], 8, pa[4 * kt + 3]); }
#undef XA_PK4
  { bf16x8 st[16];
#pragma unroll
    for (int i = 0; i < 16; ++i) { const int q = tid + 512 * i, row = q >> 5, c = (q & 31) * 8; st[i] = *reinterpret_cast<const bf16x8*>(Vh + (long)row * 2048 + c); }
    __syncthreads();
#pragma unroll
    for (int i = 0; i < 16; ++i) { const int q = tid + 512 * i, row = q >> 5, c = (q & 31) * 8; *(bf16x8*)(lds + ((row >> 6) * 2 + (c >> 7)) * 16384 + v_st(row & 63, c & 127)) = st[i]; } }
  if (hi == 0) li_l[r32] = l;
  __syncthreads();
  float rli[16];
#pragma unroll
  for (int r = 0; r < 16; ++r) rli[r] = __builtin_amdgcn_rcpf(li_l[crow(r, hi)]);
  const int vb0 = (int)(uintptr_t)lds + v_rd_base(lane);
  bf16_t* Ow = Ob + (long)(wid * 32) * 1024;
#pragma unroll
  for (int dvh = 0; dvh < 2; ++dvh) { f32x16 o[4] = {};
#pragma unroll
    for (int kt = 0; kt < 4; ++kt) pv_d0(o, vb0 + (kt * 2 + dvh) * 16384, pa[4 * kt], pa[4 * kt + 1], pa[4 * kt + 2], pa[4 * kt + 3]);
#pragma unroll
    for (int r = 0; r < 16; ++r) { const int orow = crow(r, hi);
#pragma unroll
      for (int d0 = 0; d0 < 4; ++d0) { const float v = o[d0][r] * rli[r]; Ow[(long)orow * 1024 + dvh * 128 + d0 * 32 + r32] = (bf16_t)(cvtpk(v, v) & 0xffffu); } } }
  __syncthreads();
}

__device__ __forceinline__ void flash_unit64c(const bf16_t* __restrict__ Qb, int ldq, const bf16_t* __restrict__ Kh, int ldk,
                                              const bf16_t* __restrict__ Vh, int ldv, bf16_t* __restrict__ Ob, int ldo, int nkeys, char* lds) {
  constexpr int KROWB = 128, SHM_K = 8192, SHM_V = 16384;
  const int tid = opaque_tid(), wid = tid >> 6, lane = tid & 63, r32 = lane & 31, hi = lane >> 5;
  char* V_lds = lds; char* K_lds = lds + 2 * SHM_V;
  float* ws = (float*)(lds + 2 * SHM_V + 2 * SHM_K) + wid * 64; float* li_l = ws; float* al_l = ws + 32;
  float m_run = 0.f, l_reg = 0.f; f32x16 o[4] = {}; bf16x8 qr[4]; f32x16 negm = {};
  const bf16_t* Qw = Qb + (long)(wid * 32 + r32) * ldq + hi * 8;
#pragma unroll
  for (int d0 = 0; d0 < 4; ++d0) qr[d0] = *reinterpret_cast<const bf16x8*>(Qw + d0 * 16);
  const int vr = 2 * (tid >> 5) + ((tid >> 2) & 1), vc = (((tid >> 3) & 3) * 4 + (tid & 3)) * 8, vst0 = v_st(vr, vc), vst1 = v_st(32 + vr, vc);
  const int kr = tid >> 3, kc = tid & 7, kst = kr * KROWB + ((kc * 16) ^ (((kr >> 1) & 7) << 4));
  const int vb0 = (int)(uintptr_t)V_lds + v_rd_base(lane);
  const int ksw = ((r32 >> 1) & 7) << 4;
  bf16x8 vs0, vs1, ks;
#define F4_SLOAD(k0) do { vs0 = *reinterpret_cast<const bf16x8*>(Vh + (long)((k0) + vr) * ldv + vc); vs1 = *reinterpret_cast<const bf16x8*>(Vh + (long)((k0) + 32 + vr) * ldv + vc); \
    ks = *reinterpret_cast<const bf16x8*>(Kh + (long)((k0) + kr) * ldk + kc * 8); } while (0)
#define F4_SWRITE(b) do { *(bf16x8*)(V_lds + (b) * SHM_V + vst0) = vs0; *(bf16x8*)(V_lds + (b) * SHM_V + vst1) = vs1; *(bf16x8*)(K_lds + (b) * SHM_K + kst) = ks; } while (0)
#define F4_PK4(P, BASE, OUT) do { unsigned a0 = cvtpk(P[BASE + 0], P[BASE + 1]), a1 = cvtpk(P[BASE + 2], P[BASE + 3]);   \
    unsigned b0 = cvtpk(P[BASE + 4], P[BASE + 5]), b1 = cvtpk(P[BASE + 6], P[BASE + 7]);                              \
    auto r0 = __builtin_amdgcn_permlane32_swap(a0, b0, false, false); auto r1 = __builtin_amdgcn_permlane32_swap(a1, b1, false, false); \
    u32x4 w = {r0[0], r1[0], r0[1], r1[1]}; OUT = *reinterpret_cast<bf16x8*>(&w); } while (0)
#define F4_TILE(b, FIRST) do { f32x16 p0, p1; bf16x8 pa0, pa1, pa2, pa3; const char* Ks_ = K_lds + (b) * SHM_K; \
    _Pragma("unroll") for (int d0 = 0; d0 < 4; ++d0) { const int cb = (d0 * 16 + hi * 8) * 2; \
      const bf16x8 b0 = *reinterpret_cast<const bf16x8*>(Ks_ + r32 * KROWB + (cb ^ ksw)); const bf16x8 b1 = *reinterpret_cast<const bf16x8*>(Ks_ + (32 + r32) * KROWB + (cb ^ ksw)); \
      if (d0 == 0) { p0 = __builtin_amdgcn_mfma_f32_32x32x16_bf16(b0, qr[0], negm, 0, 0, 0); p1 = __builtin_amdgcn_mfma_f32_32x32x16_bf16(b1, qr[0], negm, 0, 0, 0); } \
      else { p0 = __builtin_amdgcn_mfma_f32_32x32x16_bf16(b0, qr[d0], p0, 0, 0, 0); p1 = __builtin_amdgcn_mfma_f32_32x32x16_bf16(b1, qr[d0], p1, 0, 0, 0); } } \
    float pmax = p0[0]; \
    _Pragma("unroll") for (int r = 1; r < 16; ++r) pmax = fmaxf(pmax, p0[r]); \
    _Pragma("unroll") for (int r = 0; r < 16; ++r) pmax = fmaxf(pmax, p1[r]); \
    { auto rr = __builtin_amdgcn_permlane32_swap(__float_as_uint(pmax), __float_as_uint(pmax), false, false); pmax = fmaxf(__uint_as_float(rr[0]), __uint_as_float(rr[1])); } \
    if ((FIRST) || !__builtin_expect(__all(pmax <= 8.f), 1)) { const float dl = (FIRST) ? pmax : fmaxf(pmax, 0.f); const float alpha = __builtin_amdgcn_exp2f(-dl); m_run += dl; l_reg *= alpha; \
      _Pragma("unroll") for (int r = 0; r < 16; ++r) { p0[r] -= dl; p1[r] -= dl; negm[r] = -m_run; } \
      if (!(FIRST)) { if (hi == 0) al_l[r32] = alpha; asm volatile("s_waitcnt lgkmcnt(0)" ::: "memory"); \
        _Pragma("unroll") for (int d_ = 0; d_ < 4; ++d_) _Pragma("unroll") for (int r_ = 0; r_ < 16; ++r_) o[d_][r_] *= al_l[crow(r_, hi)]; } } \
    _Pragma("unroll") for (int r = 0; r < 16; ++r) { p0[r] = __builtin_amdgcn_exp2f(p0[r]); p1[r] = __builtin_amdgcn_exp2f(p1[r]); } \
    float ps = 0.f; \
    _Pragma("unroll") for (int r = 0; r < 16; ++r) ps += p0[r]; \
    _Pragma("unroll") for (int r = 0; r < 16; ++r) ps += p1[r]; \
    { auto rr = __builtin_amdgcn_permlane32_swap(__float_as_uint(ps), __float_as_uint(ps), false, false); ps = __uint_as_float(rr[0]) + __uint_as_float(rr[1]); } \
    l_reg += ps; \
    F4_PK4(p0, 0, pa0); F4_PK4(p0, 8, pa1); F4_PK4(p1, 0, pa2); F4_PK4(p1, 8, pa3); \
    pv_d0(o, vb0 + (b) * SHM_V, pa0, pa1, pa2, pa3); } while (0)
  const int NT = nkeys / 64;
  F4_SLOAD(0); F4_SWRITE(0); F4_SLOAD(64); F4_SWRITE(1); F4_SLOAD(128); __syncthreads();
  F4_TILE(0, true);
  __syncthreads();
  F4_SWRITE(0); F4_SLOAD(192);
  for (int j = 1; j + 1 < NT; j += 2) {
    F4_TILE(1, false);
    __syncthreads();
    if (j + 2 < NT) { F4_SWRITE(1); if (j + 3 < NT) F4_SLOAD((j + 3) * 64); }
    F4_TILE(0, false);
    __syncthreads();
    if (j + 3 < NT) { F4_SWRITE(0); if (j + 4 < NT) F4_SLOAD((j + 4) * 64); }
  }
  F4_TILE(1, false);
  __syncthreads();
  if (hi == 0) li_l[r32] = l_reg; asm volatile("s_waitcnt lgkmcnt(0)" ::: "memory");
  float rli[16];
#pragma unroll
  for (int r = 0; r < 16; ++r) rli[r] = __builtin_amdgcn_rcpf(li_l[crow(r, hi)]);
  bf16_t* Ow = Ob + (long)(wid * 32) * ldo;
  { bf16_t* stg = (bf16_t*)(lds + 65536) + wid * 4096;
#pragma unroll
    for (int r = 0; r < 16; ++r) { const int orow = crow(r, hi);
#pragma unroll
      for (int d0 = 0; d0 < 4; ++d0) { const float v = o[d0][r] * rli[r]; stg[orow * 128 + d0 * 32 + r32] = (bf16_t)(cvtpk(v, v) & 0xffffu); } }
    asm volatile("s_waitcnt lgkmcnt(0)" ::: "memory");
#pragma unroll
    for (int i = 0; i < 8; ++i) { const int row = i * 4 + (lane >> 4), ch = lane & 15; const u32x4 v = *(const u32x4*)(stg + row * 128 + ch * 8); *(u32x4*)(Ow + (long)row * ldo + ch * 8) = v; } }
  __syncthreads();
#undef F4_SLOAD
#undef F4_SWRITE
#undef F4_PK4
#undef F4_TILE
}
}
typedef unsigned short bf16;
typedef float f32x4 __attribute__((ext_vector_type(4)));
typedef unsigned v4u __attribute__((ext_vector_type(4)));
typedef short bf16x8 __attribute__((ext_vector_type(8)));
typedef float f32x16 __attribute__((ext_vector_type(16)));
#define LAS __attribute__((address_space(3)))
constexpr int BATCH = 8, SEQ = 4096, DM = 1024, T = BATCH * SEQ, DEPTH = 2, NMEM = 256, TM = BATCH * NMEM, INW = 2560, DFF = 4096;
constexpr int NWAVES = 8, NTHR = 512;
constexpr size_t MiB = 1u << 20;
constexpr size_t WS_W = 0, W_LAYER = 32 * MiB;
constexpr size_t WO_IN = 0, WO_OUT = 5 * MiB, WO_Q = 7 * MiB, WO_KV = 9 * MiB, WO_O = 13 * MiB, WO_1 = 15 * MiB, WO_2 = 23 * MiB;
constexpr size_t WS_GATE = 64 * MiB;
constexpr size_t WS_ROPE = 65 * MiB;
constexpr size_t WS_RSS = 67 * MiB;
constexpr size_t WS_MEMN = 68 * MiB;
constexpr size_t WS_KVX = 76 * MiB;
constexpr size_t WS_SUM = 92 * MiB;
constexpr size_t WS_XB = 108 * MiB;
constexpr size_t WS_Z = 172 * MiB, WS_OC = 332 * MiB, WS_MIX = 396 * MiB, WS_CIN = 460 * MiB, WS_RSSP = 464 * MiB, WS_END = 480 * MiB;
constexpr size_t WS_BAR = WS_RSS + 964 * 1024;
constexpr size_t WS_CNT = WS_RSS + 960 * 1024;
constexpr size_t WS_H = WS_Z, WS_QX = WS_Z, WS_OX = WS_Z + 64 * MiB;
constexpr int LDS_BYTES = 147456;
constexpr float LOG2E = 1.4426950408889634f;

__device__ __forceinline__ float bf2f(short v) { return __uint_as_float(((unsigned)(unsigned short)v) << 16); }
__device__ __forceinline__ unsigned f2bf(float f) { unsigned u = __builtin_bit_cast(unsigned, f); return (u + 0x7fffu + ((u >> 16) & 1u)) >> 16; }
__device__ __forceinline__ unsigned pk2(float lo, float hi) { return f2bf(lo) | (f2bf(hi) << 16); }
__device__ __forceinline__ float wave_sum(float v) {
#pragma unroll
    for (int o = 1; o < 64; o <<= 1) v += __shfl_xor(v, o);
    return v;
}
__device__ __forceinline__ float sigm(float x) { return __builtin_amdgcn_rcpf(1.f + __expf(-x)); }
__device__ __forceinline__ float gelu_tanh(float x) { const float y = 0.7978845608028654f * (x + 0.044715f * x * x * x); const float e = __expf(2.f * y); const float th = 1.f - 2.f * __builtin_amdgcn_rcpf(e + 1.f); return 0.5f * x * (1.f + th); }

struct LruArgs { const float* spl; float* CIN; unsigned* CNT; const bf16* Z; const float *conv_w, *conv_b, *b_r, *b_i, *a_param, *norm_g; const bf16* WG; float* SUM; bf16* MIX; const bf16* OC; const float* subln_g; float lam, oml; };
constexpr int CSB = 1040, CFS = 516, CF_OFF = 34816;
__device__ __forceinline__ int crow16(int r, int hi) { return (r & 3) + 8 * (r >> 2) + 4 * hi; }

template <bool REV> __device__ __forceinline__ void lru_scan(f32x16& a, f32x16& u, float cin, float& Atot, float& Htot, int hi) {
    float P[16], As[4], Hs[4];
#pragma unroll
    for (int s = 0; s < 4; ++s) { float h = 0.f, p = 1.f;
#pragma unroll
        for (int q = 0; q < 4; ++q) { const int r = REV ? 4 * s + 3 - q : 4 * s + q; h = a[r] * h + u[r]; p *= a[r]; u[r] = h; P[r] = p; }
        As[s] = p; Hs[s] = h; }
    float pA[4], pH[4];
#pragma unroll
    for (int s = 0; s < 4; ++s) { pA[s] = __shfl_xor(As[s], 32); pH[s] = __shfl_xor(Hs[s], 32); }
    float c = cin, at = 1.f, cm[4] = {0.f, 0.f, 0.f, 0.f};
#pragma unroll
    for (int gg = 0; gg < 8; ++gg) { const int g = REV ? 7 - gg : gg; const int s = g >> 1; const bool own = ((g & 1) == hi);
        const float Ag = own ? As[s] : pA[s], Hg = own ? Hs[s] : pH[s];
        cm[s] = own ? c : cm[s];
        c = Ag * c + Hg; at *= Ag; }
    Atot = at; Htot = c;
#pragma unroll
    for (int r = 0; r < 16; ++r) u[r] = u[r] + P[r] * cm[r >> 2];
}
template <bool REV> __device__ __forceinline__ float lru_carry(const float* sb  , int j) {
    const int n = REV ? 127 - j : j; float c = 0.f;
    for (int k0 = 0; k0 < n; k0 += 8) { float Av[8], Hv[8];
#pragma unroll
        for (int q = 0; q < 8; ++q) { const int k = k0 + q; const bool ok = k < n; const int i = ok ? (REV ? 127 - k : k) : (REV ? 127 : 0);
            const float av = sb[(size_t)i * 2048], hv = sb[(size_t)i * 2048 + 512]; Av[q] = ok ? av : 1.f; Hv[q] = ok ? hv : 0.f; }
#pragma unroll
        for (int q = 0; q < 8; ++q) c = Av[q] * c + Hv[q];
    }
    return c;
}
__device__ __forceinline__ void lru_xload(bf16x8 (&xr)[7], const LruArgs& A, int b, int j, int w, int lane) {
    const int t0 = j * 32 + 4 * w; const long rowb = (long)b * SEQ;
#pragma unroll
    for (int rr = 0; rr < 7; ++rr) { const int t = t0 + rr - 2; const int tc = t < 0 ? 0 : (t >= SEQ ? SEQ - 1 : t);
        const bf16x8 raw = *(const bf16x8*)(A.Z + (rowb + tc) * INW + 1536 + 8 * lane); xr[rr] = (t >= 0 && t < SEQ) ? raw : (bf16x8){0, 0, 0, 0, 0, 0, 0, 0}; }
}
template <bool FINAL> __device__ __forceinline__ void lru_chunk(const LruArgs& A, int b, int j, char* lds, bf16x8 (&xr)[7], int nb_, int nj_, bool publish) {
    const int tid = opaque_tid(), w = __builtin_amdgcn_readfirstlane(tid >> 6), lane = tid & 63, n32 = lane & 31, hi = lane >> 5;
    char* Cs = lds; float* Cf = (float*)(lds + CF_OFF);
    const long rowb = (long)b * SEQ;
    {
        const int tl = 4 * w;
        float xv[7][8];
#pragma unroll
        for (int rr = 0; rr < 7; ++rr) {
#pragma unroll
            for (int e = 0; e < 8; ++e) xv[rr][e] = bf2f(xr[rr][e]); }
        float cw[4][8], cb[8];
#pragma unroll
        for (int jj = 0; jj < 4; ++jj) { const f32x4 a0 = *(const f32x4*)(A.conv_w + jj * 512 + 8 * lane), a1 = *(const f32x4*)(A.conv_w + jj * 512 + 8 * lane + 4);
#pragma unroll
            for (int e = 0; e < 4; ++e) { cw[jj][e] = a0[e]; cw[jj][4 + e] = a1[e]; } }
        { const f32x4 a0 = *(const f32x4*)(A.conv_b + 8 * lane), a1 = *(const f32x4*)(A.conv_b + 8 * lane + 4);
#pragma unroll
            for (int e = 0; e < 4; ++e) { cb[e] = a0[e]; cb[4 + e] = a1[e]; } }
#pragma unroll
        for (int tt = 0; tt < 4; ++tt) { float c[8];
#pragma unroll
            for (int e = 0; e < 8; ++e) c[e] = cb[e] + cw[0][e] * xv[tt][e] + cw[1][e] * xv[tt + 1][e] + cw[2][e] * xv[tt + 2][e] + cw[3][e] * xv[tt + 3][e];
            v4u pk; pk.x = pk2(c[0], c[1]); pk.y = pk2(c[2], c[3]); pk.z = pk2(c[4], c[5]); pk.w = pk2(c[6], c[7]);
            *(v4u*)(Cs + (tl + tt) * CSB + lane * 16) = pk;
            *(f32x4*)(Cf + (tl + tt) * CFS + 8 * lane) = (f32x4){c[0], c[1], c[2], c[3]};
            *(f32x4*)(Cf + (tl + tt) * CFS + 8 * lane + 4) = (f32x4){c[4], c[5], c[6], c[7]}; }
    }
    __syncthreads();
    if (nj_ >= 0) lru_xload(xr, A, nb_, nj_, w, lane);
    bf16x8 gpre[4], o1pre[4], o2pre[4];
    if (FINAL) {
#pragma unroll
        for (int tt = 0; tt < 4; ++tt) { const long grow = rowb + j * 32 + 4 * w + tt;
            gpre[tt] = *(const bf16x8*)(A.Z + grow * INW + 2048 + 8 * lane); o1pre[tt] = *(const bf16x8*)(A.OC + grow * 512 + 8 * lane); o2pre[tt] = *(const bf16x8*)(A.OC + (size_t)T * 512 + grow * 512 + 8 * lane); } }
    bf16x8 af[4];
#pragma unroll
    for (int ks = 0; ks < 4; ++ks) af[ks] = *(const bf16x8*)(Cs + n32 * CSB + (64 * w + 16 * ks + 8 * hi) * 2);
#pragma unroll
    for (int nb = 0; nb < 2; ++nb) {
        const int cl = 32 * nb + n32, ch = 64 * w + cl;
        f32x16 hs = {};
#pragma unroll
        for (int dir = 0; dir < 2; ++dir) {
            const bf16* wg_r = A.WG + ((size_t)((dir * 2 + 0) * 8 + w) * 64 + cl) * 64 + 8 * hi;
            const bf16* wg_i = A.WG + ((size_t)((dir * 2 + 1) * 8 + w) * 64 + cl) * 64 + 8 * hi;
            f32x16 dr = {}, di = {};
#pragma unroll
            for (int ks = 0; ks < 4; ++ks) {
                dr = __builtin_amdgcn_mfma_f32_32x32x16_bf16(af[ks], *(const bf16x8*)(wg_r + 16 * ks), dr, 0, 0, 0);
                di = __builtin_amdgcn_mfma_f32_32x32x16_bf16(af[ks], *(const bf16x8*)(wg_i + 16 * ks), di, 0, 0, 0); }
            const float spl = A.spl[dir * 512 + ch], br = -LOG2E * A.b_r[dir * 512 + ch], bi = -LOG2E * A.b_i[dir * 512 + ch];
#pragma unroll
            for (int r = 0; r < 16; ++r) { const int tok = crow16(r, hi);
                const float rg = __builtin_amdgcn_rcpf(1.f + __builtin_amdgcn_exp2f(dr[r] + br)), ig = __builtin_amdgcn_rcpf(1.f + __builtin_amdgcn_exp2f(di[r] + bi));
                const float a = __builtin_amdgcn_exp2f(rg * spl), mult = __builtin_amdgcn_sqrtf(fmaf(-a, a, 1.f));
                dr[r] = a; di[r] = Cf[tok * CFS + ch] * ig * mult; }
            float cin = 0.f;
            if (FINAL) cin = A.CIN[((size_t)(b * 128 + j) * 2 + dir) * 512 + ch];
            float At, Ht;
            if (dir) lru_scan<true>(dr, di, cin, At, Ht, hi); else lru_scan<false>(dr, di, cin, At, Ht, hi);
            if (!FINAL) { if (hi == 0) { float* sp_ = A.SUM + ((size_t)(b * 128 + j) * 2 + dir) * 1024 + ch;
                __hip_atomic_store(sp_, At, __ATOMIC_RELAXED, __HIP_MEMORY_SCOPE_AGENT); __hip_atomic_store(sp_ + 512, Ht, __ATOMIC_RELAXED, __HIP_MEMORY_SCOPE_AGENT); } }
            else { hs = dir ? hs + di : di; }
        }
        if (FINAL) {
#pragma unroll
            for (int r = 0; r < 16; ++r) Cf[crow16(r, hi) * CFS + ch] = hs[r];
        }
    }
    if (!FINAL && publish) {
        asm volatile("s_waitcnt vmcnt(0)" ::: "memory");
        __syncthreads();
        LAS unsigned* flag = (LAS unsigned*)(lds + 131072 - 16);
        if (tid == 0) { const unsigned old = __hip_atomic_fetch_add(A.CNT + b, 4u, __ATOMIC_RELAXED, __HIP_MEMORY_SCOPE_AGENT); *flag = (old == 124u) ? 1u : 0u; }
        __syncthreads();
        const bool last = (*flag != 0u);
        if (last) {
            __builtin_amdgcn_fence(__ATOMIC_ACQUIRE, "agent");
            const float* sb = A.SUM + (size_t)b * 128 * 2048 + tid;
            float* cb_ = A.CIN + (size_t)b * 128 * 1024 + tid;
            float cf = 0.f, cr = 0.f;
            for (int k0 = 0; k0 < 128; k0 += 32) { float Af[32], Hf[32], Ar[32], Hr[32];
#pragma unroll
                for (int q = 0; q < 32; ++q) { const int jf = k0 + q, jr = 127 - jf;
                    Af[q] = __hip_atomic_load(sb + (size_t)jf * 2048, __ATOMIC_RELAXED, __HIP_MEMORY_SCOPE_AGENT); Hf[q] = __hip_atomic_load(sb + (size_t)jf * 2048 + 512, __ATOMIC_RELAXED, __HIP_MEMORY_SCOPE_AGENT);
                    Ar[q] = __hip_atomic_load(sb + (size_t)jr * 2048 + 1024, __ATOMIC_RELAXED, __HIP_MEMORY_SCOPE_AGENT); Hr[q] = __hip_atomic_load(sb + (size_t)jr * 2048 + 1536, __ATOMIC_RELAXED, __HIP_MEMORY_SCOPE_AGENT); }
#pragma unroll
                for (int q = 0; q < 32; ++q) { const int jf = k0 + q, jr = 127 - jf;
                    cb_[(size_t)jf * 1024] = cf; cf = Af[q] * cf + Hf[q];
                    cb_[(size_t)jr * 1024 + 512] = cr; cr = Ar[q] * cr + Hr[q]; }
            }
        }
    }
    __syncthreads();
    if (FINAL) {
#pragma unroll
        for (int tt = 0; tt < 4; ++tt) { const int tl = 4 * w + tt; const long grow = rowb + j * 32 + tl;
            const f32x4 y0 = *(const f32x4*)(Cf + tl * CFS + 8 * lane), y1 = *(const f32x4*)(Cf + tl * CFS + 8 * lane + 4);
            const bf16x8 g = gpre[tt];
            float y[8]; float ss = 0.f;
#pragma unroll
            for (int e = 0; e < 8; ++e) { const float yv = e < 4 ? y0[e] : y1[e - 4]; y[e] = yv * gelu_tanh(bf2f(g[e])); ss += y[e] * y[e]; }
            ss = wave_sum(ss); const float rs = rsqrtf(ss * (1.f / 512.f) + 1e-6f);
            const f32x4 g0 = *(const f32x4*)(A.norm_g + 8 * lane), g1 = *(const f32x4*)(A.norm_g + 8 * lane + 4);
            v4u pk; pk.x = pk2(y[0] * rs * g0[0], y[1] * rs * g0[1]); pk.y = pk2(y[2] * rs * g0[2], y[3] * rs * g0[3]); pk.z = pk2(y[4] * rs * g1[0], y[5] * rs * g1[1]); pk.w = pk2(y[6] * rs * g1[2], y[7] * rs * g1[3]);
            *(v4u*)(A.MIX + grow * DM + 512 + 8 * lane) = pk;
            const bf16x8 o1 = o1pre[tt], o2 = o2pre[tt];
            float d[8]; float s2 = 0.f;
#pragma unroll
            for (int e = 0; e < 8; ++e) { d[e] = bf2f(o1[e]) - A.lam * bf2f(o2[e]); s2 += d[e] * d[e]; }
            s2 += __shfl_xor(s2, 1); s2 += __shfl_xor(s2, 2); s2 += __shfl_xor(s2, 4); s2 += __shfl_xor(s2, 8);
            const float r2 = rsqrtf(s2 * (1.f / 128.f) + 1e-6f) * A.oml;
            const int gc = (8 * lane) & 127;
            const f32x4 s0 = *(const f32x4*)(A.subln_g + gc), s1 = *(const f32x4*)(A.subln_g + gc + 4);
            v4u pq; pq.x = pk2(d[0] * r2 * s0[0], d[1] * r2 * s0[1]); pq.y = pk2(d[2] * r2 * s0[2], d[3] * r2 * s0[3]); pq.z = pk2(d[4] * r2 * s1[0], d[5] * r2 * s1[1]); pq.w = pk2(d[6] * r2 * s1[2], d[7] * r2 * s1[3]);
            *(v4u*)(A.MIX + grow * DM + 8 * lane) = pq; }
        __syncthreads();
    }
}
#define XB_TMO      128
#define XB_XCNT(j)  (256  + 64 * (j))
#define XB_XSUB(j)  (1280 + 64 * (j))
#define XB_XGEN(j)  (2304 + 64 * (j))
#define XB_TOP      3328
#define XB_TOPGEN   3392
#define XCD_BAR_WORDS 3456
#define XB_SPIN_CAP (1u << 18)

__device__ __forceinline__ unsigned xb_ld(unsigned* p)              { return __hip_atomic_load(p, __ATOMIC_RELAXED, __HIP_MEMORY_SCOPE_AGENT); }
__device__ __forceinline__ unsigned xb_add(unsigned* p, unsigned v) { return __hip_atomic_fetch_add(p, v, __ATOMIC_RELAXED, __HIP_MEMORY_SCOPE_AGENT); }
__device__ __forceinline__ unsigned xb_xcc_id() { return (unsigned)__builtin_amdgcn_s_getreg((3 << 11) | 20) & 0xFu; }
#define XB_SPIN(cond, bar) do { unsigned _sp = 0; while (cond) { __builtin_amdgcn_s_sleep(1); \
    if ((++_sp & 255u) == 0u) { if (xb_ld(&(bar)[XB_TMO])) break; if (_sp > XB_SPIN_CAP) { atomicAdd(&(bar)[XB_TMO], 1u); break; } } } } while (0)

struct XcdBarrier {
    unsigned* bar; unsigned x;
    volatile LAS unsigned* st;
};

__device__ __forceinline__ XcdBarrier xcd_barrier_post(unsigned* bar, volatile LAS unsigned* st) {
    XcdBarrier b; b.bar = bar; b.x = xb_xcc_id(); b.st = st;
    if (threadIdx.x == 0) (void)xb_add(&bar[XB_XCNT(b.x)], 1u);
    return b;
}
__device__ __forceinline__ void xcd_barrier_complete(unsigned* bar, unsigned x, unsigned& nloc, unsigned& nx) {
    const unsigned G = gridDim.x * gridDim.y * gridDim.z;
    unsigned sum, cnt, mine, sp = 0u;
    for (;;) {
        sum = 0u; cnt = 0u; mine = 0u;
#pragma unroll
        for (unsigned j = 0; j < 16; ++j) { const unsigned c = xb_ld(&bar[XB_XCNT(j)]); sum += c; cnt += (c > 0u) ? 1u : 0u; mine = (j == x) ? c : mine; }
        if (sum == G) break;
        __builtin_amdgcn_s_sleep(1);
        if ((++sp & 255u) == 0u) { if (xb_ld(&bar[XB_TMO])) break; if (sp > XB_SPIN_CAP) { atomicAdd(&bar[XB_TMO], 1u); break; } }
    }
    nloc = mine > 0u ? mine : 1u; nx = cnt > 0u ? cnt : 1u;
}

__device__ __forceinline__ void xcd_barrier(const XcdBarrier& b) {
    asm volatile("s_waitcnt vmcnt(0)" ::: "memory");
    __syncthreads();
    if (threadIdx.x == 0) {
        unsigned* bar = b.bar;
        __builtin_amdgcn_s_waitcnt(0);
        unsigned nloc = b.st[0], nx = b.st[1];
        if (nloc == 0u) { xcd_barrier_complete(bar, b.x, nloc, nx); b.st[0] = nloc; b.st[1] = nx; }
        const unsigned old = xb_add(&bar[XB_XSUB(b.x)], 1u);
        const unsigned gen = old / nloc;
        if (old + 1u == (gen + 1u) * nloc) {
            __builtin_amdgcn_fence(__ATOMIC_RELEASE, "agent");
            asm volatile("s_waitcnt vmcnt(0)" ::: "memory");
            const unsigned og = xb_add(&bar[XB_TOP], 1u);
            const unsigned tg = og / nx;
            if (og + 1u == (tg + 1u) * nx) xb_add(&bar[XB_TOPGEN], 1u);
            else XB_SPIN(xb_ld(&bar[XB_TOPGEN]) == tg, bar);
            __builtin_amdgcn_fence(__ATOMIC_ACQUIRE, "agent");
            xb_add(&bar[XB_XGEN(b.x)], 1u);
            asm volatile("s_waitcnt vmcnt(0)" ::: "memory");
        } else {
            XB_SPIN(xb_ld(&bar[XB_XGEN(b.x)]) == gen, bar);
            __builtin_amdgcn_fence(__ATOMIC_ACQUIRE, "agent");
            asm volatile("s_waitcnt vmcnt(0)" ::: "memory");
        }
    }
    __syncthreads();
}

struct Args { const void* in[29]; float* out; unsigned char* ws; };
__device__ __forceinline__ void transpose_item(const float* W, int K, int N, bf16* WT, int row_off, const float* gain, LAS float* scr, int item, int lane) {
    const int nblk = N / 32, kb = item / nblk, nb = item % nblk, k0 = 64 * kb, n0 = 32 * nb;
    float wv_[32];
#pragma unroll
    for (int i = 0; i < 32; ++i) wv_[i] = __builtin_nontemporal_load(W + (size_t)(k0 + 2 * i + (lane >> 5)) * N + n0 + (lane & 31));
#pragma unroll
    for (int i = 0; i < 32; ++i) { const int kk = 2 * i + (lane >> 5); const float gv = gain ? gain[k0 + kk] : 1.f; scr[kk * 33 + (lane & 31)] = wv_[i] * gv; }
    asm volatile("s_waitcnt lgkmcnt(0)" ::: "memory");
    const int c = lane & 7;
#pragma unroll
    for (int j = 0; j < 4; ++j) { const int n = (lane >> 3) + 8 * j; const LAS float* s = scr + (8 * c) * 33 + n;
        v4u o; o.x = pk2(s[0 * 33], s[1 * 33]); o.y = pk2(s[2 * 33], s[3 * 33]); o.z = pk2(s[4 * 33], s[5 * 33]); o.w = pk2(s[6 * 33], s[7 * 33]);
        *(v4u*)(WT + (size_t)(row_off + n0 + n) * K + k0 + 8 * c) = o; }
    asm volatile("s_waitcnt lgkmcnt(0)" ::: "memory");
}
#define IN_F(i) ((const float*)args.in[i])

__global__ void __launch_bounds__(NTHR, 2) mega_fwd(Args args) {
    extern __shared__ __attribute__((aligned(16))) unsigned char lds[];
    cg::grid_group grid = cg::this_grid();
    const int tid = threadIdx.x, lane = tid & 63, wave = __builtin_amdgcn_readfirstlane(tid >> 6);
    const int G = gridDim.x, bx = blockIdx.x;
    const int vcu = (G % 8 == 0) ? (bx % 8) * (G / 8) + bx / 8 : bx;
    unsigned char* ws = args.ws;
    float* XF = args.out;
    bf16* XB = (bf16*)(ws + WS_XB);
    float* RSS = (float*)(ws + WS_RSSP);
    float* ROPE = (float*)(ws + WS_ROPE);
    bf16* Zb = (bf16*)(ws + WS_Z); bf16* OC = (bf16*)(ws + WS_OC); bf16* MIX = (bf16*)(ws + WS_MIX);
    bf16* Hb = (bf16*)(ws + WS_H); bf16* QX = (bf16*)(ws + WS_QX); bf16* OX = (bf16*)(ws + WS_OX);
    LAS unsigned char* ldsl = (LAS unsigned char*)lds;

    volatile LAS unsigned* bst = (volatile LAS unsigned*)(ldsl + 131072 + 64);
    if (tid < 2) bst[tid] = 0u;
    __syncthreads();
    for (int rep_ = 0; rep_ < REP_PRO; ++rep_) {
        const int gw = vcu * NWAVES + wave, NGW = G * NWAVES;
        LAS float* scr = (LAS float*)(ldsl + wave * 16384);
        constexpr int I_IN = 16 * 80, I_SQ = 16 * 32, I_1 = 16 * 128, I_2 = 64 * 32, IPL = I_IN + 5 * I_SQ + I_1 + I_2;
        for (int it = gw; it < DEPTH * IPL; it += NGW) {
            const int l = it / IPL; int r = it % IPL; unsigned char* wl = ws + WS_W + (size_t)l * W_LAYER;
            if (r < I_IN) { transpose_item(IN_F(4) + (size_t)l * DM * INW, DM, INW, (bf16*)(wl + WO_IN), 0, IN_F(3) + l * DM, scr, r, lane); continue; } r -= I_IN;
            if (r < I_SQ) { transpose_item(IN_F(18) + (size_t)l * DM * DM, DM, DM, (bf16*)(wl + WO_OUT), 0, nullptr, scr, r, lane); continue; } r -= I_SQ;
            if (r < I_SQ) { transpose_item(IN_F(21) + (size_t)l * DM * DM, DM, DM, (bf16*)(wl + WO_Q), 0, IN_F(19) + l * DM, scr, r, lane); continue; } r -= I_SQ;
            if (r < I_SQ) { transpose_item(IN_F(22) + (size_t)l * DM * DM, DM, DM, (bf16*)(wl + WO_KV), 0, nullptr, scr, r, lane); continue; } r -= I_SQ;
            if (r < I_SQ) { transpose_item(IN_F(23) + (size_t)l * DM * DM, DM, DM, (bf16*)(wl + WO_KV), DM, nullptr, scr, r, lane); continue; } r -= I_SQ;
            if (r < I_SQ) { transpose_item(IN_F(24) + (size_t)l * DM * DM, DM, DM, (bf16*)(wl + WO_O), 0, nullptr, scr, r, lane); continue; } r -= I_SQ;
            if (r < I_1) { transpose_item(IN_F(26) + (size_t)l * DM * DFF, DM, DFF, (bf16*)(wl + WO_1), 0, IN_F(25) + l * DM, scr, r, lane); continue; } r -= I_1;
            transpose_item(IN_F(27) + (size_t)l * DFF * DM, DFF, DM, (bf16*)(wl + WO_2), 0, nullptr, scr, r, lane);
        }
        const int gt = vcu * NTHR + tid, NGT = G * NTHR;
        { bf16* WG = (bf16*)(ws + WS_GATE);
          for (int o = gt; o < DEPTH * 2 * 2 * 8 * 64 * 64; o += NGT) { const int i = o & 63, jx = (o >> 6) & 63, n = (o >> 12) & 7, gate = (o >> 15) & 1, dir = (o >> 16) & 1, l = o >> 17;
              const float* src = gate ? IN_F(14) : IN_F(12);
              WG[o] = (bf16)f2bf(-LOG2E * src[((((size_t)l * 2 + dir) * 8 + n) * 64 + i) * 64 + jx]); } }
        { float* SPL = (float*)(ws + WS_GATE + 768 * 1024); for (int o = gt; o < DEPTH * 2 * 512; o += NGT) SPL[o] = -8.f * LOG2E * log1pf(expf(-IN_F(16)[o])); }
        { const int* pos = (const int*)args.in[2];
          for (int o = gt; o < T * 8; o += NGT) { const int row = o >> 3, i = o & 7; const float inv = powf(500000.f, -(float)i * 0.125f); const float ang = (float)pos[row] * inv;
              ROPE[row * 16 + i] = cosf(ang); ROPE[row * 16 + 8 + i] = sinf(ang); } }
        if (gt < DEPTH * BATCH) ((unsigned*)(ws + WS_CNT))[gt] = 0u;
        if (gt < XCD_BAR_WORDS) ((unsigned*)(ws + WS_BAR))[gt] = 0u;
        for (int m0 = gw * 4; m0 < T; m0 += NGW * 4) { f32x4 v[4][4];
#pragma unroll
            for (int q = 0; q < 4; ++q) { const f32x4* xr = (const f32x4*)(IN_F(0) + (size_t)(m0 + q) * DM) + lane;
#pragma unroll
                for (int j = 0; j < 4; ++j) v[q][j] = __builtin_nontemporal_load(xr + 64 * j); }
#pragma unroll
            for (int q = 0; q < 4; ++q) { float s = 0.f;
#pragma unroll
                for (int j = 0; j < 4; ++j) s += (v[q][j].x * v[q][j].x + v[q][j].y * v[q][j].y) + (v[q][j].z * v[q][j].z + v[q][j].w * v[q][j].w);
                s = wave_sum(s); if (lane < 16) RSS[(size_t)(m0 + q) * 16 + lane] = (lane == 0) ? s : 0.f;
                unsigned long long* o8 = (unsigned long long*)(XB + (size_t)(m0 + q) * DM) + lane;
#pragma unroll
                for (int j = 0; j < 4; ++j) o8[64 * j] = (unsigned long long)pk2(v[q][j].x, v[q][j].y) | ((unsigned long long)pk2(v[q][j].z, v[q][j].w) << 32); } }
        for (int m = gw; m < DEPTH * TM; m += NGW) { const int l = m / TM, row = m % TM; const f32x4* xr = (const f32x4*)(IN_F(1) + (size_t)row * DM) + lane; const f32x4* gr = (const f32x4*)(IN_F(20) + l * DM) + lane; f32x4 v[4]; float s = 0.f;
#pragma unroll
            for (int j = 0; j < 4; ++j) { v[j] = xr[64 * j]; s += (v[j].x * v[j].x + v[j].y * v[j].y) + (v[j].z * v[j].z + v[j].w * v[j].w); }
            const float rs = rsqrtf(wave_sum(s) * (1.f / DM) + 1e-6f);
            unsigned long long* o8 = (unsigned long long*)((bf16*)(ws + WS_MEMN) + (size_t)m * DM) + lane;
#pragma unroll
            for (int j = 0; j < 4; ++j) { const f32x4 g = gr[64 * j]; o8[64 * j] = (unsigned long long)pk2(v[j].x * rs * g.x, v[j].y * rs * g.y) | ((unsigned long long)pk2(v[j].z * rs * g.z, v[j].w * rs * g.w) << 32); } }
    }
    grid.sync();
    const XcdBarrier xbar = xcd_barrier_post((unsigned*)(ws + WS_BAR), bst);
#define GRID_BAR() xcd_barrier(xbar)

    for (int l = 0; l < DEPTH; ++l) {
        pg8::Gemm g{(const bf16*)(ws + WS_MEMN) + (size_t)l * TM * DM, (const bf16*)(ws + WS_W + (size_t)l * W_LAYER + WO_KV), TM, 2048, DM};
        pg8::StaticOrder S; S.init(TM, 2048, G, bx);
        pg8::EpiScale<0> E{(bf16*)(ws + WS_KVX) + (size_t)l * TM * 2048, 2048, nullptr, 1.f, nullptr};
        pg8::gemm_phase<pg8::EpiScale<0>, pg8::StaticOrder, true, true>(ldsl, g, S, E);
    }

#pragma unroll
    for (int l = 0; l < DEPTH; ++l) {
        unsigned char* wl = ws + WS_W + (size_t)l * W_LAYER;
        for (int rep_ = 0; rep_ < REP_IN; ++rep_) {
            pg8::Gemm g{XB, (const bf16*)(wl + WO_IN), T, INW, DM}; pg8::StaticOrder S; S.init(T, INW, G, bx);
            pg8::EpiScale<1> E{Zb, INW, RSS + (size_t)(3 * l) * T * 16, 0.125f * LOG2E, ROPE};
            pg8::gemm_phase<pg8::EpiScale<1>, pg8::StaticOrder, true, true>(ldsl, g, S, E);
        }
        GRID_BAR();
        const float lam_init = 0.8f - 0.6f * expf(-0.3f * (float)l);
        float lam;
        { const float a = wave_sum(IN_F(5)[l * 64 + lane] * IN_F(6)[l * 64 + lane]), b2 = wave_sum(IN_F(7)[l * 64 + lane] * IN_F(8)[l * 64 + lane]); lam = expf(a) - expf(b2) + lam_init; }
        LruArgs LA{(const float*)(ws + WS_GATE + 768 * 1024) + l * 1024, (float*)(ws + WS_CIN), (unsigned*)(ws + WS_CNT) + l * BATCH, Zb, IN_F(10) + (size_t)l * 4 * 512, IN_F(11) + l * 512, IN_F(13) + l * 1024, IN_F(15) + l * 1024, IN_F(16) + l * 1024, IN_F(17) + l * 512,
                   (const bf16*)(ws + WS_GATE) + (size_t)l * 131072, (float*)(ws + WS_SUM), MIX, OC, IN_F(9) + l * 128, lam, 1.f - lam_init};
#ifndef NO_LRUA
        for (int rep_ = 0; rep_ < REP_LRUA; ++rep_)
        for (int base = vcu * 4; base < BATCH * 128; base += G * 4) { bf16x8 xr[7]; lru_xload(xr, LA, base >> 7, base & 127, wave, lane);
#pragma unroll 1
            for (int i = 0; i < 4; ++i) lru_chunk<false>(LA, base >> 7, (base & 127) + i, (char*)lds, xr, base >> 7, i < 3 ? (base & 127) + i + 1 : -1, i == 3); }
#endif
        for (int rep_ = 0; rep_ < REP_FA; ++rep_)
        for (int i = 0; i * G < 1024; ++i) {
            const int L = i * G + vcu; if (L >= 1024) break;
            const int uid = (G == 256) ? (((vcu >> 5) * 4 + i) * 32 + (vcu & 31)) : L;
            const int bh = uid >> 5, wi = uid & 31, c = wi >> 4, qb = wi & 15, b = bh >> 2, h = bh & 3;
            const bf16* Qp = Zb + ((size_t)b * SEQ + qb * 256) * INW + h * 128 + c * 64;
            const bf16* Kp = Zb + ((size_t)b * SEQ) * INW + 512 + h * 128 + c * 64;
            const bf16* Vp = Zb + ((size_t)b * SEQ) * INW + 1024 + h * 128;
            bf16* Op = OC + (size_t)c * T * 512 + ((size_t)b * SEQ + qb * 256) * 512 + h * 128;
#ifndef NO_FA64
            fa::flash_unit64c(Qp, INW, Kp, INW, Vp, INW, Op, 512, SEQ, (char*)lds);
#endif
        }
        GRID_BAR();
#ifndef NO_LRUC
        for (int rep_ = 0; rep_ < REP_LRUC; ++rep_)
        for (int base = vcu * 4; base < BATCH * 128; base += G * 4) { bf16x8 xr[7]; lru_xload(xr, LA, base >> 7, base & 127, wave, lane);
#pragma unroll 1
            for (int i = 0; i < 4; ++i) lru_chunk<true>(LA, base >> 7, (base & 127) + i, (char*)lds, xr, base >> 7, i < 3 ? (base & 127) + i + 1 : -1, false); }
#endif
        GRID_BAR();
        {
            pg8::Gemm g{MIX, (const bf16*)(wl + WO_OUT), T, DM, DM}; pg8::StaticOrder S; S.init(T, DM, G, bx);
            if (l == 0) { pg8::EpiRes<true> E{IN_F(0), XB, RSS + (size_t)(3 * l + 1) * T * 16}; pg8::gemm_phase<pg8::EpiRes<true>, pg8::StaticOrder, true, true>(ldsl, g, S, E); }
            else { pg8::EpiRes<false> E{nullptr, XB, RSS + (size_t)(3 * l + 1) * T * 16}; pg8::gemm_phase<pg8::EpiRes<false>, pg8::StaticOrder, true, true>(ldsl, g, S, E); }
        }
        GRID_BAR();
        for (int rep_ = 0; rep_ < REP_Q; ++rep_) {
            pg8::Gemm g{XB, (const bf16*)(wl + WO_Q), T, DM, DM}; pg8::StaticOrder S; S.init(T, DM, G, bx);
            pg8::EpiScale<2> E{QX, DM, RSS + (size_t)(3 * l + 1) * T * 16, 0.0625f * LOG2E, nullptr};
            pg8::gemm_phase<pg8::EpiScale<2>, pg8::StaticOrder, true, true>(ldsl, g, S, E);
        }
        {
            pg8::StaticOrder S; S.init(T, DM, G, bx); pg8::Unit u;
            for (int rep_ = 0; rep_ < REP_XA; ++rep_)
            for (int i = 0; S.next(i, u); ++i)
            {
                    const int b = u.pm >> 4, qb = u.pm & 15, h = u.pn;
                    const bf16* KV = (const bf16*)(ws + WS_KVX) + (size_t)l * TM * 2048 + (size_t)b * NMEM * 2048;
                    const bf16* Qp = QX + ((size_t)b * SEQ + qb * 256) * DM + h * 256;
                    bf16* Op = OX + ((size_t)b * SEQ + qb * 256) * DM + h * 256;
#ifndef NO_FA256
                    fa::xattn_unit(Qp, KV + h * 256, KV + 1024 + h * 256, Op, (char*)lds);
#endif
            }
        }
        GRID_BAR();
        {
            pg8::Gemm g{OX, (const bf16*)(wl + WO_O), T, DM, DM}; pg8::StaticOrder S; S.init(T, DM, G, bx);
            pg8::EpiRes<false> E{nullptr, XB, RSS + (size_t)(3 * l + 2) * T * 16};
            pg8::gemm_phase<pg8::EpiRes<false>, pg8::StaticOrder, true, true>(ldsl, g, S, E);
        }
        GRID_BAR();
        for (int rep_ = 0; rep_ < REP_UP; ++rep_) {
            pg8::Gemm g{XB, (const bf16*)(wl + WO_1), T, DFF, DM}; pg8::StaticOrder S; S.init(T, DFF, G, bx);
            pg8::EpiScale<3> E{Hb, DFF, RSS + (size_t)(3 * l + 2) * T * 16, 1.f, nullptr};
            pg8::gemm_phase<pg8::EpiScale<3>, pg8::StaticOrder, true, true>(ldsl, g, S, E);
        }
        GRID_BAR();
        {
            pg8::Gemm g{Hb, (const bf16*)(wl + WO_2), T, DM, DFF}; pg8::StaticOrder S; S.init(T, DM, G, bx);
            pg8::EpiRes<false> E{nullptr, XB, RSS + (size_t)(3 * l + 3) * T * 16};
            pg8::gemm_phase<pg8::EpiRes<false>, pg8::StaticOrder, true, true>(ldsl, g, S, E);
        }
        GRID_BAR();
    }
    for (int rep_ = 0; rep_ < REP_SYNC; ++rep_) GRID_BAR();
    {
        const int gw = vcu * NWAVES + wave, NGW = G * NWAVES; const float* rss = RSS + (size_t)6 * T * 16; const f32x4* gr = (const f32x4*)IN_F(28) + lane;
        f32x4 gv[4];
#pragma unroll
        for (int j = 0; j < 4; ++j) gv[j] = gr[64 * j];
        for (int m0 = gw * 4; m0 < T; m0 += NGW * 4) { unsigned long long q[4][4]; float ssv[4];
#pragma unroll
            for (int r = 0; r < 4; ++r) { const unsigned long long* xr = (const unsigned long long*)(XB + (size_t)(m0 + r) * DM) + lane; ssv[r] = lane < 16 ? rss[(size_t)(m0 + r) * 16 + lane] : 0.f;
#pragma unroll
                for (int j = 0; j < 4; ++j) q[r][j] = xr[64 * j]; }
#pragma unroll
            for (int r = 0; r < 4; ++r) { const float rs = rsqrtf(wave_sum(ssv[r]) * (1.f / DM) + 1e-6f); f32x4* orow = (f32x4*)(XF + (size_t)(m0 + r) * DM) + lane;
#pragma unroll
                for (int j = 0; j < 4; ++j) { const unsigned lo = (unsigned)q[r][j], hi2 = (unsigned)(q[r][j] >> 32);
                    const f32x4 v = {__uint_as_float(lo << 16), __uint_as_float(lo & 0xffff0000u), __uint_as_float(hi2 << 16), __uint_as_float(hi2 & 0xffff0000u)};
                    orow[64 * j] = v * rs * gv[j]; } } }
    }
}

extern "C" void kernel_launch(void* const* d_in, const int* in_sizes, int n_in, void* d_out, int out_size, void* d_ws, size_t ws_size, hipStream_t stream) {
    static int grid = 0;
    if (grid == 0) {
        if (n_in != 29 || in_sizes[0] != T * DM || out_size != T * DM || ws_size < WS_END) { fprintf(stderr, "kernel_launch: unexpected shapes (n_in %d, in0 %d, out %d, ws %zu, need %zu)\n", n_in, n_in > 0 ? in_sizes[0] : -1, out_size, ws_size, (size_t)WS_END); grid = -1; return; }
        int dev = 0, cus = 0, per_cu = 0;
        if (hipGetDevice(&dev) != hipSuccess || hipDeviceGetAttribute(&cus, hipDeviceAttributeMultiprocessorCount, dev) != hipSuccess) { fprintf(stderr, "kernel_launch: device query failed\n"); grid = -1; return; }
        if (hipFuncSetAttribute((const void*)mega_fwd, hipFuncAttributeMaxDynamicSharedMemorySize, LDS_BYTES) != hipSuccess) { fprintf(stderr, "kernel_launch: hipFuncSetAttribute failed\n"); grid = -1; return; }
        if (hipOccupancyMaxActiveBlocksPerMultiprocessor(&per_cu, (const void*)mega_fwd, NTHR, LDS_BYTES) != hipSuccess || per_cu < 1) { fprintf(stderr, "kernel_launch: occupancy query says %d blocks per CU\n", per_cu); (void)hipGetLastError(); per_cu = 1; }
        grid = cus;
    }
    if (grid < 0) return;
    Args a{};
    for (int i = 0; i < 29; ++i) a.in[i] = d_in[i];
    a.out = (float*)d_out; a.ws = (unsigned char*)d_ws;
    void* kargs[] = {&a};
    const hipError_t e = hipLaunchCooperativeKernel((const void*)mega_fwd, dim3(grid), dim3(NTHR), kargs, LDS_BYTES, stream);
    if (e != hipSuccess) fprintf(stderr, "kernel_launch: cooperative launch failed: %s (grid %d)\n", hipGetErrorString(e), grid);
}
```
